# Optimizing an MI355X kernel written in HIP

```python
import math
import jax, jax.numpy as jnp
from jax import lax
import numpy as np

D_MODEL = 2048
BATCH = 2
SEQ = 8192
DEPTH = 4

N_MIXERS = 2
N_RWKV = (DEPTH + 1) // 2
N_DIFF = DEPTH // 2
RWKV_HEAD = 64
RWKV_HEADS = D_MODEL // RWKV_HEAD
LORA_DECAY = 96
LORA_AAA = 96
LORA_MV = 64
LORA_GATE = 128
GN_EPS = 64e-5
DIFF_QK = 128
DIFF_V = 256
DIFF_HEADS = D_MODEL // DIFF_V
Q_BLOCK = 128
REL_BUCKETS = 32
REL_MAX_EXACT = 16
REL_MAX_DIST = 128
D_FF = ((8 * D_MODEL // 3 + 127) // 128) * 128
CONV_W = 3
LN_EPS = 1e-5
ALPHA = (2 * DEPTH) ** 0.25
BETA = (8 * DEPTH) ** -0.25

kernel_name = "hybrid_rwkv7_diffattn_convglu_deepnorm"


def layer_norm(x, g, b):
    xf = x.astype(jnp.float32)
    mu = xf.mean(-1, keepdims=True)
    var = jnp.square(xf - mu).mean(-1, keepdims=True)
    return ((xf - mu) * lax.rsqrt(var + LN_EPS) * g + b).astype(x.dtype)


def token_shift(x):
    return jnp.pad(x, ((0, 0), (1, 0), (0, 0)))[:, :-1]


def wkv7_scan(r, decay, k, v, a_vec, b_vec):
    B, T, H, N = r.shape

    def step(S, inp):
        r_t, w_t, k_t, v_t, a_t, b_t = inp
        sa = jnp.einsum('bhij,bhj->bhi', S, a_t)
        S = S * w_t[:, :, None, :] + sa[..., None] * b_t[:, :, None, :] + v_t[..., None] * k_t[:, :, None, :]
        y = jnp.einsum('bhij,bhj->bhi', S, r_t)
        return S, y

    xs = tuple(jnp.moveaxis(t.astype(jnp.float32), 1, 0) for t in (r, decay, k, v, a_vec, b_vec))
    S0 = jnp.zeros((B, H, N, N), jnp.float32)
    _, y = lax.scan(step, S0, xs)
    return jnp.moveaxis(y, 0, 1)


def rwkv7_mix(x, v_first, vres, mu, w_rkv, w0, w1, w2, a0, a1, a2, g1, g2, k_k, k_a, r_k, lnx_g, lnx_b, w_o):
    B, T, D = x.shape
    H, N = RWKV_HEADS, RWKV_HEAD
    xx = token_shift(x) - x
    xr, xw, xk, xv, xa, xg = (x + xx * mu[i] for i in range(6))
    r = xr @ w_rkv[0]
    k = xk @ w_rkv[1]
    v = xv @ w_rkv[2]
    w = -jax.nn.softplus(-(w0 + jnp.tanh(xw @ w1) @ w2)) - 0.5
    if vres is None:
        v_first = v
    else:
        v0, v1, v2 = vres
        v = v + (v_first - v) * jax.nn.sigmoid(v0 + (xv @ v1) @ v2)
    a = jax.nn.sigmoid(a0 + (xa @ a1) @ a2)
    g = jax.nn.sigmoid(xg @ g1) @ g2
    kk = (k * k_k).reshape(B, T, H, N).astype(jnp.float32)
    kk = kk / jnp.maximum(jnp.sqrt(jnp.sum(kk * kk, -1, keepdims=True)), 1e-12)
    k = k * (1 + (a - 1) * k_a)
    r_h = r.reshape(B, T, H, N)
    k_h = k.reshape(B, T, H, N)
    v_h = v.reshape(B, T, H, N)
    a_h = a.reshape(B, T, H, N).astype(jnp.float32)
    decay = jnp.exp(-jnp.exp(w.astype(jnp.float32))).reshape(B, T, H, N)
    y = wkv7_scan(r_h, decay, k_h, v_h, -kk, kk * a_h)
    mean = y.mean(-1, keepdims=True)
    var = jnp.square(y - mean).mean(-1, keepdims=True)
    y = ((y - mean) * lax.rsqrt(var + GN_EPS)).reshape(B, T, D) * lnx_g + lnx_b
    bonus = jnp.sum(r_h * k_h * r_k, -1, keepdims=True) * v_h
    y = (y + bonus.reshape(B, T, D)).astype(x.dtype)
    return (y * g) @ w_o, v_first


def rel_bucket(dist):
    n = jnp.maximum(dist, 0)
    large = REL_MAX_EXACT + (jnp.log(jnp.maximum(n, 1).astype(jnp.float32) / REL_MAX_EXACT)
                             / math.log(REL_MAX_DIST / REL_MAX_EXACT)
                             * (REL_BUCKETS - REL_MAX_EXACT)).astype(jnp.int32)
    large = jnp.minimum(large, REL_BUCKETS - 1)
    return jnp.where(n < REL_MAX_EXACT, n, large)


def diff_attn_mix(x, w_qkv, lam, subln_g, w_o, rel_bias, lambda_init):
    B, T, D = x.shape
    H = DIFF_HEADS
    q, k, v = jnp.split(x @ w_qkv, 3, axis=-1)
    q = q.reshape(B, T, H, 2, DIFF_QK) * (DIFF_QK ** -0.5)
    k = k.reshape(B, T, H, 2, DIFF_QK)
    v = v.reshape(B, T, H, DIFF_V)
    lamf = lam.astype(jnp.float32)
    lam_full = jnp.exp(jnp.sum(lamf[0] * lamf[1])) - jnp.exp(jnp.sum(lamf[2] * lamf[3])) + lambda_init
    k_pos = jnp.arange(T)
    n_blk = T // Q_BLOCK

    def block(i):
        start = i * Q_BLOCK
        q_blk = lax.dynamic_slice_in_dim(q, start, Q_BLOCK, axis=1)
        s = jnp.einsum('bqhcd,bkhcd->bhcqk', q_blk, k).astype(jnp.float32)
        dist = (start + jnp.arange(Q_BLOCK))[:, None] - k_pos[None, :]
        bias = jnp.transpose(rel_bias[rel_bucket(dist)], (2, 0, 1))
        s = s + bias[None, :, None].astype(jnp.float32)
        s = jnp.where(dist >= 0, s, -1e30)
        p = jax.nn.softmax(s, axis=-1)
        attn = p[:, :, 0] - lam_full * p[:, :, 1]
        return jnp.einsum('bhqk,bkhd->bqhd', attn.astype(v.dtype), v)

    o = lax.map(block, jnp.arange(n_blk))
    o = jnp.moveaxis(o, 0, 1).reshape(B, T, H, DIFF_V).astype(jnp.float32)
    o = o * lax.rsqrt(jnp.mean(o * o, -1, keepdims=True) + LN_EPS) * subln_g * (1.0 - lambda_init)
    return o.reshape(B, T, D).astype(x.dtype) @ w_o


def conv_glu(x, w_up, conv_w, conv_b, w_down):
    T = x.shape[1]
    u, g = jnp.split(x @ w_up, 2, axis=-1)
    gp = jnp.pad(g, ((0, 0), (CONV_W - 1, 0), (0, 0)))
    gc = conv_b
    for j in range(CONV_W):
        gc = gc + gp[:, j:j + T] * conv_w[j]
    return (u * jax.nn.gelu(gc)) @ w_down


def setup_inputs(seed: int = 0) -> dict:
    key = jax.random.key(seed)
    ks = iter(jax.random.split(key, 40))
    nrm = lambda shape, s: jax.random.normal(next(ks), shape, jnp.float32) * s
    D, H, N, F = D_MODEL, RWKV_HEADS, RWKV_HEAD, D_FF
    nv = max(N_RWKV - 1, 1)
    ramp = (jnp.arange(D, dtype=jnp.float32) / (D - 1)) ** 0.85
    return {
        "x": nrm((BATCH, SEQ, D), 1.0),
        "ln_g": 1.0 + nrm((DEPTH, 2, D), 0.05),
        "ln_b": nrm((DEPTH, 2, D), 0.02),
        "rw_mu": jax.random.uniform(next(ks), (N_RWKV, 6, D), jnp.float32),
        "rw_w_rkv": nrm((N_RWKV, 3, D, D), D ** -0.5),
        "rw_w0": -6.0 + 5.0 * ramp[None] + nrm((N_RWKV, D), 0.1),
        "rw_w1": nrm((N_RWKV, D, LORA_DECAY), D ** -0.5),
        "rw_w2": nrm((N_RWKV, LORA_DECAY, D), 0.1 * LORA_DECAY ** -0.5),
        "rw_a0": nrm((N_RWKV, D), 0.1),
        "rw_a1": nrm((N_RWKV, D, LORA_AAA), D ** -0.5),
        "rw_a2": nrm((N_RWKV, LORA_AAA, D), 0.3 * LORA_AAA ** -0.5),
        "rw_v0": nrm((nv, D), 0.1),
        "rw_v1": nrm((nv, D, LORA_MV), D ** -0.5),
        "rw_v2": nrm((nv, LORA_MV, D), 0.3 * LORA_MV ** -0.5),
        "rw_g1": nrm((N_RWKV, D, LORA_GATE), D ** -0.5),
        "rw_g2": nrm((N_RWKV, LORA_GATE, D), LORA_GATE ** -0.5),
        "rw_k_k": 0.85 + nrm((N_RWKV, D), 0.05),
        "rw_k_a": 1.0 + nrm((N_RWKV, D), 0.05),
        "rw_r_k": nrm((N_RWKV, H, N), 0.1),
        "rw_lnx_g": 1.0 + nrm((N_RWKV, D), 0.05),
        "rw_lnx_b": nrm((N_RWKV, D), 0.02),
        "rw_w_o": nrm((N_RWKV, D, D), BETA * D ** -0.5),
        "da_w_qkv": nrm((N_DIFF, D, 3 * D), D ** -0.5),
        "da_lam": nrm((N_DIFF, 4, DIFF_QK), 0.1),
        "da_subln_g": 1.0 + nrm((N_DIFF, DIFF_V), 0.05),
        "da_w_o": nrm((N_DIFF, D, D), BETA * D ** -0.5),
        "rel_bias": nrm((REL_BUCKETS, DIFF_HEADS), 0.5),
        "ff_w_up": nrm((DEPTH, D, 2 * F), D ** -0.5),
        "ff_conv_w": nrm((DEPTH, CONV_W, F), CONV_W ** -0.5),
        "ff_conv_b": nrm((DEPTH, F), 0.02),
        "ff_w_down": nrm((DEPTH, F, D), BETA * F ** -0.5),
    }


def reference(x, ln_g, ln_b, rw_mu, rw_w_rkv, rw_w0, rw_w1, rw_w2, rw_a0, rw_a1, rw_a2,
              rw_v0, rw_v1, rw_v2, rw_g1, rw_g2, rw_k_k, rw_k_a, rw_r_k, rw_lnx_g, rw_lnx_b, rw_w_o,
              da_w_qkv, da_lam, da_subln_g, da_w_o, rel_bias,
              ff_w_up, ff_conv_w, ff_conv_b, ff_w_down):
    v_first = None
    for i in range(DEPTH):
        j = i // N_MIXERS
        if i % N_MIXERS == 0:
            vres = None if j == 0 else (rw_v0[j - 1], rw_v1[j - 1], rw_v2[j - 1])
            h, v_first = rwkv7_mix(x, v_first, vres, rw_mu[j], rw_w_rkv[j], rw_w0[j], rw_w1[j], rw_w2[j],
                                   rw_a0[j], rw_a1[j], rw_a2[j], rw_g1[j], rw_g2[j], rw_k_k[j], rw_k_a[j],
                                   rw_r_k[j], rw_lnx_g[j], rw_lnx_b[j], rw_w_o[j])
        else:
            lambda_init = 0.8 - 0.6 * math.exp(-0.3 * i)
            h = diff_attn_mix(x, da_w_qkv[j], da_lam[j], da_subln_g[j], da_w_o[j], rel_bias, lambda_init)
        x = layer_norm(ALPHA * x + h, ln_g[i, 0], ln_b[i, 0])
        x = layer_norm(ALPHA * x + conv_glu(x, ff_w_up[i], ff_conv_w[i], ff_conv_b[i], ff_w_down[i]),
                       ln_g[i, 1], ln_b[i, 1])
    return x
```

```cpp
#include <hip/hip_runtime.h>
#include <hip/hip_cooperative_groups.h>
#include <cstdio>
namespace cg = cooperative_groups;

#define LAS __attribute__((address_space(3)))
#define GAS __attribute__((address_space(1)))
typedef _Float16 h16;
typedef _Float16 h16x8 __attribute__((ext_vector_type(8)));
typedef _Float16 h16x4 __attribute__((ext_vector_type(4)));
typedef float f32x4 __attribute__((ext_vector_type(4)));
typedef float f32x2 __attribute__((ext_vector_type(2)));
typedef float f32x16 __attribute__((ext_vector_type(16)));
typedef unsigned u32x4 __attribute__((ext_vector_type(4)));

constexpr int MTOK = 16384, DM = 2048, SEQ = 8192, FF = 5504, LDC1 = 7168;
constexpr float ALPHA = 1.681792830507429f;
constexpr float LOG2E = 1.4426950408889634f;
constexpr float QSCALE = 0.08838834764831845f * LOG2E;
constexpr int LDS_BYTES = 155648;
#define PROBE_MASK 0x0000

constexpr size_t W_B1 = 0, W_B2 = 29360128, W_WO = 33554432, W_UP = 41943040, W_DN = 87031808;
constexpr size_t WS_W16 = 0, WS_X = 117440512, WS_PRE = WS_X + 134217728, WS_XH = WS_PRE + 134217728, WS_VF = WS_XH + 67108864,
                 WS_R1 = WS_VF + 67108864, WS_R2 = WS_R1 + 402653184, WS_Y = WS_R2 + 234881024, WS_BAR = WS_Y + 134217728, WS_END = WS_BAR + 16384;
constexpr size_t R1_DEC = 0, R1_A = 134217728, R1_G = R1_A + 67108864, R1_AA = R1_G + 67108864, R1_YG = R1_AA + 67108864;

struct Params {
    const float* in[31];
    float* out;
    unsigned char* ws;
    int ph_lo, ph_hi;
};

__device__ __forceinline__ int otid() { int t = (int)threadIdx.x; asm volatile("" : "+v"(t)); return t; }
__device__ __forceinline__ int obid() { int t = (int)blockIdx.x; asm volatile("" : "+s"(t)); return t; }
__device__ __forceinline__ float wave_sum(float x) {
#pragma unroll
    for (int o = 32; o >= 1; o >>= 1) x += __shfl_xor(x, o);
    return x;
}
__device__ __forceinline__ float grp16_sum(float x) {
#pragma unroll
    for (int o = 8; o >= 1; o >>= 1) x += __shfl_xor(x, o);
    return x;
}
template <int CTRL> __device__ __forceinline__ float dpp_f(float x) { return __int_as_float(__builtin_amdgcn_update_dpp(0, __float_as_int(x), CTRL, 0xF, 0xF, true)); }
__device__ __forceinline__ float row16_sum(float x) { x += dpp_f<0xB1>(x); x += dpp_f<0x4E>(x); x += dpp_f<0x141>(x); x += dpp_f<0x140>(x); return x; }
__device__ __forceinline__ float sigmoidf_(float x) { return 1.0f / (1.0f + __expf(-x)); }

namespace pg8 {
constexpr int BM = 256, BK = 64, HALF = 128, HTB = HALF * BK * 2, NXCD = 8, WGM = 4;
__device__ __forceinline__ int lds_byte(int r, int c) { const int st = (r >> 4) * 2 + (c >> 5), rr = r & 15, cc = c & 31, ob = rr * 64 + cc * 2; return st * 1024 + (ob ^ (((ob >> 9) & 1) << 5)); }
__device__ __forceinline__ void stage_rc(int b, int& R, int& C) { const int st = b / 1024, sb = b % 1024, swz = sb ^ (((sb >> 9) & 1) << 5); R = (st >> 1) * 16 + swz / 64; C = (st & 1) * 32 + (swz % 64) / 2; }
__device__ __forceinline__ int perm32(int rho) { const int n = rho >> 4, i = rho & 15; return 8 * (i >> 2) + 4 * n + (i & 3); }
struct Unit { int pm, pn; };
struct Order {
    int nM, nN, nwg, G, c;
    __device__ void init(int M, int N, int G_, int c_) { nM = M / BM; nN = N / BM; nwg = nM * nN; G = G_; c = c_; }
    __device__ bool next(int i, Unit& u) const {
        const long L = (long)i * G + c; if (L >= nwg) return false;
        int wgid = (int)L; { const int q = nwg / NXCD, r = nwg % NXCD, xcd = wgid % NXCD, off = wgid / NXCD; wgid = (xcd < r ? xcd * (q + 1) : r * (q + 1) + (xcd - r) * q) + off; }
        const int nig = WGM * nN, gid = wgid / nig, fm = gid * WGM, gsz = (nM - fm) < WGM ? (nM - fm) : WGM;
        u.pm = fm + ((wgid % nig) % gsz); u.pn = (wgid % nig) / gsz; return true;
    }
};

template <class Epi, class AMap>
__device__ __forceinline__ void gemm_phase(LAS unsigned char* lds, const AMap am, const int lda, const h16* Bt, const int ldb, const int M, const int N, const int K, const Epi& E) {
    const int tid = otid(), wid = __builtin_amdgcn_readfirstlane(tid >> 6), lane = tid & 63, wr = wid >> 2, wc = wid & 3, fr = lane & 15, fq = lane >> 4;
    const int nt = K / BK;
    Order S; S.init(M, N, (int)gridDim.x, obid());
    unsigned voffA[2], voffB[2];
#pragma unroll
    for (int i = 0; i < 2; ++i) { int R, C; stage_rc(tid * 16 + i * 8192, R, C); const int Rb = Epi::PERM ? ((R & ~31) + perm32(R & 31)) : R;
        voffA[i] = (unsigned)(R * lda + C) * 2u; voffB[i] = (unsigned)(Rb * ldb + C) * 2u; }
    const size_t kstep = (size_t)(BK * 2);
    const size_t hstepA = (size_t)HALF * lda * 2, hstepB = (size_t)HALF * ldb * 2;
    const size_t tstepA = 2 * hstepA, tstepB = 2 * hstepB;
    const unsigned ldsw = (unsigned)wid * 1024u;
    const int aoff = lds_byte(wr * 64 + fr, fq * 8), boff = lds_byte(wc * 32 + fr, fq * 8);
#define PG8_SA(b, h) (((b) * 2 + (h)) * HTB)
#define PG8_SB(b, h) ((4 + (b) * 2 + (h)) * HTB)
#define PG8_STAGE(bufoff, gbase, voff) do { _Pragma("unroll") for (int _i = 0; _i < 2; ++_i) \
        __builtin_amdgcn_global_load_lds((const unsigned*)((const char*)(gbase) + (voff)[_i]), (LAS unsigned*)(lds + (bufoff) + ldsw + _i * 8192), 16, 0, 0); } while (0)
#define PG8_LDA(dst, b, h) do { _Pragma("unroll") for (int m = 0; m < 4; ++m) _Pragma("unroll") for (int k = 0; k < 2; ++k) dst[m][k] = *(const LAS h16x8*)(lds + PG8_SA(b, h) + aoff + m * 2048 + k * 1024); } while (0)
#define PG8_LDB(dst, b, h) do { _Pragma("unroll") for (int n = 0; n < 2; ++n) _Pragma("unroll") for (int k = 0; k < 2; ++k) dst[n][k] = *(const LAS h16x8*)(lds + PG8_SB(b, h) + boff + n * 2048 + k * 1024); } while (0)
#define PG8_MMA(ai, bj, At, Bt_) do { __builtin_amdgcn_s_setprio(1); _Pragma("unroll") for (int m = 0; m < 4; ++m) _Pragma("unroll") for (int n = 0; n < 2; ++n) _Pragma("unroll") for (int k = 0; k < 2; ++k) \
        acc[ai][bj][m][n] = __builtin_amdgcn_mfma_f32_16x16x32_f16(Bt_[n][k], At[m][k], acc[ai][bj][m][n], 0, 0, 0); __builtin_amdgcn_s_setprio(0); } while (0)
#define PG8_WAIT_V(n) asm volatile("s_waitcnt vmcnt(" #n ")" ::: "memory")
#define PG8_WAIT_L(n) asm volatile("s_waitcnt lgkmcnt(" #n ")" ::: "memory")
#define PG8_BAR __builtin_amdgcn_s_barrier()
#define PG8_SCHED __builtin_amdgcn_sched_barrier(0)
    Unit cur, nxt; int ui = 0;
    if (!S.next(0, cur)) return;
    f32x4 acc[2][2][4][2];
#pragma unroll
    for (int a = 0; a < 2; ++a)
#pragma unroll
        for (int b = 0; b < 2; ++b)
#pragma unroll
            for (int m = 0; m < 4; ++m)
#pragma unroll
                for (int n = 0; n < 2; ++n) acc[a][b][m][n] = (f32x4){0.f, 0.f, 0.f, 0.f};
    h16x8 At[4][2], B0[2][2], B1[2][2];
    const char* cA = am(cur.pn) + (size_t)cur.pm * tstepA; const char* cB = (const char*)Bt + (size_t)cur.pn * tstepB;
    PG8_STAGE(PG8_SB(0, 0), cB, voffB); PG8_STAGE(PG8_SA(0, 0), cA, voffA); PG8_STAGE(PG8_SB(0, 1), cB + hstepB, voffB); PG8_STAGE(PG8_SA(0, 1), cA + hstepA, voffA);
    if (wr == 1) PG8_BAR;
    PG8_WAIT_V(4); PG8_BAR;
    PG8_STAGE(PG8_SB(1, 0), cB + kstep, voffB); PG8_STAGE(PG8_SA(1, 0), cA + kstep, voffA); PG8_STAGE(PG8_SB(1, 1), cB + hstepB + kstep, voffB);
    PG8_WAIT_V(6); PG8_BAR;
    for (;;) {
        const bool has_next = S.next(ui + 1, nxt);
        const char* nA = has_next ? am(nxt.pn) + (size_t)nxt.pm * tstepA : cA; const char* nB = has_next ? (const char*)Bt + (size_t)nxt.pn * tstepB : cB;
#pragma unroll 1
        for (int t = 0; t < nt; t += 2) {
            const bool last = (t == nt - 2);
            const char* a1 = cA + (size_t)(t + 1) * kstep;
            const char* a2 = last ? nA : cA + (size_t)(t + 2) * kstep; const char* b2 = last ? nB : cB + (size_t)(t + 2) * kstep;
            const char* a3 = a2 + kstep; const char* b3 = b2 + kstep;
            PG8_LDB(B0, 0, 0); PG8_SCHED; PG8_LDA(At, 0, 0); PG8_STAGE(PG8_SA(1, 1), a1 + hstepA, voffA);
            PG8_WAIT_L(8); PG8_BAR; PG8_WAIT_L(0); PG8_MMA(0, 0, At, B0); PG8_BAR; PG8_SCHED;
            PG8_LDB(B1, 0, 1); PG8_STAGE(PG8_SB(0, 0), b2, voffB);
            PG8_BAR; PG8_WAIT_L(0); PG8_MMA(0, 1, At, B1); PG8_BAR;
            PG8_LDA(At, 0, 1); PG8_STAGE(PG8_SA(0, 0), a2, voffA);
            PG8_BAR; PG8_WAIT_L(0); PG8_MMA(1, 0, At, B0); PG8_BAR; PG8_SCHED;
            PG8_STAGE(PG8_SB(0, 1), b2 + hstepB, voffB);
            PG8_WAIT_V(6); PG8_BAR; PG8_MMA(1, 1, At, B1); PG8_BAR;
            PG8_LDB(B0, 1, 0); PG8_SCHED; PG8_LDA(At, 1, 0); PG8_STAGE(PG8_SA(0, 1), a2 + hstepA, voffA);
            PG8_WAIT_L(8); PG8_BAR; PG8_WAIT_L(0); PG8_MMA(0, 0, At, B0); PG8_BAR; PG8_SCHED;
            PG8_LDB(B1, 1, 1); PG8_STAGE(PG8_SB(1, 0), b3, voffB);
            PG8_BAR; PG8_WAIT_L(0); PG8_MMA(0, 1, At, B1); PG8_BAR;
            PG8_LDA(At, 1, 1); PG8_STAGE(PG8_SA(1, 0), a3, voffA);
            PG8_BAR; PG8_WAIT_L(0); PG8_MMA(1, 0, At, B0); PG8_BAR; PG8_SCHED;
            PG8_STAGE(PG8_SB(1, 1), b3 + hstepB, voffB);
            PG8_WAIT_V(6); PG8_BAR; PG8_MMA(1, 1, At, B1); PG8_BAR;
        }
        E(acc, cur, wr, wc, fr, fq);
        if (!has_next) break;
#pragma unroll
        for (int a = 0; a < 2; ++a)
#pragma unroll
            for (int b = 0; b < 2; ++b)
#pragma unroll
                for (int m = 0; m < 4; ++m)
#pragma unroll
                    for (int n = 0; n < 2; ++n) acc[a][b][m][n] = (f32x4){0.f, 0.f, 0.f, 0.f};
        cur = nxt; cA = nA; cB = nB; ++ui;
    }
    PG8_WAIT_V(0);
    if (wr == 0) PG8_BAR;
    PG8_BAR;
#undef PG8_SA
#undef PG8_SB
#undef PG8_STAGE
#undef PG8_LDA
#undef PG8_LDB
#undef PG8_MMA
#undef PG8_WAIT_V
#undef PG8_WAIT_L
#undef PG8_BAR
#undef PG8_SCHED
}
}
using pg8::Unit;

__device__ __forceinline__ u32x4 pack8(f32x4 a, f32x4 b) {
    h16x8 v = {(h16)a[0], (h16)a[1], (h16)a[2], (h16)a[3], (h16)b[0], (h16)b[1], (h16)b[2], (h16)b[3]};
    return __builtin_bit_cast(u32x4, v);
}

struct AMapOne { const char* A; __device__ __forceinline__ const char* operator()(int) const { return A; } };
struct AMapMix {
    const char* A;
    __device__ __forceinline__ const char* operator()(int pn) const {
        int idx; if (pn < 8) idx = 0; else if (pn < 16) idx = 2; else if (pn < 24) idx = 3; else if (pn == 24) idx = 1; else if (pn == 25) idx = 4; else if (pn == 26) idx = 5; else idx = 3;
        return A + (size_t)idx * ((size_t)MTOK * DM * 2);
    }
};
struct AMapLora {
    const char* C1;
    __device__ __forceinline__ const char* operator()(int pn) const { return C1 + (size_t)(6144 + 256 * (pn >> 3)) * 2; }
};

#define EPI_ROWS_PERM  const int row0 = u.pm * 256 + wr * 64 + fr; const int colt = u.pn * 256 + wc * 32 + 8 * fq;
struct EpiH16 {
    static constexpr bool PERM = true;
    h16* O; int ldc;
    __device__ __forceinline__ void operator()(const f32x4 (&acc)[2][2][4][2], const Unit& u, int wr, int wc, int fr, int fq) const {
        EPI_ROWS_PERM
#pragma unroll
        for (int ai = 0; ai < 2; ++ai)
#pragma unroll
            for (int m = 0; m < 4; ++m) { h16* rowp = O + (size_t)(row0 + ai * 128 + m * 16) * ldc + colt;
#pragma unroll
                for (int bj = 0; bj < 2; ++bj) *(u32x4*)(rowp + bj * 128) = pack8(acc[ai][bj][m][0], acc[ai][bj][m][1]); }
    }
};
struct EpiG1 {
    static constexpr bool PERM = true;
    h16* O;
    __device__ __forceinline__ void operator()(const f32x4 (&acc)[2][2][4][2], const Unit& u, int wr, int wc, int fr, int fq) const {
        EPI_ROWS_PERM
        const int mode = u.pn == 24 ? 1 : (u.pn == 26 ? 2 : 0);
#pragma unroll
        for (int ai = 0; ai < 2; ++ai)
#pragma unroll
            for (int m = 0; m < 4; ++m) { h16* rowp = O + (size_t)(row0 + ai * 128 + m * 16) * LDC1 + colt;
#pragma unroll
                for (int bj = 0; bj < 2; ++bj) { f32x4 v0 = acc[ai][bj][m][0], v1 = acc[ai][bj][m][1];
                    if (mode == 1) {
#pragma unroll
                        for (int j = 0; j < 4; ++j) { v0[j] = 1.0f - 2.0f / (1.0f + __expf(2.0f * v0[j])); v1[j] = 1.0f - 2.0f / (1.0f + __expf(2.0f * v1[j])); } }
                    else if (mode == 2) {
#pragma unroll
                        for (int j = 0; j < 4; ++j) { v0[j] = sigmoidf_(v0[j]); v1[j] = sigmoidf_(v1[j]); } }
                    *(u32x4*)(rowp + bj * 128) = pack8(v0, v1); } }
    }
};
template <int GI_> struct EpiG2 {
    static constexpr bool PERM = true;
    h16* DEC; h16* Ab; h16* Gb; h16* C1; const h16* VF; const float* w0; const float* a0; const float* v0; h16* AA; const float* k_k; const float* k_a;
    template <int GI>
    __device__ __forceinline__ void body(const f32x4 (&acc)[2][2][4][2], int row0, int colt) const {
#pragma unroll
        for (int bj = 0; bj < 2; ++bj) {
            const int c = colt + bj * 128;
            f32x4 b0 = (f32x4){0.f, 0.f, 0.f, 0.f}, b1 = b0;
            if (GI == 0) { b0 = *(const f32x4*)(w0 + c); b1 = *(const f32x4*)(w0 + c + 4); }
            else if (GI == 1) { b0 = *(const f32x4*)(a0 + c); b1 = *(const f32x4*)(a0 + c + 4); }
            else if (GI == 3) { b0 = *(const f32x4*)(v0 + c); b1 = *(const f32x4*)(v0 + c + 4); }
#pragma unroll
            for (int ai = 0; ai < 2; ++ai)
#pragma unroll
                for (int m = 0; m < 4; ++m) {
                    const size_t row = (size_t)(row0 + ai * 128 + m * 16);
                    f32x4 x0 = acc[ai][bj][m][0] + b0, x1 = acc[ai][bj][m][1] + b1;
                    if (GI == 0) {
#pragma unroll
                        for (int j = 0; j < 4; ++j) {
                            x0[j] = 0.6065306597126334f * sigmoidf_(x0[j]); x1[j] = 0.6065306597126334f * sigmoidf_(x1[j]); }
                        *(u32x4*)(DEC + row * DM + c) = pack8(x0, x1);
                    } else if (GI == 1) {
#pragma unroll
                        for (int j = 0; j < 4; ++j) { x0[j] = sigmoidf_(x0[j]); x1[j] = sigmoidf_(x1[j]); }
                        *(u32x4*)(Ab + row * DM + c) = pack8(x0, x1);
                    } else if (GI == 2) {
                        *(u32x4*)(Gb + row * DM + c) = pack8(x0, x1);
                    } else {
                        h16* vp = C1 + row * LDC1 + 4096 + c;
                        const h16x8 vv = *(const h16x8*)vp; const h16x8 vf = *(const h16x8*)(VF + row * DM + c);
                        f32x4 o0, o1;
#pragma unroll
                        for (int j = 0; j < 4; ++j) { float v = (float)vv[j], f = (float)vf[j]; o0[j] = v + (f - v) * sigmoidf_(x0[j]); v = (float)vv[4 + j]; f = (float)vf[4 + j]; o1[j] = v + (f - v) * sigmoidf_(x1[j]); }
                        *(u32x4*)vp = pack8(o0, o1);
                    }
                    __builtin_amdgcn_sched_barrier(0);
                }
        }
    }
    __device__ __forceinline__ void body_a(const f32x4 (&acc)[2][2][4][2], int row0, int cb0) const {
#pragma unroll
        for (int ai = 0; ai < 2; ++ai)
#pragma unroll
            for (int m = 0; m < 4; ++m) {
                const size_t row = (size_t)(row0 + ai * 128 + m * 16);
                asm volatile("" ::: "memory");
                float a[2][8], kv[2][8], kk[2][8]; float ss = 0.f;
#pragma unroll
                for (int bj = 0; bj < 2; ++bj) {
                    const int c = cb0 + 32 * bj;
                    const f32x4 b0 = *(const f32x4*)(a0 + c), b1 = *(const f32x4*)(a0 + c + 4), q0 = *(const f32x4*)(k_k + c), q1 = *(const f32x4*)(k_k + c + 4);
                    const h16x8 kh = *(const h16x8*)(C1 + row * LDC1 + 2048 + c);
#pragma unroll
                    for (int e = 0; e < 4; ++e) {
                        a[bj][e] = sigmoidf_(acc[ai][bj][m][0][e] + b0[e]); a[bj][4 + e] = sigmoidf_(acc[ai][bj][m][1][e] + b1[e]);
                        kv[bj][e] = (float)kh[e]; kv[bj][4 + e] = (float)kh[4 + e];
                        kk[bj][e] = kv[bj][e] * q0[e]; kk[bj][4 + e] = kv[bj][4 + e] * q1[e];
                        ss += kk[bj][e] * kk[bj][e] + kk[bj][4 + e] * kk[bj][4 + e];
                    }
                }
                ss += __shfl_xor(ss, 16); ss += __shfl_xor(ss, 32);
                const float inv = 1.0f / fmaxf(sqrtf(ss), 1e-12f);
#pragma unroll
                for (int bj = 0; bj < 2; ++bj) {
                    const int c = cb0 + 32 * bj;
                    const f32x4 p0 = *(const f32x4*)(k_a + c), p1 = *(const f32x4*)(k_a + c + 4);
                    f32x4 ko0, ko1, ao0, ao1, bo0, bo1;
#pragma unroll
                    for (int e = 0; e < 4; ++e) {
                        ko0[e] = kv[bj][e] * (1.0f + (a[bj][e] - 1.0f) * p0[e]); ko1[e] = kv[bj][4 + e] * (1.0f + (a[bj][4 + e] - 1.0f) * p1[e]);
                        const float n0_ = kk[bj][e] * inv, n1_ = kk[bj][4 + e] * inv;
                        ao0[e] = -n0_; ao1[e] = -n1_; bo0[e] = n0_ * a[bj][e]; bo1[e] = n1_ * a[bj][4 + e];
                    }
                    *(u32x4*)(C1 + row * LDC1 + 2048 + c) = pack8(ko0, ko1);
                    *(u32x4*)(AA + row * DM + c) = pack8(ao0, ao1);
                    *(u32x4*)(Ab + row * DM + c) = pack8(bo0, bo1);
                }
                __builtin_amdgcn_sched_barrier(0);
            }
    }
    __device__ __forceinline__ void operator()(const f32x4 (&acc)[2][2][4][2], const Unit& u, int wr, int wc, int fr, int fq) const {
        const int row0 = u.pm * 256 + wr * 64 + fr; const int colt = u.pn * 256 + wc * 32 + 8 * fq;
        if (GI_ == 1) body_a(acc, row0, u.pn * 256 + wc * 64 + 8 * fq);
        else body<GI_>(acc, row0, colt);
    }
};
struct EpiRes {
    static constexpr bool PERM = true;
    const h16* X; h16* PRE;
    __device__ __forceinline__ void operator()(const f32x4 (&acc)[2][2][4][2], const Unit& u, int wr, int wc, int fr, int fq) const {
        EPI_ROWS_PERM
#pragma unroll
        for (int ai = 0; ai < 2; ++ai)
#pragma unroll
            for (int m = 0; m < 4; ++m) { const size_t off = (size_t)(row0 + ai * 128 + m * 16) * DM + colt;
#pragma unroll
                for (int bj = 0; bj < 2; ++bj) {
                    const h16x8 x = *(const h16x8*)(X + off + bj * 128);
                    f32x4 o0, o1;
#pragma unroll
                    for (int e = 0; e < 4; ++e) { o0[e] = (float)x[e] * ALPHA + acc[ai][bj][m][0][e]; o1[e] = (float)x[4 + e] * ALPHA + acc[ai][bj][m][1][e]; }
                    *(u32x4*)(PRE + off + bj * 128) = pack8(o0, o1); } }
    }
};
__device__ __forceinline__ float gelu_mul(float u, float gc) {
    const float t = gc * gc;
    const float z = gc * (t * (0.044715f * 1.5957691216057308f * LOG2E) + 1.5957691216057308f * LOG2E);
    return u * gc * __builtin_amdgcn_rcpf(1.0f + __builtin_amdgcn_exp2f(-z));
}
struct EpiUpConv {
    static constexpr bool PERM = true;
    h16* ACT; h16* SIDE; const float* cw; const float* cb;
    __device__ __forceinline__ void operator()(const f32x4 (&acc)[2][2][4][2], const Unit& u, int wr, int wc, int fr, int fq) const {
        const int row0 = u.pm * 256 + wr * 64 + fr, f0 = u.pn * 128 + wc * 32 + 8 * fq;
        f32x4 w0[2], w1[2], w2[2], bb[2];
#pragma unroll
        for (int n = 0; n < 2; ++n) { w0[n] = *(const f32x4*)(cw + f0 + 4 * n); w1[n] = *(const f32x4*)(cw + FF + f0 + 4 * n); w2[n] = *(const f32x4*)(cw + 2 * FF + f0 + 4 * n); bb[n] = *(const f32x4*)(cb + f0 + 4 * n); }
#pragma unroll
        for (int ai = 0; ai < 2; ++ai) {
            f32x4 p1[2], p2[2];
#pragma unroll
            for (int n = 0; n < 2; ++n) { p1[n] = (f32x4){0.f, 0.f, 0.f, 0.f}; p2[n] = p1[n]; }
#pragma unroll
            for (int m = 0; m < 4; ++m) {
                const int row = row0 + ai * 128 + m * 16;
                f32x4 r1[2], r2[2], o[2];
#pragma unroll
                for (int n = 0; n < 2; ++n)
#pragma unroll
                    for (int e = 0; e < 4; ++e) {
                        const float g = acc[ai][1][m][n][e];
                        r1[n][e] = dpp_f<0x121>(g); r2[n][e] = dpp_f<0x122>(g);
                        const float g1 = fr >= 1 ? r1[n][e] : p1[n][e], g2 = fr >= 2 ? r2[n][e] : p2[n][e];
                        const float gc = bb[n][e] + g2 * w0[n][e] + g1 * w1[n][e] + g * w2[n][e];
                        o[n][e] = gelu_mul(acc[ai][0][m][n][e], gc);
                    }
                if (m > 0 || fr >= 2) *(u32x4*)(ACT + (size_t)row * FF + f0) = pack8(o[0], o[1]);
                if (m == 0 && fr < 2) { h16* sp = SIDE + ((size_t)(row >> 6) * 4 + 2 + fr) * (2 * FF) + f0;
                    *(u32x4*)sp = pack8(acc[ai][0][m][0], acc[ai][0][m][1]); *(u32x4*)(sp + FF) = pack8(acc[ai][1][m][0], acc[ai][1][m][1]); }
                if (m == 3 && fr >= 14) { h16* sp = SIDE + ((size_t)(row >> 6) * 4 + (fr - 14)) * (2 * FF) + FF + f0;
                    *(u32x4*)sp = pack8(acc[ai][1][m][0], acc[ai][1][m][1]); }
#pragma unroll
                for (int n = 0; n < 2; ++n) { p1[n] = r1[n]; p2[n] = r2[n]; }
            }
        }
    }
};
__device__ __forceinline__ void convfix_phase(const h16* SIDE, h16* ACT, const float* cw, const float* cb) {
    constexpr int NCG = FF / 8, NT = 256 * 2 * NCG;
    for (int task = obid() * 512 + otid(); task < NT; task += gridDim.x * 512) {
        const int cgi = task % NCG, j = (task / NCG) & 1, gidx = task / (2 * NCG), f = cgi * 8;
        const bool first = (gidx & 127) == 0;
        const h16* cur = SIDE + ((size_t)gidx * 4 + 2 + j) * (2 * FF) + f;
        const h16x8 uh = *(const h16x8*)cur, g0h = *(const h16x8*)(cur + FF);
        h16x8 g1h = {}, g2h = {};
        if (j == 0) { if (!first) { g1h = *(const h16x8*)(SIDE + ((size_t)(gidx - 1) * 4 + 1) * (2 * FF) + FF + f); g2h = *(const h16x8*)(SIDE + ((size_t)(gidx - 1) * 4 + 0) * (2 * FF) + FF + f); } }
        else { g1h = *(const h16x8*)(SIDE + ((size_t)gidx * 4 + 2) * (2 * FF) + FF + f); if (!first) g2h = *(const h16x8*)(SIDE + ((size_t)(gidx - 1) * 4 + 1) * (2 * FF) + FF + f); }
        h16x8 o;
#pragma unroll
        for (int e = 0; e < 8; ++e) {
            const float gc = cb[f + e] + (float)g2h[e] * cw[f + e] + (float)g1h[e] * cw[FF + f + e] + (float)g0h[e] * cw[2 * FF + f + e];
            o[e] = (h16)gelu_mul((float)uh[e], gc);
        }
        *(h16x8*)(ACT + ((size_t)gidx * 64 + j) * FF + f) = o;
    }
}
struct EpiQKV {
    static constexpr bool PERM = true;
    h16* Qb; h16* Kb; h16* Vt;
    __device__ __forceinline__ void operator()(const f32x4 (&acc)[2][2][4][2], const Unit& u, int wr, int wc, int fr, int fq) const {
        const int row0 = u.pm * 256 + wr * 64 + fr; const int part = u.pn >> 3; const int colt = (u.pn & 7) * 256 + wc * 32 + 8 * fq;
#pragma unroll
        for (int ai = 0; ai < 2; ++ai)
#pragma unroll
            for (int m = 0; m < 4; ++m) { const int row = row0 + ai * 128 + m * 16;
#pragma unroll
                for (int bj = 0; bj < 2; ++bj) { const int c = colt + bj * 128;
                    if (part == 0) *(u32x4*)(Qb + (size_t)row * DM + c) = pack8(acc[ai][bj][m][0] * QSCALE, acc[ai][bj][m][1] * QSCALE);
                    else if (part == 1) *(u32x4*)(Kb + (size_t)row * DM + c) = pack8(acc[ai][bj][m][0], acc[ai][bj][m][1]);
                    else {
                        const int b = row >> 13, t = row & 8191, hd = c >> 8, dv = c & 255;
                        const int pos = (t & ~12) | ((t & 4) << 1) | ((t & 8) >> 1);
                        h16* vp = Vt + ((size_t)((b * 8 + hd) * 256 + dv)) * SEQ + pos;
#pragma unroll
                        for (int j = 0; j < 4; ++j) { vp[(size_t)j * SEQ] = (h16)acc[ai][bj][m][0][j]; vp[(size_t)(4 + j) * SEQ] = (h16)acc[ai][bj][m][1][j]; }
                    } } }
    }
};

__device__ __forceinline__ void cvt_job(LAS unsigned char* lds, const float* src, int Ks, int Ns, h16* dst, int Kd, int Nd, int remap = 0) {
    LAS h16* tile = (LAS h16*)lds;
    const int tid = otid(), tk = Kd >> 6, tn = Nd >> 6;
    for (int t = obid(); t < tk * tn; t += gridDim.x) {
        const int k0 = (t % tk) * 64, n0 = (t / tk) * 64;
#pragma unroll
        for (int i = 0; i < 2; ++i) {
            const int idx = tid + 512 * i, kr = idx >> 4, nc = (idx & 15) * 4, k = k0 + kr, n = n0 + nc;
            f32x4 v = (f32x4){0.f, 0.f, 0.f, 0.f};
            if (k < Ks && n < Ns) v = *(const f32x4*)(src + (size_t)k * Ns + n);
            tile[kr * 66 + nc + 0] = (h16)v[0]; tile[kr * 66 + nc + 1] = (h16)v[1]; tile[kr * 66 + nc + 2] = (h16)v[2]; tile[kr * 66 + nc + 3] = (h16)v[3];
        }
        __syncthreads();
        { const int n = tid >> 3, kg = tid & 7; h16x8 o;
#pragma unroll
          for (int e = 0; e < 8; ++e) o[e] = tile[(kg * 8 + e) * 66 + n];
          const int no = n0 + n;
          const int nd = remap == 0 ? no : (remap == 1 ? (no < FF ? (no >> 7) * 256 + (no & 127) : ((no - FF) >> 7) * 256 + 128 + ((no - FF) & 127))
                                                      : ((no & ~255) | ((no & 32) << 2) | ((no & 192) >> 1) | (no & 31)));
          *(h16x8*)(dst + (size_t)nd * Kd + k0 + kg * 8) = o; }
        __syncthreads();
    }
}
__device__ __forceinline__ void cvt_layer(LAS unsigned char* lds, const Params& p, int layer) {
    h16* W = (h16*)(p.ws + WS_W16);
    const int j = layer >> 1;
    if ((layer & 1) == 0) {
        h16* B1 = (h16*)((char*)W + W_B1); h16* B2 = (h16*)((char*)W + W_B2);
        for (int i = 0; i < 3; ++i) cvt_job(lds, p.in[4] + ((size_t)j * 3 + i) * DM * DM, DM, DM, B1 + (size_t)i * DM * DM, DM, DM);
        cvt_job(lds, p.in[6] + (size_t)j * DM * 96, DM, 96, B1 + (size_t)6144 * DM, DM, 256);
        cvt_job(lds, p.in[9] + (size_t)j * DM * 96, DM, 96, B1 + (size_t)6400 * DM, DM, 256);
        cvt_job(lds, p.in[14] + (size_t)j * DM * 128, DM, 128, B1 + (size_t)6656 * DM, DM, 256);
        cvt_job(lds, p.in[7] + (size_t)j * 96 * DM, 96, DM, B2, 256, DM);
        cvt_job(lds, p.in[10] + (size_t)j * 96 * DM, 96, DM, B2 + (size_t)2048 * 256, 256, DM, 2);
        cvt_job(lds, p.in[15] + (size_t)j * 128 * DM, 128, DM, B2 + (size_t)4096 * 256, 256, DM);
        if (j > 0) {
            cvt_job(lds, p.in[12] + (size_t)(j - 1) * DM * 64, DM, 64, B1 + (size_t)6912 * DM, DM, 256);
            cvt_job(lds, p.in[13] + (size_t)(j - 1) * 64 * DM, 64, DM, B2 + (size_t)6144 * 256, 256, DM);
        }
        cvt_job(lds, p.in[21] + (size_t)j * DM * DM, DM, DM, (h16*)((char*)W + W_WO), DM, DM);
    } else {
        cvt_job(lds, p.in[22] + (size_t)j * DM * 6144, DM, 6144, (h16*)((char*)W + W_B1), DM, 6144);
        cvt_job(lds, p.in[25] + (size_t)j * DM * DM, DM, DM, (h16*)((char*)W + W_WO), DM, DM);
    }
    cvt_job(lds, p.in[27] + (size_t)layer * DM * 2 * FF, DM, 2 * FF, (h16*)((char*)W + W_UP), DM, 2 * FF, 1);
    cvt_job(lds, p.in[30] + (size_t)layer * FF * DM, FF, DM, (h16*)((char*)W + W_DN), FF, DM);
}

template <bool LN>
__device__ __forceinline__ void ln_row(const void* src, size_t row, int lane, const float* g, const float* bt, f32x4 (&v)[8]) {
    if (LN) {
        const h16x4* sp = (const h16x4*)((const h16*)src + row * DM);
#pragma unroll
        for (int i = 0; i < 8; ++i) { const h16x4 t = sp[i * 64 + lane]; v[i] = (f32x4){(float)t[0], (float)t[1], (float)t[2], (float)t[3]}; }
        float s = 0.f;
#pragma unroll
        for (int i = 0; i < 8; ++i) s += (v[i][0] + v[i][1]) + (v[i][2] + v[i][3]);
        const float mean = wave_sum(s) * (1.0f / DM);
        float q = 0.f;
#pragma unroll
        for (int i = 0; i < 8; ++i) { v[i] = v[i] - mean; q += (v[i][0] * v[i][0] + v[i][1] * v[i][1]) + (v[i][2] * v[i][2] + v[i][3] * v[i][3]); }
        const float rstd = rsqrtf(wave_sum(q) * (1.0f / DM) + 1e-5f);
#pragma unroll
        for (int i = 0; i < 8; ++i) { const f32x4 gg = ((const f32x4*)g)[i * 64 + lane], bb = ((const f32x4*)bt)[i * 64 + lane]; v[i] = v[i] * rstd * gg + bb; }
    } else {
        const f32x4* sp = (const f32x4*)((const float*)src + row * DM);
#pragma unroll
        for (int i = 0; i < 8; ++i) v[i] = sp[i * 64 + lane];
    }
}
__device__ __forceinline__ void ln_load16(const void* src, size_t row, int lane, h16x4 (&t)[8]) {
    const h16x4* sp = (const h16x4*)((const h16*)src + row * DM);
#pragma unroll
    for (int i = 0; i < 8; ++i) t[i] = sp[i * 64 + lane];
}
__device__ __forceinline__ void ln_apply16(const h16x4 (&t)[8], int lane, const float* g, const float* bt, f32x4 (&v)[8]) {
#pragma unroll
    for (int i = 0; i < 8; ++i) v[i] = (f32x4){(float)t[i][0], (float)t[i][1], (float)t[i][2], (float)t[i][3]};
    float s = 0.f;
#pragma unroll
    for (int i = 0; i < 8; ++i) s += (v[i][0] + v[i][1]) + (v[i][2] + v[i][3]);
    const float mean = wave_sum(s) * (1.0f / DM);
    float q = 0.f;
#pragma unroll
    for (int i = 0; i < 8; ++i) { v[i] = v[i] - mean; q += (v[i][0] * v[i][0] + v[i][1] * v[i][1]) + (v[i][2] * v[i][2] + v[i][3] * v[i][3]); }
    const float rstd = rsqrtf(wave_sum(q) * (1.0f / DM) + 1e-5f);
#pragma unroll
    for (int i = 0; i < 8; ++i) { const f32x4 gg = ((const f32x4*)g)[i * 64 + lane], bb = ((const f32x4*)bt)[i * 64 + lane]; v[i] = v[i] * rstd * gg + bb; }
}
template <bool LN>
__device__ __forceinline__ void ln_phase(const void* src, const float* g, const float* bt, float* xout, h16* xh, const float* mu, h16* mix) {
    const int lane = otid() & 63, gw = obid() * 8 + (otid() >> 6), GW = gridDim.x * 8;
    for (int ch = gw; ch < MTOK / 8; ch += GW) {
        const size_t t0 = (size_t)ch * 8;
        f32x4 prev[8], cur[8];
        if (mix) {
            if ((t0 & (SEQ - 1)) == 0) {
#pragma unroll
                for (int i = 0; i < 8; ++i) prev[i] = (f32x4){0.f, 0.f, 0.f, 0.f};
            } else ln_row<LN>(src, t0 - 1, lane, g, bt, prev);
        }
        h16x4 raw[8], rawn[8];
        if (LN) ln_load16(src, t0, lane, raw);
#pragma unroll 1
        for (int r = 0; r < 8; ++r) {
            const size_t row = t0 + r;
            asm volatile("" ::: "memory");
            if (LN) {
                ln_load16(src, t0 + (r < 7 ? r + 1 : 7), lane, rawn);
                ln_apply16(raw, lane, g, bt, cur);
#pragma unroll
                for (int i = 0; i < 8; ++i) raw[i] = rawn[i];
            } else ln_row<LN>(src, row, lane, g, bt, cur);
            if (xout) {
#pragma unroll
                for (int i = 0; i < 8; ++i) ((f32x4*)(xout + row * DM))[i * 64 + lane] = cur[i];
            }
            if (xh) {
#pragma unroll
                for (int i = 0; i < 8; ++i) { h16x4 o = {(h16)cur[i][0], (h16)cur[i][1], (h16)cur[i][2], (h16)cur[i][3]}; ((h16x4*)(xh + row * DM))[i * 64 + lane] = o; }
            }
            if (mix) {
#pragma unroll
                for (int i = 0; i < 8; ++i) {
                    asm volatile("" ::: "memory");
                    const f32x4 xx = prev[i] - cur[i];
#pragma unroll
                    for (int k = 0; k < 6; ++k) {
                        const f32x4 m4 = ((const f32x4*)(mu + (size_t)k * DM))[i * 64 + lane];
                        const f32x4 o4 = cur[i] + xx * m4;
                        h16x4 o = {(h16)o4[0], (h16)o4[1], (h16)o4[2], (h16)o4[3]};
                        ((h16x4*)(mix + ((size_t)k * MTOK + row) * DM))[i * 64 + lane] = o;
                    }
                    prev[i] = cur[i];
                }
            }
        }
    }
}

__device__ __forceinline__ void prep_phase(h16* C1, h16* Ab, h16* AA, h16* VF, const float* k_k, const float* k_a, bool first) {
    const int lane = otid() & 63, gw = obid() * 8 + (otid() >> 6), GW = gridDim.x * 8;
    for (int row = gw; row < MTOK; row += GW) {
#pragma unroll
        for (int i = 0; i < 8; ++i) {
            const int c = i * 256 + lane * 4;
            h16x4* kp = (h16x4*)(C1 + (size_t)row * LDC1 + 2048 + c);
            h16x4* ap = (h16x4*)(Ab + (size_t)row * DM + c);
            const h16x4 kh = *kp, ah = *ap;
            const f32x4 kkw = *(const f32x4*)(k_k + c), kaw = *(const f32x4*)(k_a + c);
            f32x4 k, a, kk;
#pragma unroll
            for (int e = 0; e < 4; ++e) { k[e] = (float)kh[e]; a[e] = (float)ah[e]; kk[e] = k[e] * kkw[e]; }
            float ss = (kk[0] * kk[0] + kk[1] * kk[1]) + (kk[2] * kk[2] + kk[3] * kk[3]);
            ss = grp16_sum(ss);
            const float inv = 1.0f / fmaxf(sqrtf(ss), 1e-12f);
            h16x4 ko, aao, bbo;
#pragma unroll
            for (int e = 0; e < 4; ++e) { const float kn = kk[e] * inv; ko[e] = (h16)(k[e] * (1.0f + (a[e] - 1.0f) * kaw[e])); aao[e] = (h16)(-kn); bbo[e] = (h16)(kn * a[e]); }
            *kp = ko; *ap = bbo; *(h16x4*)(AA + (size_t)row * DM + c) = aao;
            if (first) *(h16x4*)(VF + (size_t)row * DM + c) = *(const h16x4*)(C1 + (size_t)row * LDC1 + 4096 + c);
        }
    }
}

__device__ __forceinline__ void scan_phase(LAS unsigned char* lds, const h16* C1, const h16* DEC, const h16* AA, const h16* BB, float* Y) {
    constexpr int CH = 32, NCH = SEQ / CH, BUF = 18976;
    LAS float* L = (LAS float*)lds;
    const int tid = otid(), wid = tid >> 6, lane = tid & 63;
    for (int item = obid(); item < 256; item += gridDim.x) {
        const int b = item >> 7, h = (item >> 2) & 31, q = item & 3;
        const size_t row0 = (size_t)b * SEQ;
        __syncthreads();
        if (wid >= 4) {
            const int lt = tid - 256, s = lt >> 3, e8 = lt & 7;
            struct StReg { h16x8 r8, k8, a8, b8, v8, d8; };
            auto gload = [&](int c) -> StReg {
                StReg R;
                const size_t row = row0 + (size_t)c * CH + s;
                R.r8 = *(const h16x8*)(C1 + row * LDC1 + h * 64 + e8 * 8);
                R.k8 = *(const h16x8*)(C1 + row * LDC1 + 2048 + h * 64 + e8 * 8);
                { const int tn = c * CH + s + 1; const size_t rown = row0 + (size_t)(tn < SEQ ? tn : SEQ - 1);
                  R.a8 = *(const h16x8*)(AA + rown * DM + h * 64 + e8 * 8); }
                R.b8 = *(const h16x8*)(BB + row * DM + h * 64 + e8 * 8);
                R.d8 = *(const h16x8*)(DEC + row * DM + h * 64 + e8 * 8);
                R.v8 = (h16x8){};
                if (lt < 64) R.v8 = *(const h16x8*)(C1 + (row0 + (size_t)c * CH + (lt >> 1)) * LDC1 + 4096 + h * 64 + q * 16 + (lt & 1) * 8);
                return R;
            };
            auto lwrite = [&](const StReg& R, int bufi) {
                LAS float* Bf = L + bufi * BUF;
                LAS float* dst = Bf + s * 64 + e8 * 8;
                *(LAS f32x4*)(dst + 0 * 2048) = (f32x4){(float)R.r8[0], (float)R.r8[1], (float)R.r8[2], (float)R.r8[3]}; *(LAS f32x4*)(dst + 0 * 2048 + 4) = (f32x4){(float)R.r8[4], (float)R.r8[5], (float)R.r8[6], (float)R.r8[7]};
                *(LAS f32x4*)(dst + 1 * 2048) = (f32x4){__expf(-(float)R.d8[0]), __expf(-(float)R.d8[1]), __expf(-(float)R.d8[2]), __expf(-(float)R.d8[3])};
                *(LAS f32x4*)(dst + 1 * 2048 + 4) = (f32x4){__expf(-(float)R.d8[4]), __expf(-(float)R.d8[5]), __expf(-(float)R.d8[6]), __expf(-(float)R.d8[7])};
                *(LAS f32x4*)(dst + 2 * 2048) = (f32x4){(float)R.k8[0], (float)R.k8[1], (float)R.k8[2], (float)R.k8[3]}; *(LAS f32x4*)(dst + 2 * 2048 + 4) = (f32x4){(float)R.k8[4], (float)R.k8[5], (float)R.k8[6], (float)R.k8[7]};
                *(LAS f32x4*)(dst + 3 * 2048) = (f32x4){(float)R.a8[0], (float)R.a8[1], (float)R.a8[2], (float)R.a8[3]}; *(LAS f32x4*)(dst + 3 * 2048 + 4) = (f32x4){(float)R.a8[4], (float)R.a8[5], (float)R.a8[6], (float)R.a8[7]};
                *(LAS f32x4*)(dst + 4 * 2048) = (f32x4){(float)R.b8[0], (float)R.b8[1], (float)R.b8[2], (float)R.b8[3]}; *(LAS f32x4*)(dst + 4 * 2048 + 4) = (f32x4){(float)R.b8[4], (float)R.b8[5], (float)R.b8[6], (float)R.b8[7]};
                { float cp = 0.f;
#pragma unroll
                  for (int e = 0; e < 8; ++e) cp += (float)R.b8[e] * (float)R.a8[e];
                  cp += __shfl_xor(cp, 1); cp += __shfl_xor(cp, 2); cp += __shfl_xor(cp, 4);
                  if (e8 == 0) Bf[18944 + s] = cp; }
                if (lt < 64) { LAS float* vd = Bf + 10240 + (lt >> 1) * 16 + (lt & 1) * 8;
                    *(LAS f32x4*)vd = (f32x4){(float)R.v8[0], (float)R.v8[1], (float)R.v8[2], (float)R.v8[3]}; *(LAS f32x4*)(vd + 4) = (f32x4){(float)R.v8[4], (float)R.v8[5], (float)R.v8[6], (float)R.v8[7]}; }
            };
            auto yout = [&](int c, int bufi) {
#pragma unroll
                for (int o2 = 0; o2 < 2; ++o2) {
                    const int o = lt + 256 * o2, ys = o >> 4, yr = o & 15;
                    LAS float* yp = L + bufi * BUF + 10752 + o * 16;
                    f32x4 acc4 = *(LAS f32x4*)(yp + (((0 + (o >> 2)) & 3) << 2));
#pragma unroll
                    for (int i = 1; i < 4; ++i) acc4 += *(LAS f32x4*)(yp + (((i + (o >> 2)) & 3) << 2));
                    Y[(row0 + (size_t)c * CH + ys) * DM + h * 64 + q * 16 + yr] = (acc4[0] + acc4[1]) + (acc4[2] + acc4[3]);
                }
            };
            { const StReg R0 = gload(0); lwrite(R0, 0); }
            StReg RA = gload(1);
            __syncthreads();
            for (int c = 0; c < NCH; ++c) {
                StReg RB = RA;
                if (c + 2 < NCH) RB = gload(c + 2);
                if (c + 1 < NCH) lwrite(RA, (c + 1) & 1);
                if (c > 0) yout(c - 1, (c - 1) & 1);
                __syncthreads();
                RA = RB;
            }
            yout(NCH - 1, (NCH - 1) & 1);
        } else {
            const int jg = lane & 15, rl = wid * 4 + (lane >> 4);
            f32x2 Sa = (f32x2){0.f, 0.f}, Sb = (f32x2){0.f, 0.f};
            float sa = 0.f;
            __syncthreads();
            for (int c = 0; c < NCH; ++c) {
                LAS float* Bf = L + (c & 1) * BUF;
                LAS float* vec = Bf + jg * 4;
                f32x4 r4 = *(LAS f32x4*)(vec + 0 * 2048), w4 = *(LAS f32x4*)(vec + 1 * 2048), k4 = *(LAS f32x4*)(vec + 2 * 2048), a4 = *(LAS f32x4*)(vec + 3 * 2048), b4 = *(LAS f32x4*)(vec + 4 * 2048);
                float v = Bf[10240 + rl], cn = Bf[18944];
#pragma unroll 1
                for (int s0 = 0; s0 < CH; s0 += 8) {
                    float yv[8];
#pragma unroll
                    for (int u = 0; u < 8; ++u) {
                        const int s = s0 + u, sn = (s + 1 < CH) ? s + 1 : CH - 1;
                        const f32x4 r4n = *(LAS f32x4*)(vec + 0 * 2048 + sn * 64), w4n = *(LAS f32x4*)(vec + 1 * 2048 + sn * 64), k4n = *(LAS f32x4*)(vec + 2 * 2048 + sn * 64),
                                    a4n = *(LAS f32x4*)(vec + 3 * 2048 + sn * 64), b4n = *(LAS f32x4*)(vec + 4 * 2048 + sn * 64);
                        const float vn = Bf[10240 + sn * 16 + rl], cnn = Bf[18944 + sn];
                        const f32x2 aL = {a4[0], a4[1]}, aH = {a4[2], a4[3]}, wL = {w4[0], w4[1]}, wH = {w4[2], w4[3]}, kL = {k4[0], k4[1]}, kH = {k4[2], k4[3]},
                                    bL = {b4[0], b4[1]}, bH = {b4[2], b4[3]}, rL = {r4[0], r4[1]}, rH = {r4[2], r4[3]};
                        const f32x2 uL = Sa * wL + kL * v, uH = Sb * wH + kH * v;
                        const f32x2 dz = uL * aL + uH * aH;
                        const float z = row16_sum(dz[0] + dz[1]);
                        Sa = bL * sa + uL; Sb = bH * sa + uH;
                        const f32x2 dr = Sa * rL + Sb * rH;
                        yv[u] = dr[0] + dr[1];
                        sa = z + cn * sa;
                        r4 = r4n; w4 = w4n; k4 = k4n; a4 = a4n; b4 = b4n; v = vn; cn = cnn;
                    }
#pragma unroll
                    for (int u = 0; u < 8; ++u) Bf[10752 + ((s0 + u) * 16 + rl) * 16 + jg] = yv[u];
                }
                __syncthreads();
            }
        }
    }
}

__device__ __forceinline__ void gn_phase(const float* Y, const h16* C1, const h16* Gb, h16* YG, const float* r_k, const float* lnx_g, const float* lnx_b, h16* VFw) {
    const int lane = otid() & 63, gw = obid() * 8 + (otid() >> 6), GW = gridDim.x * 8;
    for (int row = gw; row < MTOK; row += GW) {
#pragma unroll
        for (int i = 0; i < 8; ++i) {
            const int c = i * 256 + lane * 4;
            const f32x4 y = *(const f32x4*)(Y + (size_t)row * DM + c);
            const h16x4 rh = *(const h16x4*)(C1 + (size_t)row * LDC1 + c), kh = *(const h16x4*)(C1 + (size_t)row * LDC1 + 2048 + c), vh = *(const h16x4*)(C1 + (size_t)row * LDC1 + 4096 + c);
            const h16x4 gh = *(const h16x4*)(Gb + (size_t)row * DM + c);
            const f32x4 rk = *(const f32x4*)(r_k + c), lg = *(const f32x4*)(lnx_g + c), lb = *(const f32x4*)(lnx_b + c);
            float s = (y[0] + y[1]) + (y[2] + y[3]);
            const float mean = grp16_sum(s) * (1.0f / 64.0f);
            const f32x4 d = y - mean;
            float qv = (d[0] * d[0] + d[1] * d[1]) + (d[2] * d[2] + d[3] * d[3]);
            const float rstd = rsqrtf(grp16_sum(qv) * (1.0f / 64.0f) + 64e-5f);
            float bs = 0.f;
#pragma unroll
            for (int e = 0; e < 4; ++e) bs += (float)rh[e] * (float)kh[e] * rk[e];
            bs = grp16_sum(bs);
            h16x4 o;
#pragma unroll
            for (int e = 0; e < 4; ++e) o[e] = (h16)((d[e] * rstd * lg[e] + lb[e] + bs * (float)vh[e]) * (float)gh[e]);
            *(h16x4*)(YG + (size_t)row * DM + c) = o;
            if (VFw) *(h16x4*)(VFw + (size_t)row * DM + c) = vh;
        }
    }
}

__device__ __forceinline__ void convglu_phase(const h16* U, h16* ACT, const float* cw, const float* cb) {
    constexpr int NCG = FF / 8, RC = 16, NT = (MTOK / RC) * NCG;
    for (int task = obid() * 512 + otid(); task < NT; task += gridDim.x * 512) {
        const int cgi = task % NCG, rc = task / NCG, f = cgi * 8, m0 = rc * RC;
        float w0[8], w1[8], w2[8], bb[8], g1[8], g2[8];
#pragma unroll
        for (int e = 0; e < 8; ++e) { w0[e] = cw[f + e]; w1[e] = cw[FF + f + e]; w2[e] = cw[2 * FF + f + e]; bb[e] = cb[f + e]; g1[e] = 0.f; g2[e] = 0.f; }
        if ((m0 & (SEQ - 1)) != 0) {
            const h16x8 a = *(const h16x8*)(U + (size_t)(m0 - 1) * (2 * FF) + FF + f), c2 = *(const h16x8*)(U + (size_t)(m0 - 2) * (2 * FF) + FF + f);
#pragma unroll
            for (int e = 0; e < 8; ++e) { g1[e] = (float)a[e]; g2[e] = (float)c2[e]; }
        }
        for (int r = 0; r < RC; ++r) {
            const size_t m = (size_t)(m0 + r);
            const h16x8 uh = *(const h16x8*)(U + m * (2 * FF) + f), gh = *(const h16x8*)(U + m * (2 * FF) + FF + f);
            h16x8 o;
#pragma unroll
            for (int e = 0; e < 8; ++e) {
                const float g0 = (float)gh[e];
                const float gc = bb[e] + g2[e] * w0[e] + g1[e] * w1[e] + g0 * w2[e];
                const float z = 1.5957691216057308f * (gc + 0.044715f * gc * gc * gc);
                const float ge = gc / (1.0f + __expf(-z));
                o[e] = (h16)((float)uh[e] * ge);
                g2[e] = g1[e]; g1[e] = g0;
            }
            *(h16x8*)(ACT + m * FF + f) = o;
        }
    }
}

__device__ __forceinline__ void attn_phase(LAS unsigned char* lds, const h16* Qb, const h16* Kb, const h16* Vt, h16* AO, const float* rel_bias, const float* lam, const float* subg, float lambda_init) {
    const int wid = __builtin_amdgcn_readfirstlane(otid() >> 6), rg = wid & 3, mp = wid >> 2;
    LAS float* lut = (LAS float*)(lds + 131072);
    LAS float* osh = (LAS float*)lds;
    for (int vc = obid(); vc < 256; vc += gridDim.x) {
        const int bh = vc & 15, jj = vc >> 4, b = bh >> 3, h = bh & 7;
        for (int it = 0; it < 4; ++it) {
            const int qb = it == 0 ? 63 - jj : (it == 1 ? 32 + jj : (it == 2 ? 31 - jj : jj));
            __syncthreads();
            const int tid = otid(), lane = tid & 63, l32 = lane & 31, hh = lane >> 5;
            const int xk = l32 & 15, yv = (l32 >> 2) & 3;
            if (tid <= 128) {
                const float* rbp_ = rel_bias; asm volatile("" : "+s"(rbp_)); const GAS float* rbp = (const GAS float*)rbp_;
                float val = 0.f;
                if (tid < 128) { int bk = tid; if (tid >= 16) { bk = 16 + (int)(__logf((float)tid * (1.0f / 16.0f)) / 2.0794415416798357f * 16.0f); bk = bk > 31 ? 31 : bk; }
                    val = (rbp[bk * 8 + h] - rbp[31 * 8 + h]) * LOG2E; }
                lut[tid] = val;
            }
            const int q0 = qb * 128, qrow = q0 + 32 * rg + l32;
            const size_t tokbase = (size_t)b * SEQ;
            LAS unsigned char* qs = lds + 65536 + wid * 8192 + lane * 16;
            { const h16* qp = Qb + (tokbase + qrow) * DM + h * 256 + mp * 128 + hh * 8;
              h16x8 qf[8];
#pragma unroll
              for (int k = 0; k < 8; ++k) qf[k] = *(const h16x8*)(qp + k * 16);
#pragma unroll
              for (int k = 0; k < 8; ++k) *(LAS h16x8*)(qs + k * 1024) = qf[k]; }
            f32x16 O[8];
#pragma unroll
            for (int i = 0; i < 8; ++i)
#pragma unroll
                for (int r = 0; r < 16; ++r) O[i][r] = 0.f;
            float mrun = -1e30f, lrun = 0.f;
            const int nks = 4 * qb + 4;
            const int kkey = wid * 2 + (lane >> 5);
            const h16* kg = Kb + (tokbase + kkey) * DM + h * 256 + (((lane & 31) ^ (kkey & 15)) << 3);
            const int vdv = wid * 16 + (lane >> 2);
            const h16* vg = Vt + ((size_t)((b * 8 + h) * 256) + vdv) * SEQ + (((lane & 3) ^ ((lane >> 4) & 3)) << 3);
#define ATT_ISSUE(KS, BUF) do { _Pragma("unroll") for (int _i = 0; _i < 2; ++_i) \
                __builtin_amdgcn_global_load_lds((const unsigned*)(kg + (size_t)(32 * (KS) + 16 * _i) * DM), (LAS unsigned*)((BUF) + (_i * 8 + wid) * 1024), 16, 0, 0); \
              _Pragma("unroll") for (int _i = 0; _i < 2; ++_i) \
                __builtin_amdgcn_global_load_lds((const unsigned*)(vg + (size_t)(128 * _i) * SEQ + 32 * (KS)), (LAS unsigned*)((BUF) + 16384 + (_i * 8 + wid) * 1024), 16, 0, 0); } while (0)
#define ATT_SCHED __builtin_amdgcn_sched_barrier(0)
            ATT_ISSUE(0, lds);
            asm volatile("s_waitcnt vmcnt(0)" ::: "memory");
            __syncthreads();
            for (int ks = 0; ks < nks; ++ks) {
                LAS unsigned char* cb = lds + (ks & 1) * 32768; LAS unsigned char* nb = lds + ((ks & 1) ^ 1) * 32768;
                if (ks + 1 < nks) ATT_ISSUE(ks + 1, nb);
                if (ks <= 4 * qb + rg) {
                    const bool near = ks >= 4 * qb - 4;
                    LAS unsigned char* kp_ = cb + l32 * 512 + mp * 256;
                    LAS unsigned char* vp_ = cb + 16384 + l32 * 64;
                    const int vo0 = ((0 + hh) ^ yv) << 4, vo1 = ((2 + hh) ^ yv) << 4;
                    h16x8 A0[4], A1[4];
#define LDQK(A, G) do { A[0] = *(LAS h16x8*)(kp_ + (((4 * (G) + hh) ^ xk) << 4)); A[1] = *(LAS h16x8*)(qs + (2 * (G)) * 1024); \
                        A[2] = *(LAS h16x8*)(kp_ + (((4 * (G) + 2 + hh) ^ xk) << 4)); A[3] = *(LAS h16x8*)(qs + (2 * (G) + 1) * 1024); } while (0)
#define LDV(A, D0, VO) do { _Pragma("unroll") for (int _d = 0; _d < 4; ++_d) A[_d] = *(LAS h16x8*)(vp_ + ((D0) + _d) * 2048 + (VO)); } while (0)
#define MMQK(A) do { S0 = __builtin_amdgcn_mfma_f32_32x32x16_f16(A[0], A[1], S0, 0, 0, 0); S0 = __builtin_amdgcn_mfma_f32_32x32x16_f16(A[2], A[3], S0, 0, 0, 0); } while (0)
#define MMV(A, D0, P) do { _Pragma("unroll") for (int _d = 0; _d < 4; ++_d) O[(D0) + _d] = __builtin_amdgcn_mfma_f32_32x32x16_f16(A[_d], P, O[(D0) + _d], 0, 0, 0); } while (0)
                    f32x16 S0;
#pragma unroll
                    for (int r = 0; r < 16; ++r) S0[r] = 0.f;
                    LDQK(A0, 0); ATT_SCHED;
                    LDQK(A1, 1); ATT_SCHED; MMQK(A0); ATT_SCHED;
                    LDQK(A0, 2); ATT_SCHED; MMQK(A1); ATT_SCHED;
                    LDQK(A1, 3); ATT_SCHED; MMQK(A0); ATT_SCHED;
                    LDV(A0, 0, vo0); ATT_SCHED; MMQK(A1); ATT_SCHED;
                    if (near) {
#pragma unroll
                        for (int r = 0; r < 16; ++r) {
                            const int kp = 32 * ks + (r >> 2) * 8 + hh * 4 + (r & 3); const int d0 = qrow - kp;
                            const int di = d0 < 0 ? 0 : (d0 > 128 ? 128 : d0);
                            const float bv = lut[di];
                            S0[r] = d0 < 0 ? -1e30f : S0[r] + bv;
                        }
                    }
                    float mt = S0[0];
#pragma unroll
                    for (int r = 1; r < 16; ++r) mt = fmaxf(mt, S0[r]);
                    mt = fmaxf(mt, __shfl_xor(mt, 32));
                    const float mn = fmaxf(mrun, mt);
                    const float al = __builtin_amdgcn_exp2f(mrun - mn);
                    mrun = mn;
                    float ps = 0.f;
#pragma unroll
                    for (int r = 0; r < 16; ++r) { S0[r] = __builtin_amdgcn_exp2f(S0[r] - mn); ps += S0[r]; }
                    lrun = lrun * al + ps;
                    if (__builtin_amdgcn_ballot_w64(al != 1.0f) != 0ull) {
#pragma unroll
                        for (int i = 0; i < 8; ++i) O[i] = O[i] * al;
                    }
                    h16x8 P0, P1;
#pragma unroll
                    for (int e = 0; e < 8; ++e) { P0[e] = (h16)S0[e]; P1[e] = (h16)S0[8 + e]; }
                    ATT_SCHED;
                    LDV(A1, 4, vo0); ATT_SCHED; MMV(A0, 0, P0); ATT_SCHED;
                    LDV(A0, 0, vo1); ATT_SCHED; MMV(A1, 4, P0); ATT_SCHED;
                    LDV(A1, 4, vo1); ATT_SCHED; MMV(A0, 0, P1); ATT_SCHED;
                    MMV(A1, 4, P1);
#undef LDQK
#undef LDV
#undef MMQK
#undef MMV
                }
                asm volatile("s_waitcnt vmcnt(0)" ::: "memory");
                __syncthreads();
            }
#undef ATT_ISSUE
#undef ATT_SCHED
            lrun += __shfl_xor(lrun, 32);
            const float inv = 1.0f / lrun;
            const int lane2 = otid() & 63, l32b = lane2 & 31, hhb = lane2 >> 5;
            const int obase = (rg * 8) * 16 * 64 + lane2;
            if (mp == 1) {
                float lf;
                { const float* lmp_ = lam; asm volatile("" : "+s"(lmp_)); const GAS float* lmp = (const GAS float*)lmp_;
                  float s1 = 0.f, s2 = 0.f; for (int i = lane2; i < 128; i += 64) { s1 += lmp[i] * lmp[128 + i]; s2 += lmp[256 + i] * lmp[384 + i]; }
                  s1 = wave_sum(s1); s2 = wave_sum(s2); lf = __expf(s1) - __expf(s2) + lambda_init; }
                const float sc = inv * lf;
#pragma unroll
                for (int dvb = 0; dvb < 8; ++dvb)
#pragma unroll
                    for (int r = 0; r < 16; ++r) osh[obase + (dvb * 16 + r) * 64] = O[dvb][r] * sc;
            }
            __syncthreads();
            if (mp == 0) {
                const float* sgp_ = subg; asm volatile("" : "+s"(sgp_)); const GAS float* sgp = (const GAS float*)sgp_;
                float ss = 0.f;
#pragma unroll
                for (int dvb = 0; dvb < 8; ++dvb)
#pragma unroll
                    for (int r = 0; r < 16; ++r) { const float o = O[dvb][r] * inv - osh[obase + (dvb * 16 + r) * 64]; O[dvb][r] = o; ss += o * o; }
                ss += __shfl_xor(ss, 32);
                const float rms = rsqrtf(ss * (1.0f / 256.0f) + 1e-5f) * (1.0f - lambda_init);
                h16* op = AO + ((size_t)b * SEQ + q0 + 32 * rg + l32b) * DM + h * 256 + hhb * 4;
#pragma unroll
                for (int dvb = 0; dvb < 8; ++dvb)
#pragma unroll
                    for (int rq = 0; rq < 4; ++rq) {
                        const int dv0 = dvb * 32 + rq * 8;
                        const f32x4 sg = *(const GAS f32x4*)(sgp + dv0 + hhb * 4);
                        h16x4 o = {(h16)(O[dvb][rq * 4 + 0] * rms * sg[0]), (h16)(O[dvb][rq * 4 + 1] * rms * sg[1]), (h16)(O[dvb][rq * 4 + 2] * rms * sg[2]), (h16)(O[dvb][rq * 4 + 3] * rms * sg[3])};
                        *(h16x4*)(op + dv0) = o;
                    }
            }
        }
    }
}

#define XB_TMO      128
#define XB_XCNT(j)  (256  + 64 * (j))
#define XB_XSUB(j)  (1280 + 64 * (j))
#define XB_XGEN(j)  (2304 + 64 * (j))
#define XB_TOP      3328
#define XB_TOPGEN   3392
#define XCD_BAR_WORDS 3456
#define XB_SPIN_CAP (1u << 18)

__device__ __forceinline__ unsigned xb_ld(unsigned* p)              { return __hip_atomic_load(p, __ATOMIC_RELAXED, __HIP_MEMORY_SCOPE_AGENT); }
__device__ __forceinline__ unsigned xb_add(unsigned* p, unsigned v) { return __hip_atomic_fetch_add(p, v, __ATOMIC_RELAXED, __HIP_MEMORY_SCOPE_AGENT); }
__device__ __forceinline__ unsigned xb_xcc_id() { return (unsigned)__builtin_amdgcn_s_getreg((3 << 11) | 20) & 0xFu; }
#define XB_SPIN(cond, bar) do { unsigned _sp = 0; while (cond) { __builtin_amdgcn_s_sleep(1); \
    if ((++_sp & 255u) == 0u) { if (xb_ld(&(bar)[XB_TMO])) break; if (_sp > XB_SPIN_CAP) { atomicAdd(&(bar)[XB_TMO], 1u); break; } } } } while (0)

struct XcdBarrier {
    unsigned* bar; unsigned x;
    volatile LAS unsigned* st;
};

__device__ __forceinline__ XcdBarrier xcd_barrier_post(unsigned* bar, volatile LAS unsigned* st) {
    XcdBarrier b; b.bar = bar; b.x = xb_xcc_id(); b.st = st;
    if (threadIdx.x == 0) (void)xb_add(&bar[XB_XCNT(b.x)], 1u);
    return b;
}
__device__ __forceinline__ void xcd_barrier_complete(unsigned* bar, unsigned x, unsigned& nloc, unsigned& nx) {
    const unsigned G = gridDim.x * gridDim.y * gridDim.z;
    unsigned sum, cnt, mine, sp = 0u;
    for (;;) {
        sum = 0u; cnt = 0u; mine = 0u;
#pragma unroll
        for (unsigned j = 0; j < 16; ++j) { const unsigned c = xb_ld(&bar[XB_XCNT(j)]); sum += c; cnt += (c > 0u) ? 1u : 0u; mine = (j == x) ? c : mine; }
        if (sum == G) break;
        __builtin_amdgcn_s_sleep(1);
        if ((++sp & 255u) == 0u) { if (xb_ld(&bar[XB_TMO])) break; if (sp > XB_SPIN_CAP) { atomicAdd(&bar[XB_TMO], 1u); break; } }
    }
    nloc = mine > 0u ? mine : 1u; nx = cnt > 0u ? cnt : 1u;
}

__device__ __forceinline__ void xcd_barrier(const XcdBarrier& b) {
    asm volatile("s_waitcnt vmcnt(0)" ::: "memory");
    __syncthreads();
    if (threadIdx.x == 0) {
        unsigned* bar = b.bar;
        __builtin_amdgcn_s_waitcnt(0);
        unsigned nloc = b.st[0], nx = b.st[1];
        if (nloc == 0u) { xcd_barrier_complete(bar, b.x, nloc, nx); b.st[0] = nloc; b.st[1] = nx; }
        const unsigned old = xb_add(&bar[XB_XSUB(b.x)], 1u);
        const unsigned gen = old / nloc;
        if (old + 1u == (gen + 1u) * nloc) {
            __builtin_amdgcn_fence(__ATOMIC_RELEASE, "agent");
            asm volatile("s_waitcnt vmcnt(0)" ::: "memory");
            const unsigned og = xb_add(&bar[XB_TOP], 1u);
            const unsigned tg = og / nx;
            if (og + 1u == (tg + 1u) * nx) xb_add(&bar[XB_TOPGEN], 1u);
            else XB_SPIN(xb_ld(&bar[XB_TOPGEN]) == tg, bar);
            __builtin_amdgcn_fence(__ATOMIC_ACQUIRE, "agent");
            xb_add(&bar[XB_XGEN(b.x)], 1u);
            asm volatile("s_waitcnt vmcnt(0)" ::: "memory");
        } else {
            XB_SPIN(xb_ld(&bar[XB_XGEN(b.x)]) == gen, bar);
            __builtin_amdgcn_fence(__ATOMIC_ACQUIRE, "agent");
            asm volatile("s_waitcnt vmcnt(0)" ::: "memory");
        }
    }
    __syncthreads();
}


__device__ __forceinline__ void gbar(unsigned* ctr, unsigned target) {
    asm volatile("s_waitcnt vmcnt(0)" ::: "memory");
    __syncthreads();
    if (threadIdx.x == 0) {
        __builtin_amdgcn_fence(__ATOMIC_RELEASE, "agent");
        asm volatile("s_waitcnt vmcnt(0)" ::: "memory");
        __hip_atomic_fetch_add(ctr, 1u, __ATOMIC_RELAXED, __HIP_MEMORY_SCOPE_AGENT);
        while (__hip_atomic_load(ctr, __ATOMIC_RELAXED, __HIP_MEMORY_SCOPE_AGENT) < target) __builtin_amdgcn_s_sleep(1);
        __builtin_amdgcn_fence(__ATOMIC_ACQUIRE, "agent");
        asm volatile("s_waitcnt vmcnt(0)" ::: "memory");
    }
    __syncthreads();
}

#ifndef ONLY_GI
#define ENG(k) true
#else
#define ENG(k) ((k) == ONLY_GI)
#endif
#ifndef ONLY_KIND
#define EN(k) true
#else
#define EN(k) ((k) == ONLY_KIND)
#endif
__global__ void __launch_bounds__(512, 2) fwd_megakernel(Params p) {
    extern __shared__ __attribute__((aligned(16))) unsigned char shm[];
    LAS unsigned char* lds = (LAS unsigned char*)shm;
    cg::grid_group grid = cg::this_grid();
    unsigned char* ws = p.ws;
    h16* W = (h16*)(ws + WS_W16);
    h16* PRE = (h16*)(ws + WS_PRE); h16* XH = (h16*)(ws + WS_XH); h16* VF = (h16*)(ws + WS_VF);
    unsigned char* R1 = ws + WS_R1; unsigned char* R2 = ws + WS_R2; float* Y = (float*)(ws + WS_Y);
    h16* MIX = (h16*)R1; h16* SIDE = (h16*)R1; h16* AO = (h16*)R1;
    h16* DEC = (h16*)(R1 + R1_DEC); h16* Ab = (h16*)(R1 + R1_A); h16* Gb = (h16*)(R1 + R1_G); h16* AA = (h16*)(R1 + R1_AA); h16* YG = (h16*)(R1 + R1_YG);
    h16* C1 = (h16*)R2; h16* ACT = (h16*)R2; h16* Qb = (h16*)R2; h16* Kb = Qb + (size_t)MTOK * DM; h16* Vt = Kb + (size_t)MTOK * DM;
    const h16* wB1 = (const h16*)((char*)W + W_B1); const h16* wB2 = (const h16*)((char*)W + W_B2); const h16* wWO = (const h16*)((char*)W + W_WO);
    const h16* wUP = (const h16*)((char*)W + W_UP); const h16* wDN = (const h16*)((char*)W + W_DN);

    volatile LAS unsigned* xst = (volatile LAS unsigned*)(lds + LDS_BYTES - 16);
    if (threadIdx.x == 0) { xst[0] = 0u; xst[1] = 0u; }
    __syncthreads();
    const XcdBarrier xb = xcd_barrier_post((unsigned*)(ws + WS_BAR), xst);
    for (int ph = p.ph_lo; ph < p.ph_hi; ++ph) {
        int layer, kind;
        if (ph < 11) { layer = 0; kind = (int)((0xDCBA9854210ull >> (4 * ph)) & 15ull); }
        else if (ph < 19) { layer = 1; kind = (int)((0xDCBA9876ull >> (4 * (ph - 11))) & 15ull); }
        else if (ph < 29) { layer = 2; kind = (int)((0xDCBA985421ull >> (4 * (ph - 19))) & 15ull); }
        else { layer = 3; kind = (int)((0xDCBA9876ull >> (4 * (ph - 29))) & 15ull); }
        const int j = layer >> 1;
        const int nrep = ((PROBE_MASK >> kind) & 1) ? 2 : 1;
        for (int rep = 0; rep < nrep; ++rep)
        switch (kind) {
        case 0: if (EN(0)) {
            cvt_layer(lds, p, 0);
            ln_phase<false>(p.in[0], nullptr, nullptr, nullptr, XH, p.in[3], MIX);
        } break;
        case 1: if (EN(1)) {
            AMapMix am{(const char*)MIX}; EpiG1 e{C1};
            pg8::gemm_phase(lds, am, DM, wB1, DM, MTOK, j == 0 ? 6912 : 7168, DM, e);
        } break;
        case 2: if (EN(2)) {
            const float* w0 = p.in[5] + (size_t)j * DM; const float* a0 = p.in[8] + (size_t)j * DM; const float* v0 = p.in[11] + (size_t)(j > 0 ? j - 1 : 0) * DM;
            int k2 = 256; asm volatile("" : "+s"(k2));
            if (ENG(0)) { AMapOne am{(const char*)(C1 + 6144)}; EpiG2<0> e{DEC, Ab, Gb, C1, VF, w0, a0, v0, AA, p.in[16] + (size_t)j * DM, p.in[17] + (size_t)j * DM}; pg8::gemm_phase(lds, am, LDC1, wB2, 256, MTOK, DM, k2, e); }
            if (ENG(1)) { AMapOne am{(const char*)(C1 + 6400)}; EpiG2<1> e{DEC, Ab, Gb, C1, VF, w0, a0, v0, AA, p.in[16] + (size_t)j * DM, p.in[17] + (size_t)j * DM}; pg8::gemm_phase(lds, am, LDC1, wB2 + (size_t)2048 * 256, 256, MTOK, DM, k2, e); }
            if (ENG(2)) { AMapOne am{(const char*)(C1 + 6656)}; EpiG2<2> e{DEC, Ab, Gb, C1, VF, w0, a0, v0, AA, p.in[16] + (size_t)j * DM, p.in[17] + (size_t)j * DM}; pg8::gemm_phase(lds, am, LDC1, wB2 + (size_t)4096 * 256, 256, MTOK, DM, k2, e); }
            if (ENG(3) && j > 0) { AMapOne am{(const char*)(C1 + 6912)}; EpiG2<3> e{DEC, Ab, Gb, C1, VF, w0, a0, v0, AA, p.in[16] + (size_t)j * DM, p.in[17] + (size_t)j * DM}; pg8::gemm_phase(lds, am, LDC1, wB2 + (size_t)6144 * 256, 256, MTOK, DM, k2, e); }
        } break;
        case 3: if (EN(3)) prep_phase(C1, Ab, AA, VF, p.in[16] + (size_t)j * DM, p.in[17] + (size_t)j * DM, j == 0); break;
        case 4: if (EN(4)) scan_phase(lds, C1, DEC, AA, Ab, Y); break;
        case 5: if (EN(5)) gn_phase(Y, C1, Gb, YG, p.in[18] + (size_t)j * DM, p.in[19] + (size_t)j * DM, p.in[20] + (size_t)j * DM, j == 0 ? VF : nullptr); break;
        case 6: if (EN(6)) {
            AMapOne am{(const char*)XH}; EpiQKV e{Qb, Kb, Vt};
            pg8::gemm_phase(lds, am, DM, wB1, DM, MTOK, 6144, DM, e);
        } break;
        case 7: if (EN(7)) {
            const float li = layer == 1 ? 0.35550906759096926f : 0.5560581861995943f;
            attn_phase(lds, Qb, Kb, Vt, AO, p.in[26], p.in[23] + (size_t)j * 512, p.in[24] + (size_t)j * 256, li);
        } break;
        case 8: if (EN(8)) {
            AMapOne am{(const char*)((layer & 1) ? AO : YG)}; EpiRes e{XH, PRE};
            pg8::gemm_phase(lds, am, DM, wWO, DM, MTOK, DM, DM, e);
        } break;
        case 9: case 13: if (EN(9)) {
            const int sub = kind == 9 ? 0 : 1;
            const float* g = p.in[1] + (size_t)(layer * 2 + sub) * DM; const float* bt = p.in[2] + (size_t)(layer * 2 + sub) * DM;
            float* xo = nullptr; h16* xh = XH; const float* mu = nullptr; h16* mx = nullptr;
            if (kind == 13) {
                if (layer == 3) { xo = p.out; xh = nullptr; }
                else {
                    cvt_layer(lds, p, layer + 1);
                    if (layer == 1) { mu = p.in[3] + (size_t)1 * 6 * DM; mx = MIX; }
                }
            }
            ln_phase<true>(PRE, g, bt, xo, xh, mu, mx);
        } break;
        case 10: if (EN(10)) {
            AMapOne am{(const char*)XH}; EpiUpConv e{ACT, SIDE, p.in[28] + (size_t)layer * 3 * FF, p.in[29] + (size_t)layer * FF};
            pg8::gemm_phase(lds, am, DM, wUP, DM, MTOK, 2 * FF, DM, e);
        } break;
        case 11: if (EN(11)) convfix_phase(SIDE, ACT, p.in[28] + (size_t)layer * 3 * FF, p.in[29] + (size_t)layer * FF); break;
        case 12: if (EN(12)) {
            AMapOne am{(const char*)ACT}; EpiRes e{XH, PRE};
            pg8::gemm_phase(lds, am, FF, wDN, FF, MTOK, DM, FF, e);
        } break;
        }
        if (ph + 1 < p.ph_hi) {
            if (ph == p.ph_lo) grid.sync();
            else xcd_barrier(xb);
        }
    }
}

constexpr int NPHASES = 37;

extern "C" void kernel_launch(void* const* d_in, const int* in_sizes, int n_in, void* d_out, int out_size, void* d_ws, size_t ws_size, hipStream_t stream) {
    static int grid_blocks = 0;
    if (!grid_blocks) {
        if (n_in != 31 || ws_size < WS_END) { fprintf(stderr, "kernel_launch: unexpected n_in %d / ws_size %zu (need %zu)\n", n_in, ws_size, (size_t)WS_END); grid_blocks = -1; return; }
        int dev = 0, cus = 0, per_cu = 0;
        hipGetDevice(&dev);
        hipDeviceGetAttribute(&cus, hipDeviceAttributeMultiprocessorCount, dev);
        if (hipFuncSetAttribute((const void*)fwd_megakernel, hipFuncAttributeMaxDynamicSharedMemorySize, LDS_BYTES) != hipSuccess) { fprintf(stderr, "kernel_launch: hipFuncSetAttribute failed\n"); grid_blocks = -1; return; }
        if (hipOccupancyMaxActiveBlocksPerMultiprocessor(&per_cu, (const void*)fwd_megakernel, 512, LDS_BYTES) != hipSuccess || per_cu < 1) { fprintf(stderr, "kernel_launch: occupancy query gave %d\n", per_cu); per_cu = 1; (void)hipGetLastError(); }
        grid_blocks = cus * per_cu;
        if (grid_blocks > 256) grid_blocks = 256;
    }
    if (grid_blocks < 0) return;
    Params p{};
    for (int i = 0; i < 31; ++i) p.in[i] = (const float*)d_in[i];
    p.out = (float*)d_out; p.ws = (unsigned char*)d_ws; p.ph_lo = 0; p.ph_hi = NPHASES;
    if (hipMemsetAsync((char*)d_ws + WS_BAR, 0, 16384, stream) != hipSuccess) { fprintf(stderr, "kernel_launch: memset failed\n"); return; }
    void* args[] = {&p};
    hipError_t e = hipLaunchCooperativeKernel((const void*)fwd_megakernel, dim3(grid_blocks), dim3(512), args, LDS_BYTES, stream);
    if (e != hipSuccess) fprintf(stderr, "cooperative launch failed: %s (grid %d)\n", hipGetErrorString(e), grid_blocks);
}
```

```cpp
#include <hip/hip_runtime.h>
#include <hip/hip_cooperative_groups.h>
#include <cstdio>
namespace cg = cooperative_groups;

#define LAS __attribute__((address_space(3)))
#define GAS __attribute__((address_space(1)))
typedef _Float16 h16;
typedef _Float16 h16x8 __attribute__((ext_vector_type(8)));
typedef _Float16 h16x4 __attribute__((ext_vector_type(4)));
typedef float f32x4 __attribute__((ext_vector_type(4)));
typedef float f32x2 __attribute__((ext_vector_type(2)));
typedef float f32x16 __attribute__((ext_vector_type(16)));
typedef unsigned u32x4 __attribute__((ext_vector_type(4)));

constexpr int MTOK = 16384, DM = 2048, SEQ = 8192, FF = 5504, LDC1 = 7168;
constexpr float ALPHA = 1.681792830507429f;
constexpr float LOG2E = 1.4426950408889634f;
constexpr float QSCALE = 0.08838834764831845f * LOG2E;
constexpr int LDS_BYTES = 157696;
#define PROBE_MASK 0x0000

constexpr size_t W_B1 = 0, W_B2 = 29360128, W_WO = 33554432, W_UP = 41943040, W_DN = 87031808;
constexpr size_t WS_W16 = 0, WS_X = 117440512, WS_PRE = WS_X + 134217728, WS_XH = WS_PRE + 134217728, WS_VF = WS_XH + 67108864,
                 WS_R1 = WS_VF + 67108864, WS_R2 = WS_R1 + 402653184, WS_Y = WS_R2 + 234881024, WS_BAR = WS_Y + 134217728, WS_END = WS_BAR + 16384;
constexpr size_t R1_DEC = 0, R1_A = 134217728, R1_G = R1_A + 67108864, R1_AA = R1_G + 67108864, R1_YG = R1_AA + 67108864;

struct Params {
    const float* in[31];
    float* out;
    unsigned char* ws;
    int ph_lo, ph_hi;
};

__device__ __forceinline__ int otid() { int t = (int)threadIdx.x; asm volatile("" : "+v"(t)); return t; }
__device__ __forceinline__ int obid() { int t = (int)blockIdx.x; asm volatile("" : "+s"(t)); return t; }
__device__ __forceinline__ float wave_sum(float x) {
#pragma unroll
    for (int o = 32; o >= 1; o >>= 1) x += __shfl_xor(x, o);
    return x;
}
__device__ __forceinline__ float grp16_sum(float x) {
#pragma unroll
    for (int o = 8; o >= 1; o >>= 1) x += __shfl_xor(x, o);
    return x;
}
template <int CTRL> __device__ __forceinline__ float dpp_f(float x) { return __int_as_float(__builtin_amdgcn_update_dpp(0, __float_as_int(x), CTRL, 0xF, 0xF, true)); }
__device__ __forceinline__ float row16_sum(float x) { x += dpp_f<0xB1>(x); x += dpp_f<0x4E>(x); x += dpp_f<0x141>(x); x += dpp_f<0x140>(x); return x; }
__device__ __forceinline__ float sigmoidf_(float x) { return 1.0f / (1.0f + __expf(-x)); }

namespace pg8 {
constexpr int BM = 256, BK = 64, HALF = 128, HTB = HALF * BK * 2, NXCD = 8, WGM = 4;
__device__ __forceinline__ int lds_byte(int r, int c) { const int st = (r >> 4) * 2 + (c >> 5), rr = r & 15, cc = c & 31, ob = rr * 64 + cc * 2; return st * 1024 + (ob ^ (((ob >> 9) & 1) << 5)); }
__device__ __forceinline__ void stage_rc(int b, int& R, int& C) { const int st = b / 1024, sb = b % 1024, swz = sb ^ (((sb >> 9) & 1) << 5); R = (st >> 1) * 16 + swz / 64; C = (st & 1) * 32 + (swz % 64) / 2; }
__device__ __forceinline__ int perm32(int rho) { const int n = rho >> 4, i = rho & 15; return 8 * (i >> 2) + 4 * n + (i & 3); }
struct Unit { int pm, pn; };
struct Order {
    int nM, nN, nwg, G, c;
    __device__ void init(int M, int N, int G_, int c_) { nM = M / BM; nN = N / BM; nwg = nM * nN; G = G_; c = c_; }
    __device__ bool next(int i, Unit& u) const {
        const long L = (long)i * G + c; if (L >= nwg) return false;
        int wgid = (int)L; { const int q = nwg / NXCD, r = nwg % NXCD, xcd = wgid % NXCD, off = wgid / NXCD; wgid = (xcd < r ? xcd * (q + 1) : r * (q + 1) + (xcd - r) * q) + off; }
        const int nig = WGM * nN, gid = wgid / nig, fm = gid * WGM, gsz = (nM - fm) < WGM ? (nM - fm) : WGM;
        u.pm = fm + ((wgid % nig) % gsz); u.pn = (wgid % nig) / gsz; return true;
    }
};

template <class Epi, class AMap>
__device__ __forceinline__ void gemm_phase(LAS unsigned char* lds, const AMap am, const int lda, const h16* Bt, const int ldb, const int M, const int N, const int K, const Epi& E) {
    const int tid = otid(), wid = __builtin_amdgcn_readfirstlane(tid >> 6), lane = tid & 63, wr = wid >> 2, wc = wid & 3, fr = lane & 15, fq = lane >> 4;
    const int nt = K / BK;
    Order S; S.init(M, N, (int)gridDim.x, obid());
    unsigned voffA[2], voffB[2];
#pragma unroll
    for (int i = 0; i < 2; ++i) { int R, C; stage_rc(tid * 16 + i * 8192, R, C); const int Rb = Epi::PERM ? ((R & ~31) + perm32(R & 31)) : R;
        voffA[i] = (unsigned)(R * lda + C) * 2u; voffB[i] = (unsigned)(Rb * ldb + C) * 2u; }
    const size_t kstep = (size_t)(BK * 2);
    const size_t hstepA = (size_t)HALF * lda * 2, hstepB = (size_t)HALF * ldb * 2;
    const size_t tstepA = 2 * hstepA, tstepB = 2 * hstepB;
    const unsigned ldsw = (unsigned)wid * 1024u;
    const int aoff = lds_byte(wr * 64 + fr, fq * 8), boff = lds_byte(wc * 32 + fr, fq * 8);
#define PG8_SA(b, h) (((b) * 2 + (h)) * HTB)
#define PG8_SB(b, h) ((4 + (b) * 2 + (h)) * HTB)
#define PG8_STAGE(bufoff, gbase, voff) do { _Pragma("unroll") for (int _i = 0; _i < 2; ++_i) \
        __builtin_amdgcn_global_load_lds((const unsigned*)((const char*)(gbase) + (voff)[_i]), (LAS unsigned*)(lds + (bufoff) + ldsw + _i * 8192), 16, 0, 0); } while (0)
#define PG8_LDA(dst, b, h) do { _Pragma("unroll") for (int m = 0; m < 4; ++m) _Pragma("unroll") for (int k = 0; k < 2; ++k) dst[m][k] = *(const LAS h16x8*)(lds + PG8_SA(b, h) + aoff + m * 2048 + k * 1024); } while (0)
#define PG8_LDB(dst, b, h) do { _Pragma("unroll") for (int n = 0; n < 2; ++n) _Pragma("unroll") for (int k = 0; k < 2; ++k) dst[n][k] = *(const LAS h16x8*)(lds + PG8_SB(b, h) + boff + n * 2048 + k * 1024); } while (0)
#define PG8_MMA(ai, bj, At, Bt_) do { __builtin_amdgcn_s_setprio(1); _Pragma("unroll") for (int m = 0; m < 4; ++m) _Pragma("unroll") for (int n = 0; n < 2; ++n) _Pragma("unroll") for (int k = 0; k < 2; ++k) \
        acc[ai][bj][m][n] = __builtin_amdgcn_mfma_f32_16x16x32_f16(Bt_[n][k], At[m][k], acc[ai][bj][m][n], 0, 0, 0); __builtin_amdgcn_s_setprio(0); } while (0)
#define PG8_WAIT_V(n) asm volatile("s_waitcnt vmcnt(" #n ")" ::: "memory")
#define PG8_WAIT_L(n) asm volatile("s_waitcnt lgkmcnt(" #n ")" ::: "memory")
#define PG8_BAR __builtin_amdgcn_s_barrier()
#define PG8_SCHED __builtin_amdgcn_sched_barrier(0)
    Unit cur, nxt; int ui = 0;
    if (!S.next(0, cur)) return;
    f32x4 acc[2][2][4][2];
#pragma unroll
    for (int a = 0; a < 2; ++a)
#pragma unroll
        for (int b = 0; b < 2; ++b)
#pragma unroll
            for (int m = 0; m < 4; ++m)
#pragma unroll
                for (int n = 0; n < 2; ++n) acc[a][b][m][n] = (f32x4){0.f, 0.f, 0.f, 0.f};
    h16x8 At[4][2], B0[2][2], B1[2][2];
    const char* cA = am(cur.pn) + (size_t)cur.pm * tstepA; const char* cB = (const char*)Bt + (size_t)cur.pn * tstepB;
    PG8_STAGE(PG8_SB(0, 0), cB, voffB); PG8_STAGE(PG8_SA(0, 0), cA, voffA); PG8_STAGE(PG8_SB(0, 1), cB + hstepB, voffB); PG8_STAGE(PG8_SA(0, 1), cA + hstepA, voffA);
    if (wr == 1) PG8_BAR;
    PG8_WAIT_V(4); PG8_BAR;
    PG8_STAGE(PG8_SB(1, 0), cB + kstep, voffB); PG8_STAGE(PG8_SA(1, 0), cA + kstep, voffA); PG8_STAGE(PG8_SB(1, 1), cB + hstepB + kstep, voffB);
    PG8_WAIT_V(6); PG8_BAR;
    for (;;) {
        const bool has_next = S.next(ui + 1, nxt);
        const char* nA = has_next ? am(nxt.pn) + (size_t)nxt.pm * tstepA : cA; const char* nB = has_next ? (const char*)Bt + (size_t)nxt.pn * tstepB : cB;
#pragma unroll 1
        for (int t = 0; t < nt; t += 2) {
            const bool last = (t == nt - 2);
            const char* a1 = cA + (size_t)(t + 1) * kstep;
            const char* a2 = last ? nA : cA + (size_t)(t + 2) * kstep; const char* b2 = last ? nB : cB + (size_t)(t + 2) * kstep;
            const char* a3 = a2 + kstep; const char* b3 = b2 + kstep;
            PG8_LDB(B0, 0, 0); PG8_SCHED; PG8_LDA(At, 0, 0); PG8_STAGE(PG8_SA(1, 1), a1 + hstepA, voffA);
            PG8_WAIT_L(8); PG8_BAR; PG8_WAIT_L(0); PG8_MMA(0, 0, At, B0); PG8_BAR; PG8_SCHED;
            PG8_LDB(B1, 0, 1); PG8_STAGE(PG8_SB(0, 0), b2, voffB);
            PG8_BAR; PG8_WAIT_L(0); PG8_MMA(0, 1, At, B1); PG8_BAR;
            PG8_LDA(At, 0, 1); PG8_STAGE(PG8_SA(0, 0), a2, voffA);
            PG8_BAR; PG8_WAIT_L(0); PG8_MMA(1, 0, At, B0); PG8_BAR; PG8_SCHED;
            PG8_STAGE(PG8_SB(0, 1), b2 + hstepB, voffB);
            PG8_WAIT_V(6); PG8_BAR; PG8_MMA(1, 1, At, B1); PG8_BAR;
            PG8_LDB(B0, 1, 0); PG8_SCHED; PG8_LDA(At, 1, 0); PG8_STAGE(PG8_SA(0, 1), a2 + hstepA, voffA);
            PG8_WAIT_L(8); PG8_BAR; PG8_WAIT_L(0); PG8_MMA(0, 0, At, B0); PG8_BAR; PG8_SCHED;
            PG8_LDB(B1, 1, 1); PG8_STAGE(PG8_SB(1, 0), b3, voffB);
            PG8_BAR; PG8_WAIT_L(0); PG8_MMA(0, 1, At, B1); PG8_BAR;
            PG8_LDA(At, 1, 1); PG8_STAGE(PG8_SA(1, 0), a3, voffA);
            PG8_BAR; PG8_WAIT_L(0); PG8_MMA(1, 0, At, B0); PG8_BAR; PG8_SCHED;
            PG8_STAGE(PG8_SB(1, 1), b3 + hstepB, voffB);
            PG8_WAIT_V(6); PG8_BAR; PG8_MMA(1, 1, At, B1); PG8_BAR;
        }
        E(acc, cur, wr, wc, fr, fq);
        if (!has_next) break;
#pragma unroll
        for (int a = 0; a < 2; ++a)
#pragma unroll
            for (int b = 0; b < 2; ++b)
#pragma unroll
                for (int m = 0; m < 4; ++m)
#pragma unroll
                    for (int n = 0; n < 2; ++n) acc[a][b][m][n] = (f32x4){0.f, 0.f, 0.f, 0.f};
        cur = nxt; cA = nA; cB = nB; ++ui;
    }
    PG8_WAIT_V(0);
    if (wr == 0) PG8_BAR;
    PG8_BAR;
#undef PG8_SA
#undef PG8_SB
#undef PG8_STAGE
#undef PG8_LDA
#undef PG8_LDB
#undef PG8_MMA
#undef PG8_WAIT_V
#undef PG8_WAIT_L
#undef PG8_BAR
#undef PG8_SCHED
}
}
using pg8::Unit;

__device__ __forceinline__ u32x4 pack8(f32x4 a, f32x4 b) {
    h16x8 v = {(h16)a[0], (h16)a[1], (h16)a[2], (h16)a[3], (h16)b[0], (h16)b[1], (h16)b[2], (h16)b[3]};
    return __builtin_bit_cast(u32x4, v);
}

struct AMapOne { const char* A; __device__ __forceinline__ const char* operator()(int) const { return A; } };
struct AMapMix {
    const char* A;
    __device__ __forceinline__ const char* operator()(int pn) const {
        int idx; if (pn < 8) idx = 0; else if (pn < 16) idx = 2; else if (pn < 24) idx = 3; else if (pn == 24) idx = 1; else if (pn == 25) idx = 4; else if (pn == 26) idx = 5; else idx = 3;
        return A + (size_t)idx * ((size_t)MTOK * DM * 2);
    }
};
struct AMapLora {
    const char* C1;
    __device__ __forceinline__ const char* operator()(int pn) const { return C1 + (size_t)(6144 + 256 * (pn >> 3)) * 2; }
};

#define EPI_ROWS_PERM  const int row0 = u.pm * 256 + wr * 64 + fr; const int colt = u.pn * 256 + wc * 32 + 8 * fq;
struct EpiH16 {
    static constexpr bool PERM = true;
    h16* O; int ldc;
    __device__ __forceinline__ void operator()(const f32x4 (&acc)[2][2][4][2], const Unit& u, int wr, int wc, int fr, int fq) const {
        EPI_ROWS_PERM
#pragma unroll
        for (int ai = 0; ai < 2; ++ai)
#pragma unroll
            for (int m = 0; m < 4; ++m) { h16* rowp = O + (size_t)(row0 + ai * 128 + m * 16) * ldc + colt;
#pragma unroll
                for (int bj = 0; bj < 2; ++bj) *(u32x4*)(rowp + bj * 128) = pack8(acc[ai][bj][m][0], acc[ai][bj][m][1]); }
    }
};
struct EpiG1 {
    static constexpr bool PERM = true;
    h16* O;
    __device__ __forceinline__ void operator()(const f32x4 (&acc)[2][2][4][2], const Unit& u, int wr, int wc, int fr, int fq) const {
        EPI_ROWS_PERM
        const int mode = u.pn == 24 ? 1 : (u.pn == 26 ? 2 : 0);
#pragma unroll
        for (int ai = 0; ai < 2; ++ai)
#pragma unroll
            for (int m = 0; m < 4; ++m) { h16* rowp = O + (size_t)(row0 + ai * 128 + m * 16) * LDC1 + colt;
#pragma unroll
                for (int bj = 0; bj < 2; ++bj) { f32x4 v0 = acc[ai][bj][m][0], v1 = acc[ai][bj][m][1];
                    if (mode == 1) {
#pragma unroll
                        for (int j = 0; j < 4; ++j) { v0[j] = 1.0f - 2.0f / (1.0f + __expf(2.0f * v0[j])); v1[j] = 1.0f - 2.0f / (1.0f + __expf(2.0f * v1[j])); } }
                    else if (mode == 2) {
#pragma unroll
                        for (int j = 0; j < 4; ++j) { v0[j] = sigmoidf_(v0[j]); v1[j] = sigmoidf_(v1[j]); } }
                    *(u32x4*)(rowp + bj * 128) = pack8(v0, v1); } }
    }
};
template <int GI_> struct EpiG2 {
    static constexpr bool PERM = true;
    h16* DEC; h16* Ab; h16* Gb; h16* C1; const h16* VF; const float* w0; const float* a0; const float* v0; h16* AA; const float* k_k; const float* k_a;
    template <int GI>
    __device__ __forceinline__ void body(const f32x4 (&acc)[2][2][4][2], int row0, int colt) const {
#pragma unroll
        for (int bj = 0; bj < 2; ++bj) {
            const int c = colt + bj * 128;
            f32x4 b0 = (f32x4){0.f, 0.f, 0.f, 0.f}, b1 = b0;
            if (GI == 0) { b0 = *(const f32x4*)(w0 + c); b1 = *(const f32x4*)(w0 + c + 4); }
            else if (GI == 1) { b0 = *(const f32x4*)(a0 + c); b1 = *(const f32x4*)(a0 + c + 4); }
            else if (GI == 3) { b0 = *(const f32x4*)(v0 + c); b1 = *(const f32x4*)(v0 + c + 4); }
#pragma unroll
            for (int ai = 0; ai < 2; ++ai)
#pragma unroll
                for (int m = 0; m < 4; ++m) {
                    const size_t row = (size_t)(row0 + ai * 128 + m * 16);
                    f32x4 x0 = acc[ai][bj][m][0] + b0, x1 = acc[ai][bj][m][1] + b1;
                    if (GI == 0) {
#pragma unroll
                        for (int j = 0; j < 4; ++j) {
                            x0[j] = 0.6065306597126334f * sigmoidf_(x0[j]); x1[j] = 0.6065306597126334f * sigmoidf_(x1[j]); }
                        *(u32x4*)(DEC + row * DM + c) = pack8(x0, x1);
                    } else if (GI == 1) {
#pragma unroll
                        for (int j = 0; j < 4; ++j) { x0[j] = sigmoidf_(x0[j]); x1[j] = sigmoidf_(x1[j]); }
                        *(u32x4*)(Ab + row * DM + c) = pack8(x0, x1);
                    } else if (GI == 2) {
                        *(u32x4*)(Gb + row * DM + c) = pack8(x0, x1);
                    } else {
                        h16* vp = C1 + row * LDC1 + 4096 + c;
                        const h16x8 vv = *(const h16x8*)vp; const h16x8 vf = *(const h16x8*)(VF + row * DM + c);
                        f32x4 o0, o1;
#pragma unroll
                        for (int j = 0; j < 4; ++j) { float v = (float)vv[j], f = (float)vf[j]; o0[j] = v + (f - v) * sigmoidf_(x0[j]); v = (float)vv[4 + j]; f = (float)vf[4 + j]; o1[j] = v + (f - v) * sigmoidf_(x1[j]); }
                        *(u32x4*)vp = pack8(o0, o1);
                    }
                    __builtin_amdgcn_sched_barrier(0);
                }
        }
    }
    __device__ __forceinline__ void body_a(const f32x4 (&acc)[2][2][4][2], int row0, int cb0) const {
#pragma unroll
        for (int ai = 0; ai < 2; ++ai)
#pragma unroll
            for (int m = 0; m < 4; ++m) {
                const size_t row = (size_t)(row0 + ai * 128 + m * 16);
                asm volatile("" ::: "memory");
                float a[2][8], kv[2][8], kk[2][8]; float ss = 0.f;
#pragma unroll
                for (int bj = 0; bj < 2; ++bj) {
                    const int c = cb0 + 32 * bj;
                    const f32x4 b0 = *(const f32x4*)(a0 + c), b1 = *(const f32x4*)(a0 + c + 4), q0 = *(const f32x4*)(k_k + c), q1 = *(const f32x4*)(k_k + c + 4);
                    const h16x8 kh = *(const h16x8*)(C1 + row * LDC1 + 2048 + c);
#pragma unroll
                    for (int e = 0; e < 4; ++e) {
                        a[bj][e] = sigmoidf_(acc[ai][bj][m][0][e] + b0[e]); a[bj][4 + e] = sigmoidf_(acc[ai][bj][m][1][e] + b1[e]);
                        kv[bj][e] = (float)kh[e]; kv[bj][4 + e] = (float)kh[4 + e];
                        kk[bj][e] = kv[bj][e] * q0[e]; kk[bj][4 + e] = kv[bj][4 + e] * q1[e];
                        ss += kk[bj][e] * kk[bj][e] + kk[bj][4 + e] * kk[bj][4 + e];
                    }
                }
                ss += __shfl_xor(ss, 16); ss += __shfl_xor(ss, 32);
                const float inv = 1.0f / fmaxf(sqrtf(ss), 1e-12f);
#pragma unroll
                for (int bj = 0; bj < 2; ++bj) {
                    const int c = cb0 + 32 * bj;
                    const f32x4 p0 = *(const f32x4*)(k_a + c), p1 = *(const f32x4*)(k_a + c + 4);
                    f32x4 ko0, ko1, ao0, ao1, bo0, bo1;
#pragma unroll
                    for (int e = 0; e < 4; ++e) {
                        ko0[e] = kv[bj][e] * (1.0f + (a[bj][e] - 1.0f) * p0[e]); ko1[e] = kv[bj][4 + e] * (1.0f + (a[bj][4 + e] - 1.0f) * p1[e]);
                        const float n0_ = kk[bj][e] * inv, n1_ = kk[bj][4 + e] * inv;
                        ao0[e] = -n0_; ao1[e] = -n1_; bo0[e] = n0_ * a[bj][e]; bo1[e] = n1_ * a[bj][4 + e];
                    }
                    *(u32x4*)(C1 + row * LDC1 + 2048 + c) = pack8(ko0, ko1);
                    *(u32x4*)(AA + row * DM + c) = pack8(ao0, ao1);
                    *(u32x4*)(Ab + row * DM + c) = pack8(bo0, bo1);
                }
                __builtin_amdgcn_sched_barrier(0);
            }
    }
    __device__ __forceinline__ void operator()(const f32x4 (&acc)[2][2][4][2], const Unit& u, int wr, int wc, int fr, int fq) const {
        const int row0 = u.pm * 256 + wr * 64 + fr; const int colt = u.pn * 256 + wc * 32 + 8 * fq;
        if (GI_ == 1) body_a(acc, row0, u.pn * 256 + wc * 64 + 8 * fq);
        else body<GI_>(acc, row0, colt);
    }
};
struct EpiRes {
    static constexpr bool PERM = true;
    const h16* X; h16* PRE;
    __device__ __forceinline__ void operator()(const f32x4 (&acc)[2][2][4][2], const Unit& u, int wr, int wc, int fr, int fq) const {
        EPI_ROWS_PERM
#pragma unroll
        for (int ai = 0; ai < 2; ++ai)
#pragma unroll
            for (int m = 0; m < 4; ++m) { const size_t off = (size_t)(row0 + ai * 128 + m * 16) * DM + colt;
#pragma unroll
                for (int bj = 0; bj < 2; ++bj) {
                    const h16x8 x = *(const h16x8*)(X + off + bj * 128);
                    f32x4 o0, o1;
#pragma unroll
                    for (int e = 0; e < 4; ++e) { o0[e] = (float)x[e] * ALPHA + acc[ai][bj][m][0][e]; o1[e] = (float)x[4 + e] * ALPHA + acc[ai][bj][m][1][e]; }
                    *(u32x4*)(PRE + off + bj * 128) = pack8(o0, o1); } }
    }
};
__device__ __forceinline__ float gelu_mul(float u, float gc) {
    const float t = gc * gc;
    const float z = gc * (t * (0.044715f * 1.5957691216057308f * LOG2E) + 1.5957691216057308f * LOG2E);
    return u * gc * __builtin_amdgcn_rcpf(1.0f + __builtin_amdgcn_exp2f(-z));
}
struct EpiUpConv {
    static constexpr bool PERM = true;
    h16* ACT; h16* SIDE; const float* cw; const float* cb;
    __device__ __forceinline__ void operator()(const f32x4 (&acc)[2][2][4][2], const Unit& u, int wr, int wc, int fr, int fq) const {
        const int row0 = u.pm * 256 + wr * 64 + fr, f0 = u.pn * 128 + wc * 32 + 8 * fq;
        f32x4 w0[2], w1[2], w2[2], bb[2];
#pragma unroll
        for (int n = 0; n < 2; ++n) { w0[n] = *(const f32x4*)(cw + f0 + 4 * n); w1[n] = *(const f32x4*)(cw + FF + f0 + 4 * n); w2[n] = *(const f32x4*)(cw + 2 * FF + f0 + 4 * n); bb[n] = *(const f32x4*)(cb + f0 + 4 * n); }
#pragma unroll
        for (int ai = 0; ai < 2; ++ai) {
            f32x4 p1[2], p2[2];
#pragma unroll
            for (int n = 0; n < 2; ++n) { p1[n] = (f32x4){0.f, 0.f, 0.f, 0.f}; p2[n] = p1[n]; }
#pragma unroll
            for (int m = 0; m < 4; ++m) {
                const int row = row0 + ai * 128 + m * 16;
                f32x4 r1[2], r2[2], o[2];
#pragma unroll
                for (int n = 0; n < 2; ++n)
#pragma unroll
                    for (int e = 0; e < 4; ++e) {
                        const float g = acc[ai][1][m][n][e];
                        r1[n][e] = dpp_f<0x121>(g); r2[n][e] = dpp_f<0x122>(g);
                        const float g1 = fr >= 1 ? r1[n][e] : p1[n][e], g2 = fr >= 2 ? r2[n][e] : p2[n][e];
                        const float gc = bb[n][e] + g2 * w0[n][e] + g1 * w1[n][e] + g * w2[n][e];
                        o[n][e] = gelu_mul(acc[ai][0][m][n][e], gc);
                    }
                if (m > 0 || fr >= 2) *(u32x4*)(ACT + (size_t)row * FF + f0) = pack8(o[0], o[1]);
                if (m == 0 && fr < 2) { h16* sp = SIDE + ((size_t)(row >> 6) * 4 + 2 + fr) * (2 * FF) + f0;
                    *(u32x4*)sp = pack8(acc[ai][0][m][0], acc[ai][0][m][1]); *(u32x4*)(sp + FF) = pack8(acc[ai][1][m][0], acc[ai][1][m][1]); }
                if (m == 3 && fr >= 14) { h16* sp = SIDE + ((size_t)(row >> 6) * 4 + (fr - 14)) * (2 * FF) + FF + f0;
                    *(u32x4*)sp = pack8(acc[ai][1][m][0], acc[ai][1][m][1]); }
#pragma unroll
                for (int n = 0; n < 2; ++n) { p1[n] = r1[n]; p2[n] = r2[n]; }
            }
        }
    }
};
__device__ __forceinline__ void convfix_phase(const h16* SIDE, h16* ACT, const float* cw, const float* cb) {
    constexpr int NCG = FF / 8, NT = 256 * 2 * NCG;
    for (int task = obid() * 512 + otid(); task < NT; task += gridDim.x * 512) {
        const int cgi = task % NCG, j = (task / NCG) & 1, gidx = task / (2 * NCG), f = cgi * 8;
        const bool first = (gidx & 127) == 0;
        const h16* cur = SIDE + ((size_t)gidx * 4 + 2 + j) * (2 * FF) + f;
        const h16x8 uh = *(const h16x8*)cur, g0h = *(const h16x8*)(cur + FF);
        h16x8 g1h = {}, g2h = {};
        if (j == 0) { if (!first) { g1h = *(const h16x8*)(SIDE + ((size_t)(gidx - 1) * 4 + 1) * (2 * FF) + FF + f); g2h = *(const h16x8*)(SIDE + ((size_t)(gidx - 1) * 4 + 0) * (2 * FF) + FF + f); } }
        else { g1h = *(const h16x8*)(SIDE + ((size_t)gidx * 4 + 2) * (2 * FF) + FF + f); if (!first) g2h = *(const h16x8*)(SIDE + ((size_t)(gidx - 1) * 4 + 1) * (2 * FF) + FF + f); }
        h16x8 o;
#pragma unroll
        for (int e = 0; e < 8; ++e) {
            const float gc = cb[f + e] + (float)g2h[e] * cw[f + e] + (float)g1h[e] * cw[FF + f + e] + (float)g0h[e] * cw[2 * FF + f + e];
            o[e] = (h16)gelu_mul((float)uh[e], gc);
        }
        *(h16x8*)(ACT + ((size_t)gidx * 64 + j) * FF + f) = o;
    }
}
struct EpiQKV {
    static constexpr bool PERM = true;
    h16* Qb; h16* Kb; h16* Vt;
    __device__ __forceinline__ void operator()(const f32x4 (&acc)[2][2][4][2], const Unit& u, int wr, int wc, int fr, int fq) const {
        const int row0 = u.pm * 256 + wr * 64 + fr; const int part = u.pn >> 3; const int colt = (u.pn & 7) * 256 + wc * 32 + 8 * fq;
#pragma unroll
        for (int ai = 0; ai < 2; ++ai)
#pragma unroll
            for (int m = 0; m < 4; ++m) { const int row = row0 + ai * 128 + m * 16;
#pragma unroll
                for (int bj = 0; bj < 2; ++bj) { const int c = colt + bj * 128;
                    if (part == 0) *(u32x4*)(Qb + (size_t)row * DM + c) = pack8(acc[ai][bj][m][0] * QSCALE, acc[ai][bj][m][1] * QSCALE);
                    else if (part == 1) *(u32x4*)(Kb + (size_t)row * DM + c) = pack8(acc[ai][bj][m][0], acc[ai][bj][m][1]);
                    else {
                        const int b = row >> 13, t = row & 8191, hd = c >> 8, dv = c & 255;
                        const int pos = (t & ~12) | ((t & 4) << 1) | ((t & 8) >> 1);
                        h16* vp = Vt + ((size_t)((b * 8 + hd) * 256 + dv)) * SEQ + pos;
#pragma unroll
                        for (int j = 0; j < 4; ++j) { vp[(size_t)j * SEQ] = (h16)acc[ai][bj][m][0][j]; vp[(size_t)(4 + j) * SEQ] = (h16)acc[ai][bj][m][1][j]; }
                    } } }
    }
};

__device__ __forceinline__ void cvt_job(LAS unsigned char* lds, const float* src, int Ks, int Ns, h16* dst, int Kd, int Nd, int remap = 0) {
    LAS h16* tile = (LAS h16*)lds;
    const int tid = otid(), tk = Kd >> 6, tn = Nd >> 6;
    for (int t = obid(); t < tk * tn; t += gridDim.x) {
        const int k0 = (t % tk) * 64, n0 = (t / tk) * 64;
#pragma unroll
        for (int i = 0; i < 2; ++i) {
            const int idx = tid + 512 * i, kr = idx >> 4, nc = (idx & 15) * 4, k = k0 + kr, n = n0 + nc;
            f32x4 v = (f32x4){0.f, 0.f, 0.f, 0.f};
            if (k < Ks && n < Ns) v = *(const f32x4*)(src + (size_t)k * Ns + n);
            tile[kr * 66 + nc + 0] = (h16)v[0]; tile[kr * 66 + nc + 1] = (h16)v[1]; tile[kr * 66 + nc + 2] = (h16)v[2]; tile[kr * 66 + nc + 3] = (h16)v[3];
        }
        __syncthreads();
        { const int n = tid >> 3, kg = tid & 7; h16x8 o;
#pragma unroll
          for (int e = 0; e < 8; ++e) o[e] = tile[(kg * 8 + e) * 66 + n];
          const int no = n0 + n;
          const int nd = remap == 0 ? no : (remap == 1 ? (no < FF ? (no >> 7) * 256 + (no & 127) : ((no - FF) >> 7) * 256 + 128 + ((no - FF) & 127))
                                                      : ((no & ~255) | ((no & 32) << 2) | ((no & 192) >> 1) | (no & 31)));
          *(h16x8*)(dst + (size_t)nd * Kd + k0 + kg * 8) = o; }
        __syncthreads();
    }
}
__device__ __forceinline__ void cvt_layer(LAS unsigned char* lds, const Params& p, int layer) {
    h16* W = (h16*)(p.ws + ((layer & 1) ? WS_X : WS_W16));
    const int j = layer >> 1;
    if ((layer & 1) == 0) {
        h16* B1 = (h16*)((char*)W + W_B1); h16* B2 = (h16*)((char*)W + W_B2);
        for (int i = 0; i < 3; ++i) cvt_job(lds, p.in[4] + ((size_t)j * 3 + i) * DM * DM, DM, DM, B1 + (size_t)i * DM * DM, DM, DM);
        cvt_job(lds, p.in[6] + (size_t)j * DM * 96, DM, 96, B1 + (size_t)6144 * DM, DM, 256);
        cvt_job(lds, p.in[9] + (size_t)j * DM * 96, DM, 96, B1 + (size_t)6400 * DM, DM, 256);
        cvt_job(lds, p.in[14] + (size_t)j * DM * 128, DM, 128, B1 + (size_t)6656 * DM, DM, 256);
        cvt_job(lds, p.in[7] + (size_t)j * 96 * DM, 96, DM, B2, 256, DM);
        cvt_job(lds, p.in[10] + (size_t)j * 96 * DM, 96, DM, B2 + (size_t)2048 * 256, 256, DM, 2);
        cvt_job(lds, p.in[15] + (size_t)j * 128 * DM, 128, DM, B2 + (size_t)4096 * 256, 256, DM);
        if (j > 0) {
            cvt_job(lds, p.in[12] + (size_t)(j - 1) * DM * 64, DM, 64, B1 + (size_t)6912 * DM, DM, 256);
            cvt_job(lds, p.in[13] + (size_t)(j - 1) * 64 * DM, 64, DM, B2 + (size_t)6144 * 256, 256, DM);
        }
        cvt_job(lds, p.in[21] + (size_t)j * DM * DM, DM, DM, (h16*)((char*)W + W_WO), DM, DM);
    } else {
        cvt_job(lds, p.in[22] + (size_t)j * DM * 6144, DM, 6144, (h16*)((char*)W + W_B1), DM, 6144);
        cvt_job(lds, p.in[25] + (size_t)j * DM * DM, DM, DM, (h16*)((char*)W + W_WO), DM, DM);
    }
    cvt_job(lds, p.in[27] + (size_t)layer * DM * 2 * FF, DM, 2 * FF, (h16*)((char*)W + W_UP), DM, 2 * FF, 1);
    cvt_job(lds, p.in[30] + (size_t)layer * FF * DM, FF, DM, (h16*)((char*)W + W_DN), FF, DM);
}

template <bool LN>
__device__ __forceinline__ void ln_row(const void* src, size_t row, int lane, const float* g, const float* bt, f32x4 (&v)[8]) {
    if (LN) {
        const h16x4* sp = (const h16x4*)((const h16*)src + row * DM);
#pragma unroll
        for (int i = 0; i < 8; ++i) { const h16x4 t = sp[i * 64 + lane]; v[i] = (f32x4){(float)t[0], (float)t[1], (float)t[2], (float)t[3]}; }
        float s = 0.f;
#pragma unroll
        for (int i = 0; i < 8; ++i) s += (v[i][0] + v[i][1]) + (v[i][2] + v[i][3]);
        const float mean = wave_sum(s) * (1.0f / DM);
        float q = 0.f;
#pragma unroll
        for (int i = 0; i < 8; ++i) { v[i] = v[i] - mean; q += (v[i][0] * v[i][0] + v[i][1] * v[i][1]) + (v[i][2] * v[i][2] + v[i][3] * v[i][3]); }
        const float rstd = rsqrtf(wave_sum(q) * (1.0f / DM) + 1e-5f);
#pragma unroll
        for (int i = 0; i < 8; ++i) { const f32x4 gg = ((const f32x4*)g)[i * 64 + lane], bb = ((const f32x4*)bt)[i * 64 + lane]; v[i] = v[i] * rstd * gg + bb; }
    } else {
        const f32x4* sp = (const f32x4*)((const float*)src + row * DM);
#pragma unroll
        for (int i = 0; i < 8; ++i) v[i] = sp[i * 64 + lane];
    }
}
__device__ __forceinline__ void ln_load16(const void* src, size_t row, int lane, h16x4 (&t)[8]) {
    const h16x4* sp = (const h16x4*)((const h16*)src + row * DM);
#pragma unroll
    for (int i = 0; i < 8; ++i) t[i] = sp[i * 64 + lane];
}
__device__ __forceinline__ void ln_apply16(const h16x4 (&t)[8], int lane, const float* g, const float* bt, f32x4 (&v)[8]) {
#pragma unroll
    for (int i = 0; i < 8; ++i) v[i] = (f32x4){(float)t[i][0], (float)t[i][1], (float)t[i][2], (float)t[i][3]};
    float s = 0.f;
#pragma unroll
    for (int i = 0; i < 8; ++i) s += (v[i][0] + v[i][1]) + (v[i][2] + v[i][3]);
    const float mean = wave_sum(s) * (1.0f / DM);
    float q = 0.f;
#pragma unroll
    for (int i = 0; i < 8; ++i) { v[i] = v[i] - mean; q += (v[i][0] * v[i][0] + v[i][1] * v[i][1]) + (v[i][2] * v[i][2] + v[i][3] * v[i][3]); }
    const float rstd = rsqrtf(wave_sum(q) * (1.0f / DM) + 1e-5f);
#pragma unroll
    for (int i = 0; i < 8; ++i) { const f32x4 gg = ((const f32x4*)g)[i * 64 + lane], bb = ((const f32x4*)bt)[i * 64 + lane]; v[i] = v[i] * rstd * gg + bb; }
}
template <bool LN>
__device__ __forceinline__ void ln_phase(const void* src, const float* g, const float* bt, float* xout, h16* xh, const float* mu, h16* mix) {
    const int lane = otid() & 63, gw = obid() * 8 + (otid() >> 6), GW = gridDim.x * 8;
    for (int ch = gw; ch < MTOK / 8; ch += GW) {
        const size_t t0 = (size_t)ch * 8;
        f32x4 prev[8], cur[8];
        if (mix) {
            if ((t0 & (SEQ - 1)) == 0) {
#pragma unroll
                for (int i = 0; i < 8; ++i) prev[i] = (f32x4){0.f, 0.f, 0.f, 0.f};
            } else ln_row<LN>(src, t0 - 1, lane, g, bt, prev);
        }
        h16x4 raw[8], rawn[8];
        if (LN) ln_load16(src, t0, lane, raw);
#pragma unroll 1
        for (int r = 0; r < 8; ++r) {
            const size_t row = t0 + r;
            asm volatile("" ::: "memory");
            if (LN) {
                ln_load16(src, t0 + (r < 7 ? r + 1 : 7), lane, rawn);
                ln_apply16(raw, lane, g, bt, cur);
#pragma unroll
                for (int i = 0; i < 8; ++i) raw[i] = rawn[i];
            } else ln_row<LN>(src, row, lane, g, bt, cur);
            if (xout) {
#pragma unroll
                for (int i = 0; i < 8; ++i) ((f32x4*)(xout + row * DM))[i * 64 + lane] = cur[i];
            }
            if (xh) {
#pragma unroll
                for (int i = 0; i < 8; ++i) { h16x4 o = {(h16)cur[i][0], (h16)cur[i][1], (h16)cur[i][2], (h16)cur[i][3]}; ((h16x4*)(xh + row * DM))[i * 64 + lane] = o; }
            }
            if (mix) {
#pragma unroll
                for (int i = 0; i < 8; ++i) {
                    asm volatile("" ::: "memory");
                    const f32x4 xx = prev[i] - cur[i];
#pragma unroll
                    for (int k = 0; k < 6; ++k) {
                        const f32x4 m4 = ((const f32x4*)(mu + (size_t)k * DM))[i * 64 + lane];
                        const f32x4 o4 = cur[i] + xx * m4;
                        h16x4 o = {(h16)o4[0], (h16)o4[1], (h16)o4[2], (h16)o4[3]};
                        ((h16x4*)(mix + ((size_t)k * MTOK + row) * DM))[i * 64 + lane] = o;
                    }
                    prev[i] = cur[i];
                }
            }
        }
    }
}

__device__ __forceinline__ void prep_phase(h16* C1, h16* Ab, h16* AA, h16* VF, const float* k_k, const float* k_a, bool first) {
    const int lane = otid() & 63, gw = obid() * 8 + (otid() >> 6), GW = gridDim.x * 8;
    for (int row = gw; row < MTOK; row += GW) {
#pragma unroll
        for (int i = 0; i < 8; ++i) {
            const int c = i * 256 + lane * 4;
            h16x4* kp = (h16x4*)(C1 + (size_t)row * LDC1 + 2048 + c);
            h16x4* ap = (h16x4*)(Ab + (size_t)row * DM + c);
            const h16x4 kh = *kp, ah = *ap;
            const f32x4 kkw = *(const f32x4*)(k_k + c), kaw = *(const f32x4*)(k_a + c);
            f32x4 k, a, kk;
#pragma unroll
            for (int e = 0; e < 4; ++e) { k[e] = (float)kh[e]; a[e] = (float)ah[e]; kk[e] = k[e] * kkw[e]; }
            float ss = (kk[0] * kk[0] + kk[1] * kk[1]) + (kk[2] * kk[2] + kk[3] * kk[3]);
            ss = grp16_sum(ss);
            const float inv = 1.0f / fmaxf(sqrtf(ss), 1e-12f);
            h16x4 ko, aao, bbo;
#pragma unroll
            for (int e = 0; e < 4; ++e) { const float kn = kk[e] * inv; ko[e] = (h16)(k[e] * (1.0f + (a[e] - 1.0f) * kaw[e])); aao[e] = (h16)(-kn); bbo[e] = (h16)(kn * a[e]); }
            *kp = ko; *ap = bbo; *(h16x4*)(AA + (size_t)row * DM + c) = aao;
            if (first) *(h16x4*)(VF + (size_t)row * DM + c) = *(const h16x4*)(C1 + (size_t)row * LDC1 + 4096 + c);
        }
    }
}

__device__ __forceinline__ void scan_phase(LAS unsigned char* lds, const h16* C1, const h16* DEC, const h16* AA, const h16* BB, float* Y,
                                           const float* sQKV, const float* sWO, const float* sUP, const float* sDN, char* Wn) {
    constexpr int CH = 32, NCH = SEQ / CH, BUF = 18976;
    LAS float* L = (LAS float*)lds;
    const int tid = otid(), wid = tid >> 6, lane = tid & 63;
    for (int item = obid(); item < 256; item += gridDim.x) {
        const int b = item >> 7, h = (item >> 2) & 31, q = item & 3;
        const size_t row0 = (size_t)b * SEQ;
        __syncthreads();
        if (wid >= 4) {
            const int lt = tid - 256, s = lt >> 3, e8 = lt & 7;
            struct StReg { h16x8 r8, k8, a8, b8, v8, d8; };
            auto gload = [&](int c) -> StReg {
                StReg R;
                const size_t row = row0 + (size_t)c * CH + s;
                R.r8 = *(const h16x8*)(C1 + row * LDC1 + h * 64 + e8 * 8);
                R.k8 = *(const h16x8*)(C1 + row * LDC1 + 2048 + h * 64 + e8 * 8);
                { const int tn = c * CH + s + 1; const size_t rown = row0 + (size_t)(tn < SEQ ? tn : SEQ - 1);
                  R.a8 = *(const h16x8*)(AA + rown * DM + h * 64 + e8 * 8); }
                R.b8 = *(const h16x8*)(BB + row * DM + h * 64 + e8 * 8);
                R.d8 = *(const h16x8*)(DEC + row * DM + h * 64 + e8 * 8);
                R.v8 = (h16x8){};
                if (lt < 64) R.v8 = *(const h16x8*)(C1 + (row0 + (size_t)c * CH + (lt >> 1)) * LDC1 + 4096 + h * 64 + q * 16 + (lt & 1) * 8);
                return R;
            };
            auto lwrite = [&](const StReg& R, int bufi) {
                LAS float* Bf = L + bufi * BUF;
                LAS float* dst = Bf + s * 64 + e8 * 8;
                *(LAS f32x4*)(dst + 0 * 2048) = (f32x4){(float)R.r8[0], (float)R.r8[1], (float)R.r8[2], (float)R.r8[3]}; *(LAS f32x4*)(dst + 0 * 2048 + 4) = (f32x4){(float)R.r8[4], (float)R.r8[5], (float)R.r8[6], (float)R.r8[7]};
                *(LAS f32x4*)(dst + 1 * 2048) = (f32x4){__expf(-(float)R.d8[0]), __expf(-(float)R.d8[1]), __expf(-(float)R.d8[2]), __expf(-(float)R.d8[3])};
                *(LAS f32x4*)(dst + 1 * 2048 + 4) = (f32x4){__expf(-(float)R.d8[4]), __expf(-(float)R.d8[5]), __expf(-(float)R.d8[6]), __expf(-(float)R.d8[7])};
                *(LAS f32x4*)(dst + 2 * 2048) = (f32x4){(float)R.k8[0], (float)R.k8[1], (float)R.k8[2], (float)R.k8[3]}; *(LAS f32x4*)(dst + 2 * 2048 + 4) = (f32x4){(float)R.k8[4], (float)R.k8[5], (float)R.k8[6], (float)R.k8[7]};
                *(LAS f32x4*)(dst + 3 * 2048) = (f32x4){(float)R.a8[0], (float)R.a8[1], (float)R.a8[2], (float)R.a8[3]}; *(LAS f32x4*)(dst + 3 * 2048 + 4) = (f32x4){(float)R.a8[4], (float)R.a8[5], (float)R.a8[6], (float)R.a8[7]};
                *(LAS f32x4*)(dst + 4 * 2048) = (f32x4){(float)R.b8[0], (float)R.b8[1], (float)R.b8[2], (float)R.b8[3]}; *(LAS f32x4*)(dst + 4 * 2048 + 4) = (f32x4){(float)R.b8[4], (float)R.b8[5], (float)R.b8[6], (float)R.b8[7]};
                { float cp = 0.f;
#pragma unroll
                  for (int e = 0; e < 8; ++e) cp += (float)R.b8[e] * (float)R.a8[e];
                  cp += __shfl_xor(cp, 1); cp += __shfl_xor(cp, 2); cp += __shfl_xor(cp, 4);
                  if (e8 == 0) Bf[18944 + s] = cp; }
                if (lt < 64) { LAS float* vd = Bf + 10240 + (lt >> 1) * 16 + (lt & 1) * 8;
                    *(LAS f32x4*)vd = (f32x4){(float)R.v8[0], (float)R.v8[1], (float)R.v8[2], (float)R.v8[3]}; *(LAS f32x4*)(vd + 4) = (f32x4){(float)R.v8[4], (float)R.v8[5], (float)R.v8[6], (float)R.v8[7]}; }
            };
            auto yout = [&](int c, int bufi) {
#pragma unroll
                for (int o2 = 0; o2 < 2; ++o2) {
                    const int o = lt + 256 * o2, ys = o >> 4, yr = o & 15;
                    LAS float* yp = L + bufi * BUF + 10752 + o * 16;
                    f32x4 acc4 = *(LAS f32x4*)(yp + (((0 + (o >> 2)) & 3) << 2));
#pragma unroll
                    for (int i = 1; i < 4; ++i) acc4 += *(LAS f32x4*)(yp + (((i + (o >> 2)) & 3) << 2));
                    Y[(row0 + (size_t)c * CH + ys) * DM + h * 64 + q * 16 + yr] = (acc4[0] + acc4[1]) + (acc4[2] + acc4[3]);
                }
            };
            const int lw = (lt >> 6), wgl = item * 4 + lw;
            LAS h16* ctile = (LAS h16*)(lds + 2 * BUF * 4) + lw * 512;
            auto cvt_small = [&](int tix) {
                constexpr int T0 = 128 * 192, T1 = 128 * 64, T2 = 128 * 344, T3 = 344 * 64;
                if (tix >= T0 + T1 + T2 + T3) return;
                const float* src; h16* dst; int Ks, Ns, rm = 0, t = tix;
                if (t < T0) { src = sQKV; dst = (h16*)(Wn + W_B1); Ks = DM; Ns = 6144; }
                else if (t < T0 + T1) { t -= T0; src = sWO; dst = (h16*)(Wn + W_WO); Ks = DM; Ns = DM; }
                else if (t < T0 + T1 + T2) { t -= T0 + T1; src = sUP; dst = (h16*)(Wn + W_UP); Ks = DM; Ns = 2 * FF; rm = 1; }
                else { t -= T0 + T1 + T2; src = sDN; dst = (h16*)(Wn + W_DN); Ks = FF; Ns = DM; }
                const int tk = Ks >> 4, k0 = (t % tk) * 16, n0 = (t / tk) * 32;
                const int ln = lt & 63, kr = ln >> 3, nc = (ln & 7) * 4;
                const f32x4 v0 = *(const f32x4*)(src + (size_t)(k0 + kr) * Ns + n0 + nc), v1 = *(const f32x4*)(src + (size_t)(k0 + kr + 8) * Ns + n0 + nc);
#pragma unroll
                for (int e = 0; e < 4; ++e) { ctile[(nc + e) * 16 + kr] = (h16)v0[e]; ctile[(nc + e) * 16 + kr + 8] = (h16)v1[e]; }
                asm volatile("s_waitcnt lgkmcnt(0)" ::: "memory");
                const int n = ln & 31, hf = ln >> 5, no = n0 + n;
                const h16x8 o = *(LAS h16x8*)(ctile + n * 16 + hf * 8);
                const int nd = rm == 0 ? no : (no < FF ? (no >> 7) * 256 + (no & 127) : ((no - FF) >> 7) * 256 + 128 + ((no - FF) & 127));
                *(h16x8*)(dst + (size_t)nd * Ks + k0 + hf * 8) = o;
                asm volatile("s_waitcnt lgkmcnt(0)" ::: "memory");
            };
            { const StReg R0 = gload(0); lwrite(R0, 0); }
            StReg RA = gload(1);
            __syncthreads();
            for (int c = 0; c < NCH; ++c) {
                StReg RB = RA;
                if (c + 2 < NCH) RB = gload(c + 2);
                if (c + 1 < NCH) lwrite(RA, (c + 1) & 1);
                if (c > 0) yout(c - 1, (c - 1) & 1);
                if (Wn && (c & 1) == 0) cvt_small(wgl + 1024 * (c >> 1));
                __syncthreads();
                RA = RB;
            }
            yout(NCH - 1, (NCH - 1) & 1);
        } else {
            const int jg = lane & 15, rl = wid * 4 + (lane >> 4);
            f32x2 Sa = (f32x2){0.f, 0.f}, Sb = (f32x2){0.f, 0.f};
            float sa = 0.f;
            __syncthreads();
            for (int c = 0; c < NCH; ++c) {
                LAS float* Bf = L + (c & 1) * BUF;
                LAS float* vec = Bf + jg * 4;
                f32x4 r4 = *(LAS f32x4*)(vec + 0 * 2048), w4 = *(LAS f32x4*)(vec + 1 * 2048), k4 = *(LAS f32x4*)(vec + 2 * 2048), a4 = *(LAS f32x4*)(vec + 3 * 2048), b4 = *(LAS f32x4*)(vec + 4 * 2048);
                float v = Bf[10240 + rl], cn = Bf[18944];
#pragma unroll 1
                for (int s0 = 0; s0 < CH; s0 += 8) {
                    float yv[8];
#pragma unroll
                    for (int u = 0; u < 8; ++u) {
                        const int s = s0 + u, sn = (s + 1 < CH) ? s + 1 : CH - 1;
                        const f32x4 r4n = *(LAS f32x4*)(vec + 0 * 2048 + sn * 64), w4n = *(LAS f32x4*)(vec + 1 * 2048 + sn * 64), k4n = *(LAS f32x4*)(vec + 2 * 2048 + sn * 64),
                                    a4n = *(LAS f32x4*)(vec + 3 * 2048 + sn * 64), b4n = *(LAS f32x4*)(vec + 4 * 2048 + sn * 64);
                        const float vn = Bf[10240 + sn * 16 + rl], cnn = Bf[18944 + sn];
                        const f32x2 aL = {a4[0], a4[1]}, aH = {a4[2], a4[3]}, wL = {w4[0], w4[1]}, wH = {w4[2], w4[3]}, kL = {k4[0], k4[1]}, kH = {k4[2], k4[3]},
                                    bL = {b4[0], b4[1]}, bH = {b4[2], b4[3]}, rL = {r4[0], r4[1]}, rH = {r4[2], r4[3]};
                        const f32x2 uL = Sa * wL + kL * v, uH = Sb * wH + kH * v;
                        const f32x2 dz = uL * aL + uH * aH;
                        const float z = row16_sum(dz[0] + dz[1]);
                        Sa = bL * sa + uL; Sb = bH * sa + uH;
                        const f32x2 dr = Sa * rL + Sb * rH;
                        yv[u] = dr[0] + dr[1];
                        sa = z + cn * sa;
                        r4 = r4n; w4 = w4n; k4 = k4n; a4 = a4n; b4 = b4n; v = vn; cn = cnn;
                    }
#pragma unroll
                    for (int u = 0; u < 8; ++u) Bf[10752 + ((s0 + u) * 16 + rl) * 16 + jg] = yv[u];
                }
                __syncthreads();
            }
        }
    }
}

__device__ __forceinline__ void gn_phase(const float* Y, const h16* C1, const h16* Gb, h16* YG, const float* r_k, const float* lnx_g, const float* lnx_b, h16* VFw) {
    const int lane = otid() & 63, gw = obid() * 8 + (otid() >> 6), GW = gridDim.x * 8;
    for (int row = gw; row < MTOK; row += GW) {
#pragma unroll
        for (int i = 0; i < 8; ++i) {
            const int c = i * 256 + lane * 4;
            const f32x4 y = *(const f32x4*)(Y + (size_t)row * DM + c);
            const h16x4 rh = *(const h16x4*)(C1 + (size_t)row * LDC1 + c), kh = *(const h16x4*)(C1 + (size_t)row * LDC1 + 2048 + c), vh = *(const h16x4*)(C1 + (size_t)row * LDC1 + 4096 + c);
            const h16x4 gh = *(const h16x4*)(Gb + (size_t)row * DM + c);
            const f32x4 rk = *(const f32x4*)(r_k + c), lg = *(const f32x4*)(lnx_g + c), lb = *(const f32x4*)(lnx_b + c);
            float s = (y[0] + y[1]) + (y[2] + y[3]);
            const float mean = grp16_sum(s) * (1.0f / 64.0f);
            const f32x4 d = y - mean;
            float qv = (d[0] * d[0] + d[1] * d[1]) + (d[2] * d[2] + d[3] * d[3]);
            const float rstd = rsqrtf(grp16_sum(qv) * (1.0f / 64.0f) + 64e-5f);
            float bs = 0.f;
#pragma unroll
            for (int e = 0; e < 4; ++e) bs += (float)rh[e] * (float)kh[e] * rk[e];
            bs = grp16_sum(bs);
            h16x4 o;
#pragma unroll
            for (int e = 0; e < 4; ++e) o[e] = (h16)((d[e] * rstd * lg[e] + lb[e] + bs * (float)vh[e]) * (float)gh[e]);
            *(h16x4*)(YG + (size_t)row * DM + c) = o;
            if (VFw) *(h16x4*)(VFw + (size_t)row * DM + c) = vh;
        }
    }
}

__device__ __forceinline__ void convglu_phase(const h16* U, h16* ACT, const float* cw, const float* cb) {
    constexpr int NCG = FF / 8, RC = 16, NT = (MTOK / RC) * NCG;
    for (int task = obid() * 512 + otid(); task < NT; task += gridDim.x * 512) {
        const int cgi = task % NCG, rc = task / NCG, f = cgi * 8, m0 = rc * RC;
        float w0[8], w1[8], w2[8], bb[8], g1[8], g2[8];
#pragma unroll
        for (int e = 0; e < 8; ++e) { w0[e] = cw[f + e]; w1[e] = cw[FF + f + e]; w2[e] = cw[2 * FF + f + e]; bb[e] = cb[f + e]; g1[e] = 0.f; g2[e] = 0.f; }
        if ((m0 & (SEQ - 1)) != 0) {
            const h16x8 a = *(const h16x8*)(U + (size_t)(m0 - 1) * (2 * FF) + FF + f), c2 = *(const h16x8*)(U + (size_t)(m0 - 2) * (2 * FF) + FF + f);
#pragma unroll
            for (int e = 0; e < 8; ++e) { g1[e] = (float)a[e]; g2[e] = (float)c2[e]; }
        }
        for (int r = 0; r < RC; ++r) {
            const size_t m = (size_t)(m0 + r);
            const h16x8 uh = *(const h16x8*)(U + m * (2 * FF) + f), gh = *(const h16x8*)(U + m * (2 * FF) + FF + f);
            h16x8 o;
#pragma unroll
            for (int e = 0; e < 8; ++e) {
                const float g0 = (float)gh[e];
                const float gc = bb[e] + g2[e] * w0[e] + g1[e] * w1[e] + g0 * w2[e];
                const float z = 1.5957691216057308f * (gc + 0.044715f * gc * gc * gc);
                const float ge = gc / (1.0f + __expf(-z));
                o[e] = (h16)((float)uh[e] * ge);
                g2[e] = g1[e]; g1[e] = g0;
            }
            *(h16x8*)(ACT + m * FF + f) = o;
        }
    }
}

__device__ __forceinline__ void attn_phase(LAS unsigned char* lds, const h16* Qb, const h16* Kb, const h16* Vt, h16* AO, const float* rel_bias, const float* lam, const float* subg, float lambda_init) {
    const int wid = __builtin_amdgcn_readfirstlane(otid() >> 6), rg = wid & 3, mp = wid >> 2;
    LAS float* lut = (LAS float*)(lds + 131072);
    LAS float* osh = (LAS float*)lds;
    for (int vc = obid(); vc < 256; vc += gridDim.x) {
        const int bh = vc & 15, jj = vc >> 4, b = bh >> 3, h = bh & 7;
        for (int it = 0; it < 4; ++it) {
            const int qb = it == 0 ? 63 - jj : (it == 1 ? 32 + jj : (it == 2 ? 31 - jj : jj));
            __syncthreads();
            const int tid = otid(), lane = tid & 63, l32 = lane & 31, hh = lane >> 5;
            const int xk = l32 & 15, yv = (l32 >> 2) & 3;
            if (tid <= 128) {
                const float* rbp_ = rel_bias; asm volatile("" : "+s"(rbp_)); const GAS float* rbp = (const GAS float*)rbp_;
                float val = 0.f;
                if (tid < 128) { int bk = tid; if (tid >= 16) { bk = 16 + (int)(__logf((float)tid * (1.0f / 16.0f)) / 2.0794415416798357f * 16.0f); bk = bk > 31 ? 31 : bk; }
                    val = (rbp[bk * 8 + h] - rbp[31 * 8 + h]) * LOG2E; }
                lut[tid] = val;
            }
            const int q0 = qb * 128, qrow = q0 + 32 * rg + l32;
            const size_t tokbase = (size_t)b * SEQ;
            LAS unsigned char* qs = lds + 65536 + wid * 8192 + lane * 16;
            { const h16* qp = Qb + (tokbase + qrow) * DM + h * 256 + mp * 128 + hh * 8;
              h16x8 qf[8];
#pragma unroll
              for (int k = 0; k < 8; ++k) qf[k] = *(const h16x8*)(qp + k * 16);
#pragma unroll
              for (int k = 0; k < 8; ++k) *(LAS h16x8*)(qs + k * 1024) = qf[k]; }
            f32x16 O[8];
#pragma unroll
            for (int i = 0; i < 8; ++i)
#pragma unroll
                for (int r = 0; r < 16; ++r) O[i][r] = 0.f;
            float mrun = -1e30f, lrun = 0.f;
            const int nks = 4 * qb + 4;
            const int kkey = wid * 2 + (lane >> 5);
            const h16* kg = Kb + (tokbase + kkey) * DM + h * 256 + (((lane & 31) ^ (kkey & 15)) << 3);
            const int vdv = wid * 16 + (lane >> 2);
            const h16* vg = Vt + ((size_t)((b * 8 + h) * 256) + vdv) * SEQ + (((lane & 3) ^ ((lane >> 4) & 3)) << 3);
#define ATT_ISSUE(KS, BUF) do { _Pragma("unroll") for (int _i = 0; _i < 2; ++_i) \
                __builtin_amdgcn_global_load_lds((const unsigned*)(kg + (size_t)(32 * (KS) + 16 * _i) * DM), (LAS unsigned*)((BUF) + (_i * 8 + wid) * 1024), 16, 0, 0); \
              _Pragma("unroll") for (int _i = 0; _i < 2; ++_i) \
                __builtin_amdgcn_global_load_lds((const unsigned*)(vg + (size_t)(128 * _i) * SEQ + 32 * (KS)), (LAS unsigned*)((BUF) + 16384 + (_i * 8 + wid) * 1024), 16, 0, 0); } while (0)
#define ATT_SCHED __builtin_amdgcn_sched_barrier(0)
            ATT_ISSUE(0, lds);
            asm volatile("s_waitcnt vmcnt(0)" ::: "memory");
            __syncthreads();
            for (int ks = 0; ks < nks; ++ks) {
                LAS unsigned char* cb = lds + (ks & 1) * 32768; LAS unsigned char* nb = lds + ((ks & 1) ^ 1) * 32768;
                if (ks + 1 < nks) ATT_ISSUE(ks + 1, nb);
                if (ks <= 4 * qb + rg) {
                    const bool near = ks >= 4 * qb - 4;
                    LAS unsigned char* kp_ = cb + l32 * 512 + mp * 256;
                    LAS unsigned char* vp_ = cb + 16384 + l32 * 64;
                    const int vo0 = ((0 + hh) ^ yv) << 4, vo1 = ((2 + hh) ^ yv) << 4;
                    h16x8 A0[4], A1[4];
#define LDQK(A, G) do { A[0] = *(LAS h16x8*)(kp_ + (((4 * (G) + hh) ^ xk) << 4)); A[1] = *(LAS h16x8*)(qs + (2 * (G)) * 1024); \
                        A[2] = *(LAS h16x8*)(kp_ + (((4 * (G) + 2 + hh) ^ xk) << 4)); A[3] = *(LAS h16x8*)(qs + (2 * (G) + 1) * 1024); } while (0)
#define LDV(A, D0, VO) do { _Pragma("unroll") for (int _d = 0; _d < 4; ++_d) A[_d] = *(LAS h16x8*)(vp_ + ((D0) + _d) * 2048 + (VO)); } while (0)
#define MMQK(A) do { S0 = __builtin_amdgcn_mfma_f32_32x32x16_f16(A[0], A[1], S0, 0, 0, 0); S0 = __builtin_amdgcn_mfma_f32_32x32x16_f16(A[2], A[3], S0, 0, 0, 0); } while (0)
#define MMV(A, D0, P) do { _Pragma("unroll") for (int _d = 0; _d < 4; ++_d) O[(D0) + _d] = __builtin_amdgcn_mfma_f32_32x32x16_f16(A[_d], P, O[(D0) + _d], 0, 0, 0); } while (0)
                    f32x16 S0;
#pragma unroll
                    for (int r = 0; r < 16; ++r) S0[r] = 0.f;
                    LDQK(A0, 0); ATT_SCHED;
                    LDQK(A1, 1); ATT_SCHED; MMQK(A0); ATT_SCHED;
                    LDQK(A0, 2); ATT_SCHED; MMQK(A1); ATT_SCHED;
                    LDQK(A1, 3); ATT_SCHED; MMQK(A0); ATT_SCHED;
                    LDV(A0, 0, vo0); ATT_SCHED; MMQK(A1); ATT_SCHED;
                    if (near) {
#pragma unroll
                        for (int r = 0; r < 16; ++r) {
                            const int kp = 32 * ks + (r >> 2) * 8 + hh * 4 + (r & 3); const int d0 = qrow - kp;
                            const int di = d0 < 0 ? 0 : (d0 > 128 ? 128 : d0);
                            const float bv = lut[di];
                            S0[r] = d0 < 0 ? -1e30f : S0[r] + bv;
                        }
                    }
                    float mt = S0[0];
#pragma unroll
                    for (int r = 1; r < 16; ++r) mt = fmaxf(mt, S0[r]);
                    mt = fmaxf(mt, __shfl_xor(mt, 32));
                    const float mn = fmaxf(mrun, mt);
                    const float al = __builtin_amdgcn_exp2f(mrun - mn);
                    mrun = mn;
                    float ps = 0.f;
#pragma unroll
                    for (int r = 0; r < 16; ++r) { S0[r] = __builtin_amdgcn_exp2f(S0[r] - mn); ps += S0[r]; }
                    lrun = lrun * al + ps;
                    if (__builtin_amdgcn_ballot_w64(al != 1.0f) != 0ull) {
#pragma unroll
                        for (int i = 0; i < 8; ++i) O[i] = O[i] * al;
                    }
                    h16x8 P0, P1;
#pragma unroll
                    for (int e = 0; e < 8; ++e) { P0[e] = (h16)S0[e]; P1[e] = (h16)S0[8 + e]; }
                    ATT_SCHED;
                    LDV(A1, 4, vo0); ATT_SCHED; MMV(A0, 0, P0); ATT_SCHED;
                    LDV(A0, 0, vo1); ATT_SCHED; MMV(A1, 4, P0); ATT_SCHED;
                    LDV(A1, 4, vo1); ATT_SCHED; MMV(A0, 0, P1); ATT_SCHED;
                    MMV(A1, 4, P1);
#undef LDQK
#undef LDV
#undef MMQK
#undef MMV
                }
                asm volatile("s_waitcnt vmcnt(0)" ::: "memory");
                __syncthreads();
            }
#undef ATT_ISSUE
#undef ATT_SCHED
            lrun += __shfl_xor(lrun, 32);
            const float inv = 1.0f / lrun;
            const int lane2 = otid() & 63, l32b = lane2 & 31, hhb = lane2 >> 5;
            const int obase = (rg * 8) * 16 * 64 + lane2;
            if (mp == 1) {
                float lf;
                { const float* lmp_ = lam; asm volatile("" : "+s"(lmp_)); const GAS float* lmp = (const GAS float*)lmp_;
                  float s1 = 0.f, s2 = 0.f; for (int i = lane2; i < 128; i += 64) { s1 += lmp[i] * lmp[128 + i]; s2 += lmp[256 + i] * lmp[384 + i]; }
                  s1 = wave_sum(s1); s2 = wave_sum(s2); lf = __expf(s1) - __expf(s2) + lambda_init; }
                const float sc = inv * lf;
#pragma unroll
                for (int dvb = 0; dvb < 8; ++dvb)
#pragma unroll
                    for (int r = 0; r < 16; ++r) osh[obase + (dvb * 16 + r) * 64] = O[dvb][r] * sc;
            }
            __syncthreads();
            if (mp == 0) {
                const float* sgp_ = subg; asm volatile("" : "+s"(sgp_)); const GAS float* sgp = (const GAS float*)sgp_;
                float ss = 0.f;
#pragma unroll
                for (int dvb = 0; dvb < 8; ++dvb)
#pragma unroll
                    for (int r = 0; r < 16; ++r) { const float o = O[dvb][r] * inv - osh[obase + (dvb * 16 + r) * 64]; O[dvb][r] = o; ss += o * o; }
                ss += __shfl_xor(ss, 32);
                const float rms = rsqrtf(ss * (1.0f / 256.0f) + 1e-5f) * (1.0f - lambda_init);
                h16* op = AO + ((size_t)b * SEQ + q0 + 32 * rg + l32b) * DM + h * 256 + hhb * 4;
#pragma unroll
                for (int dvb = 0; dvb < 8; ++dvb)
#pragma unroll
                    for (int rq = 0; rq < 4; ++rq) {
                        const int dv0 = dvb * 32 + rq * 8;
                        const f32x4 sg = *(const GAS f32x4*)(sgp + dv0 + hhb * 4);
                        h16x4 o = {(h16)(O[dvb][rq * 4 + 0] * rms * sg[0]), (h16)(O[dvb][rq * 4 + 1] * rms * sg[1]), (h16)(O[dvb][rq * 4 + 2] * rms * sg[2]), (h16)(O[dvb][rq * 4 + 3] * rms * sg[3])};
                        *(h16x4*)(op + dv0) = o;
                    }
            }
        }
    }
}

#define XB_TMO      128
#define XB_XCNT(j)  (256  + 64 * (j))
#define XB_XSUB(j)  (1280 + 64 * (j))
#define XB_XGEN(j)  (2304 + 64 * (j))
#define XB_TOP      3328
#define XB_TOPGEN   3392
#define XCD_BAR_WORDS 3456
#define XB_SPIN_CAP (1u << 18)

__device__ __forceinline__ unsigned xb_ld(unsigned* p)              { return __hip_atomic_load(p, __ATOMIC_RELAXED, __HIP_MEMORY_SCOPE_AGENT); }
__device__ __forceinline__ unsigned xb_add(unsigned* p, unsigned v) { return __hip_atomic_fetch_add(p, v, __ATOMIC_RELAXED, __HIP_MEMORY_SCOPE_AGENT); }
__device__ __forceinline__ unsigned xb_xcc_id() { return (unsigned)__builtin_amdgcn_s_getreg((3 << 11) | 20) & 0xFu; }
#define XB_SPIN(cond, bar) do { unsigned _sp = 0; while (cond) { __builtin_amdgcn_s_sleep(1); \
    if ((++_sp & 255u) == 0u) { if (xb_ld(&(bar)[XB_TMO])) break; if (_sp > XB_SPIN_CAP) { atomicAdd(&(bar)[XB_TMO], 1u); break; } } } } while (0)

struct XcdBarrier {
    unsigned* bar; unsigned x;
    volatile LAS unsigned* st;
};

__device__ __forceinline__ XcdBarrier xcd_barrier_post(unsigned* bar, volatile LAS unsigned* st) {
    XcdBarrier b; b.bar = bar; b.x = xb_xcc_id(); b.st = st;
    if (threadIdx.x == 0) (void)xb_add(&bar[XB_XCNT(b.x)], 1u);
    return b;
}
__device__ __forceinline__ void xcd_barrier_complete(unsigned* bar, unsigned x, unsigned& nloc, unsigned& nx) {
    const unsigned G = gridDim.x * gridDim.y * gridDim.z;
    unsigned sum, cnt, mine, sp = 0u;
    for (;;) {
        sum = 0u; cnt = 0u; mine = 0u;
#pragma unroll
        for (unsigned j = 0; j < 16; ++j) { const unsigned c = xb_ld(&bar[XB_XCNT(j)]); sum += c; cnt += (c > 0u) ? 1u : 0u; mine = (j == x) ? c : mine; }
        if (sum == G) break;
        __builtin_amdgcn_s_sleep(1);
        if ((++sp & 255u) == 0u) { if (xb_ld(&bar[XB_TMO])) break; if (sp > XB_SPIN_CAP) { atomicAdd(&bar[XB_TMO], 1u); break; } }
    }
    nloc = mine > 0u ? mine : 1u; nx = cnt > 0u ? cnt : 1u;
}

__device__ __forceinline__ void xcd_barrier(const XcdBarrier& b) {
    asm volatile("s_waitcnt vmcnt(0)" ::: "memory");
    __syncthreads();
    if (threadIdx.x == 0) {
        unsigned* bar = b.bar;
        __builtin_amdgcn_s_waitcnt(0);
        unsigned nloc = b.st[0], nx = b.st[1];
        if (nloc == 0u) { xcd_barrier_complete(bar, b.x, nloc, nx); b.st[0] = nloc; b.st[1] = nx; }
        const unsigned old = xb_add(&bar[XB_XSUB(b.x)], 1u);
        const unsigned gen = old / nloc;
        if (old + 1u == (gen + 1u) * nloc) {
            __builtin_amdgcn_fence(__ATOMIC_RELEASE, "agent");
            asm volatile("s_waitcnt vmcnt(0)" ::: "memory");
            const unsigned og = xb_add(&bar[XB_TOP], 1u);
            const unsigned tg = og / nx;
            if (og + 1u == (tg + 1u) * nx) xb_add(&bar[XB_TOPGEN], 1u);
            else XB_SPIN(xb_ld(&bar[XB_TOPGEN]) == tg, bar);
            __builtin_amdgcn_fence(__ATOMIC_ACQUIRE, "agent");
            xb_add(&bar[XB_XGEN(b.x)], 1u);
            asm volatile("s_waitcnt vmcnt(0)" ::: "memory");
        } else {
            XB_SPIN(xb_ld(&bar[XB_XGEN(b.x)]) == gen, bar);
            __builtin_amdgcn_fence(__ATOMIC_ACQUIRE, "agent");
            asm volatile("s_waitcnt vmcnt(0)" ::: "memory");
        }
    }
    __syncthreads();
}


__device__ __forceinline__ void gbar(unsigned* ctr, unsigned target) {
    asm volatile("s_waitcnt vmcnt(0)" ::: "memory");
    __syncthreads();
    if (threadIdx.x == 0) {
        __builtin_amdgcn_fence(__ATOMIC_RELEASE, "agent");
        asm volatile("s_waitcnt vmcnt(0)" ::: "memory");
        __hip_atomic_fetch_add(ctr, 1u, __ATOMIC_RELAXED, __HIP_MEMORY_SCOPE_AGENT);
        while (__hip_atomic_load(ctr, __ATOMIC_RELAXED, __HIP_MEMORY_SCOPE_AGENT) < target) __builtin_amdgcn_s_sleep(1);
        __builtin_amdgcn_fence(__ATOMIC_ACQUIRE, "agent");
        asm volatile("s_waitcnt vmcnt(0)" ::: "memory");
    }
    __syncthreads();
}

#ifndef ONLY_GI
#define ENG(k) true
#else
#define ENG(k) ((k) == ONLY_GI)
#endif
#ifndef ONLY_KIND
#define EN(k) true
#else
#define EN(k) ((k) == ONLY_KIND)
#endif
__global__ void __launch_bounds__(512, 2) fwd_megakernel(Params p) {
    extern __shared__ __attribute__((aligned(16))) unsigned char shm[];
    LAS unsigned char* lds = (LAS unsigned char*)shm;
    cg::grid_group grid = cg::this_grid();
    unsigned char* ws = p.ws;
    h16* PRE = (h16*)(ws + WS_PRE); h16* XH = (h16*)(ws + WS_XH); h16* VF = (h16*)(ws + WS_VF);
    unsigned char* R1 = ws + WS_R1; unsigned char* R2 = ws + WS_R2; float* Y = (float*)(ws + WS_Y);
    h16* MIX = (h16*)R1; h16* SIDE = (h16*)R1; h16* AO = (h16*)R1;
    h16* DEC = (h16*)(R1 + R1_DEC); h16* Ab = (h16*)(R1 + R1_A); h16* Gb = (h16*)(R1 + R1_G); h16* AA = (h16*)(R1 + R1_AA); h16* YG = (h16*)(R1 + R1_YG);
    h16* C1 = (h16*)R2; h16* ACT = (h16*)R2; h16* Qb = (h16*)R2; h16* Kb = Qb + (size_t)MTOK * DM; h16* Vt = Kb + (size_t)MTOK * DM;

    volatile LAS unsigned* xst = (volatile LAS unsigned*)(lds + LDS_BYTES - 16);
    if (threadIdx.x == 0) { xst[0] = 0u; xst[1] = 0u; }
    __syncthreads();
    const XcdBarrier xb = xcd_barrier_post((unsigned*)(ws + WS_BAR), xst);
    for (int ph = p.ph_lo; ph < p.ph_hi; ++ph) {
        int layer, kind;
        if (ph < 11) { layer = 0; kind = (int)((0xDCBA9854210ull >> (4 * ph)) & 15ull); }
        else if (ph < 19) { layer = 1; kind = (int)((0xDCBA9876ull >> (4 * (ph - 11))) & 15ull); }
        else if (ph < 29) { layer = 2; kind = (int)((0xDCBA985421ull >> (4 * (ph - 19))) & 15ull); }
        else { layer = 3; kind = (int)((0xDCBA9876ull >> (4 * (ph - 29))) & 15ull); }
        const int j = layer >> 1;
        const char* W = (const char*)(ws + ((layer & 1) ? WS_X : WS_W16));
        const h16* wB1 = (const h16*)(W + W_B1); const h16* wB2 = (const h16*)(W + W_B2); const h16* wWO = (const h16*)(W + W_WO);
        const h16* wUP = (const h16*)(W + W_UP); const h16* wDN = (const h16*)(W + W_DN);
        const int nrep = ((PROBE_MASK >> kind) & 1) ? 2 : 1;
        for (int rep = 0; rep < nrep; ++rep)
        switch (kind) {
        case 0: if (EN(0)) {
            cvt_layer(lds, p, 0);
            ln_phase<false>(p.in[0], nullptr, nullptr, nullptr, XH, p.in[3], MIX);
        } break;
        case 1: if (EN(1)) {
            AMapMix am{(const char*)MIX}; EpiG1 e{C1};
            pg8::gemm_phase(lds, am, DM, wB1, DM, MTOK, j == 0 ? 6912 : 7168, DM, e);
        } break;
        case 2: if (EN(2)) {
            const float* w0 = p.in[5] + (size_t)j * DM; const float* a0 = p.in[8] + (size_t)j * DM; const float* v0 = p.in[11] + (size_t)(j > 0 ? j - 1 : 0) * DM;
            int k2 = 256; asm volatile("" : "+s"(k2));
            if (ENG(0)) { AMapOne am{(const char*)(C1 + 6144)}; EpiG2<0> e{DEC, Ab, Gb, C1, VF, w0, a0, v0, AA, p.in[16] + (size_t)j * DM, p.in[17] + (size_t)j * DM}; pg8::gemm_phase(lds, am, LDC1, wB2, 256, MTOK, DM, k2, e); }
            if (ENG(1)) { AMapOne am{(const char*)(C1 + 6400)}; EpiG2<1> e{DEC, Ab, Gb, C1, VF, w0, a0, v0, AA, p.in[16] + (size_t)j * DM, p.in[17] + (size_t)j * DM}; pg8::gemm_phase(lds, am, LDC1, wB2 + (size_t)2048 * 256, 256, MTOK, DM, k2, e); }
            if (ENG(2)) { AMapOne am{(const char*)(C1 + 6656)}; EpiG2<2> e{DEC, Ab, Gb, C1, VF, w0, a0, v0, AA, p.in[16] + (size_t)j * DM, p.in[17] + (size_t)j * DM}; pg8::gemm_phase(lds, am, LDC1, wB2 + (size_t)4096 * 256, 256, MTOK, DM, k2, e); }
            if (ENG(3) && j > 0) { AMapOne am{(const char*)(C1 + 6912)}; EpiG2<3> e{DEC, Ab, Gb, C1, VF, w0, a0, v0, AA, p.in[16] + (size_t)j * DM, p.in[17] + (size_t)j * DM}; pg8::gemm_phase(lds, am, LDC1, wB2 + (size_t)6144 * 256, 256, MTOK, DM, k2, e); }
        } break;
        case 3: if (EN(3)) prep_phase(C1, Ab, AA, VF, p.in[16] + (size_t)j * DM, p.in[17] + (size_t)j * DM, j == 0); break;
        case 4: if (EN(4)) scan_phase(lds, C1, DEC, AA, Ab, Y, p.in[22] + (size_t)j * DM * 6144, p.in[25] + (size_t)j * DM * DM, p.in[27] + (size_t)(layer + 1) * DM * 2 * FF, p.in[30] + (size_t)(layer + 1) * FF * DM, (char*)(ws + WS_X)); break;
        case 5: if (EN(5)) gn_phase(Y, C1, Gb, YG, p.in[18] + (size_t)j * DM, p.in[19] + (size_t)j * DM, p.in[20] + (size_t)j * DM, j == 0 ? VF : nullptr); break;
        case 6: if (EN(6)) {
            AMapOne am{(const char*)XH}; EpiQKV e{Qb, Kb, Vt};
            pg8::gemm_phase(lds, am, DM, wB1, DM, MTOK, 6144, DM, e);
        } break;
        case 7: if (EN(7)) {
            const float li = layer == 1 ? 0.35550906759096926f : 0.5560581861995943f;
            attn_phase(lds, Qb, Kb, Vt, AO, p.in[26], p.in[23] + (size_t)j * 512, p.in[24] + (size_t)j * 256, li);
        } break;
        case 8: if (EN(8)) {
            AMapOne am{(const char*)((layer & 1) ? AO : YG)}; EpiRes e{XH, PRE};
            pg8::gemm_phase(lds, am, DM, wWO, DM, MTOK, DM, DM, e);
        } break;
        case 9: case 13: if (EN(9)) {
            const int sub = kind == 9 ? 0 : 1;
            const float* g = p.in[1] + (size_t)(layer * 2 + sub) * DM; const float* bt = p.in[2] + (size_t)(layer * 2 + sub) * DM;
            float* xo = nullptr; h16* xh = XH; const float* mu = nullptr; h16* mx = nullptr;
            if (kind == 13) {
                if (layer == 3) { xo = p.out; xh = nullptr; }
                else {
                    if (layer == 1) cvt_layer(lds, p, layer + 1);
                    if (layer == 1) { mu = p.in[3] + (size_t)1 * 6 * DM; mx = MIX; }
                }
            }
            ln_phase<true>(PRE, g, bt, xo, xh, mu, mx);
        } break;
        case 10: if (EN(10)) {
            AMapOne am{(const char*)XH}; EpiUpConv e{ACT, SIDE, p.in[28] + (size_t)layer * 3 * FF, p.in[29] + (size_t)layer * FF};
            pg8::gemm_phase(lds, am, DM, wUP, DM, MTOK, 2 * FF, DM, e);
        } break;
        case 11: if (EN(11)) convfix_phase(SIDE, ACT, p.in[28] + (size_t)layer * 3 * FF, p.in[29] + (size_t)layer * FF); break;
        case 12: if (EN(12)) {
            AMapOne am{(const char*)ACT}; EpiRes e{XH, PRE};
            pg8::gemm_phase(lds, am, FF, wDN, FF, MTOK, DM, FF, e);
        } break;
        }
        if (ph + 1 < p.ph_hi) {
            if (ph == p.ph_lo) grid.sync();
            else xcd_barrier(xb);
        }
    }
}

constexpr int NPHASES = 37;

extern "C" void kernel_launch(void* const* d_in, const int* in_sizes, int n_in, void* d_out, int out_size, void* d_ws, size_t ws_size, hipStream_t stream) {
    static int grid_blocks = 0;
    if (!grid_blocks) {
        if (n_in != 31 || ws_size < WS_END) { fprintf(stderr, "kernel_launch: unexpected n_in %d / ws_size %zu (need %zu)\n", n_in, ws_size, (size_t)WS_END); grid_blocks = -1; return; }
        int dev = 0, cus = 0, per_cu = 0;
        hipGetDevice(&dev);
        hipDeviceGetAttribute(&cus, hipDeviceAttributeMultiprocessorCount, dev);
        if (hipFuncSetAttribute((const void*)fwd_megakernel, hipFuncAttributeMaxDynamicSharedMemorySize, LDS_BYTES) != hipSuccess) { fprintf(stderr, "kernel_launch: hipFuncSetAttribute failed\n"); grid_blocks = -1; return; }
        if (hipOccupancyMaxActiveBlocksPerMultiprocessor(&per_cu, (const void*)fwd_megakernel, 512, LDS_BYTES) != hipSuccess || per_cu < 1) { fprintf(stderr, "kernel_launch: occupancy query gave %d\n", per_cu); per_cu = 1; (void)hipGetLastError(); }
        grid_blocks = cus * per_cu;
        if (grid_blocks > 256) grid_blocks = 256;
    }
    if (grid_blocks < 0) return;
    Params p{};
    for (int i = 0; i < 31; ++i) p.in[i] = (const float*)d_in[i];
    p.out = (float*)d_out; p.ws = (unsigned char*)d_ws; p.ph_lo = 0; p.ph_hi = NPHASES;
    if (hipMemsetAsync((char*)d_ws + WS_BAR, 0, 16384, stream) != hipSuccess) { fprintf(stderr, "kernel_launch: memset failed\n"); return; }
    void* args[] = {&p};
    hipError_t e = hipLaunchCooperativeKernel((const void*)fwd_megakernel, dim3(grid_blocks), dim3(512), args, LDS_BYTES, stream);
    if (e != hipSuccess) fprintf(stderr, "cooperative launch failed: %s (grid %d)\n", hipGetErrorString(e), grid_blocks);
}
```

```cpp
#include <hip/hip_runtime.h>
#include <hip/hip_cooperative_groups.h>
#include <cstdio>
namespace cg = cooperative_groups;

#define LAS __attribute__((address_space(3)))
#define GAS __attribute__((address_space(1)))
typedef _Float16 h16;
typedef _Float16 h16x8 __attribute__((ext_vector_type(8)));
typedef _Float16 h16x4 __attribute__((ext_vector_type(4)));
typedef float f32x4 __attribute__((ext_vector_type(4)));
typedef float f32x2 __attribute__((ext_vector_type(2)));
typedef float f32x16 __attribute__((ext_vector_type(16)));
typedef unsigned u32x4 __attribute__((ext_vector_type(4)));

constexpr int MTOK = 16384, DM = 2048, SEQ = 8192, FF = 5504, LDC1 = 7168;
constexpr float ALPHA = 1.681792830507429f;
constexpr float LOG2E = 1.4426950408889634f;
constexpr float QSCALE = 0.08838834764831845f * LOG2E;
constexpr int LDS_BYTES = 157696;
#define PROBE_MASK 0x0000

constexpr size_t W_B1 = 0, W_B2 = 29360128, W_WO = 33554432, W_UP = 41943040, W_DN = 87031808;
constexpr size_t WS_W16 = 0, WS_X = 117440512, WS_PRE = WS_X + 134217728, WS_XH = WS_PRE + 134217728, WS_VF = WS_XH + 67108864,
                 WS_R1 = WS_VF + 67108864, WS_R2 = WS_R1 + 402653184, WS_Y = WS_R2 + 234881024, WS_BAR = WS_Y + 134217728, WS_END = WS_BAR + 16384;
constexpr size_t R1_DEC = 0, R1_A = 134217728, R1_G = R1_A + 67108864, R1_AA = R1_G + 67108864, R1_YG = R1_AA + 67108864;

struct Params {
    const float* in[31];
    float* out;
    unsigned char* ws;
    int ph_lo, ph_hi;
};

__device__ __forceinline__ int otid() { int t = (int)threadIdx.x; asm volatile("" : "+v"(t)); return t; }
__device__ __forceinline__ int obid() { int t = (int)blockIdx.x; asm volatile("" : "+s"(t)); return t; }
__device__ __forceinline__ float wave_sum(float x) {
#pragma unroll
    for (int o = 32; o >= 1; o >>= 1) x += __shfl_xor(x, o);
    return x;
}
__device__ __forceinline__ float grp16_sum(float x) {
#pragma unroll
    for (int o = 8; o >= 1; o >>= 1) x += __shfl_xor(x, o);
    return x;
}
template <int CTRL> __device__ __forceinline__ float dpp_f(float x) { return __int_as_float(__builtin_amdgcn_update_dpp(0, __float_as_int(x), CTRL, 0xF, 0xF, true)); }
__device__ __forceinline__ float row16_sum(float x) { x += dpp_f<0xB1>(x); x += dpp_f<0x4E>(x); x += dpp_f<0x141>(x); x += dpp_f<0x140>(x); return x; }
__device__ __forceinline__ float sigmoidf_(float x) { return 1.0f / (1.0f + __expf(-x)); }

namespace pg8 {
constexpr int BM = 256, BK = 64, HALF = 128, HTB = HALF * BK * 2, NXCD = 8, WGM = 4;
__device__ __forceinline__ int lds_byte(int r, int c) { const int st = (r >> 4) * 2 + (c >> 5), rr = r & 15, cc = c & 31, ob = rr * 64 + cc * 2; return st * 1024 + (ob ^ (((ob >> 9) & 1) << 5)); }
__device__ __forceinline__ void stage_rc(int b, int& R, int& C) { const int st = b / 1024, sb = b % 1024, swz = sb ^ (((sb >> 9) & 1) << 5); R = (st >> 1) * 16 + swz / 64; C = (st & 1) * 32 + (swz % 64) / 2; }
__device__ __forceinline__ int perm32(int rho) { const int n = rho >> 4, i = rho & 15; return 8 * (i >> 2) + 4 * n + (i & 3); }
struct Unit { int pm, pn; };
struct Order {
    int nM, nN, nwg, G, c;
    __device__ void init(int M, int N, int G_, int c_) { nM = M / BM; nN = N / BM; nwg = nM * nN; G = G_; c = c_; }
    __device__ bool next(int i, Unit& u) const {
        const long L = (long)i * G + c; if (L >= nwg) return false;
        int wgid = (int)L; { const int q = nwg / NXCD, r = nwg % NXCD, xcd = wgid % NXCD, off = wgid / NXCD; wgid = (xcd < r ? xcd * (q + 1) : r * (q + 1) + (xcd - r) * q) + off; }
        const int nig = WGM * nN, gid = wgid / nig, fm = gid * WGM, gsz = (nM - fm) < WGM ? (nM - fm) : WGM;
        u.pm = fm + ((wgid % nig) % gsz); u.pn = (wgid % nig) / gsz; return true;
    }
};

template <class Epi, class AMap>
__device__ __forceinline__ void gemm_phase(LAS unsigned char* lds, const AMap am, const int lda, const h16* Bt, const int ldb, const int M, const int N, const int K, const Epi& E) {
    const int tid = otid(), wid = __builtin_amdgcn_readfirstlane(tid >> 6), lane = tid & 63, wr = wid >> 2, wc = wid & 3, fr = lane & 15, fq = lane >> 4;
    const int nt = K / BK;
    Order S; S.init(M, N, (int)gridDim.x, obid());
    unsigned voffA[2], voffB[2];
#pragma unroll
    for (int i = 0; i < 2; ++i) { int R, C; stage_rc(tid * 16 + i * 8192, R, C); const int Rb = Epi::PERM ? ((R & ~31) + perm32(R & 31)) : R;
        voffA[i] = (unsigned)(R * lda + C) * 2u; voffB[i] = (unsigned)(Rb * ldb + C) * 2u; }
    const size_t kstep = (size_t)(BK * 2);
    const size_t hstepA = (size_t)HALF * lda * 2, hstepB = (size_t)HALF * ldb * 2;
    const size_t tstepA = 2 * hstepA, tstepB = 2 * hstepB;
    const unsigned ldsw = (unsigned)wid * 1024u;
    const int aoff = lds_byte(wr * 64 + fr, fq * 8), boff = lds_byte(wc * 32 + fr, fq * 8);
#define PG8_SA(b, h) (((b) * 2 + (h)) * HTB)
#define PG8_SB(b, h) ((4 + (b) * 2 + (h)) * HTB)
#define PG8_STAGE(bufoff, gbase, voff) do { _Pragma("unroll") for (int _i = 0; _i < 2; ++_i) \
        __builtin_amdgcn_global_load_lds((const unsigned*)((const char*)(gbase) + (voff)[_i]), (LAS unsigned*)(lds + (bufoff) + ldsw + _i * 8192), 16, 0, 0); } while (0)
#define PG8_LDA(dst, b, h) do { _Pragma("unroll") for (int m = 0; m < 4; ++m) _Pragma("unroll") for (int k = 0; k < 2; ++k) dst[m][k] = *(const LAS h16x8*)(lds + PG8_SA(b, h) + aoff + m * 2048 + k * 1024); } while (0)
#define PG8_LDB(dst, b, h) do { _Pragma("unroll") for (int n = 0; n < 2; ++n) _Pragma("unroll") for (int k = 0; k < 2; ++k) dst[n][k] = *(const LAS h16x8*)(lds + PG8_SB(b, h) + boff + n * 2048 + k * 1024); } while (0)
#define PG8_MMA(ai, bj, At, Bt_) do { __builtin_amdgcn_s_setprio(1); _Pragma("unroll") for (int m = 0; m < 4; ++m) _Pragma("unroll") for (int n = 0; n < 2; ++n) _Pragma("unroll") for (int k = 0; k < 2; ++k) \
        acc[ai][bj][m][n] = __builtin_amdgcn_mfma_f32_16x16x32_f16(Bt_[n][k], At[m][k], acc[ai][bj][m][n], 0, 0, 0); __builtin_amdgcn_s_setprio(0); } while (0)
#define PG8_WAIT_V(n) asm volatile("s_waitcnt vmcnt(" #n ")" ::: "memory")
#define PG8_WAIT_L(n) asm volatile("s_waitcnt lgkmcnt(" #n ")" ::: "memory")
#define PG8_BAR __builtin_amdgcn_s_barrier()
#define PG8_SCHED __builtin_amdgcn_sched_barrier(0)
    Unit cur, nxt; int ui = 0;
    if (!S.next(0, cur)) return;
    f32x4 acc[2][2][4][2];
#pragma unroll
    for (int a = 0; a < 2; ++a)
#pragma unroll
        for (int b = 0; b < 2; ++b)
#pragma unroll
            for (int m = 0; m < 4; ++m)
#pragma unroll
                for (int n = 0; n < 2; ++n) acc[a][b][m][n] = (f32x4){0.f, 0.f, 0.f, 0.f};
    h16x8 At[4][2], B0[2][2], B1[2][2];
    const char* cA = am(cur.pn) + (size_t)cur.pm * tstepA; const char* cB = (const char*)Bt + (size_t)cur.pn * tstepB;
    PG8_STAGE(PG8_SB(0, 0), cB, voffB); PG8_STAGE(PG8_SA(0, 0), cA, voffA); PG8_STAGE(PG8_SB(0, 1), cB + hstepB, voffB); PG8_STAGE(PG8_SA(0, 1), cA + hstepA, voffA);
    if (wr == 1) PG8_BAR;
    PG8_WAIT_V(4); PG8_BAR;
    PG8_STAGE(PG8_SB(1, 0), cB + kstep, voffB); PG8_STAGE(PG8_SA(1, 0), cA + kstep, voffA); PG8_STAGE(PG8_SB(1, 1), cB + hstepB + kstep, voffB);
    PG8_WAIT_V(6); PG8_BAR;
    for (;;) {
        const bool has_next = S.next(ui + 1, nxt);
        const char* nA = has_next ? am(nxt.pn) + (size_t)nxt.pm * tstepA : cA; const char* nB = has_next ? (const char*)Bt + (size_t)nxt.pn * tstepB : cB;
#pragma unroll 1
        for (int t = 0; t < nt; t += 2) {
            const bool last = (t == nt - 2);
            const char* a1 = cA + (size_t)(t + 1) * kstep;
            const char* a2 = last ? nA : cA + (size_t)(t + 2) * kstep; const char* b2 = last ? nB : cB + (size_t)(t + 2) * kstep;
            const char* a3 = a2 + kstep; const char* b3 = b2 + kstep;
            PG8_LDB(B0, 0, 0); PG8_SCHED; PG8_LDA(At, 0, 0); PG8_STAGE(PG8_SA(1, 1), a1 + hstepA, voffA);
            PG8_WAIT_L(8); PG8_BAR; PG8_WAIT_L(0); PG8_MMA(0, 0, At, B0); PG8_BAR; PG8_SCHED;
            PG8_LDB(B1, 0, 1); PG8_STAGE(PG8_SB(0, 0), b2, voffB);
            PG8_BAR; PG8_WAIT_L(0); PG8_MMA(0, 1, At, B1); PG8_BAR;
            PG8_LDA(At, 0, 1); PG8_STAGE(PG8_SA(0, 0), a2, voffA);
            PG8_BAR; PG8_WAIT_L(0); PG8_MMA(1, 0, At, B0); PG8_BAR; PG8_SCHED;
            PG8_STAGE(PG8_SB(0, 1), b2 + hstepB, voffB);
            PG8_WAIT_V(6); PG8_BAR; PG8_MMA(1, 1, At, B1); PG8_BAR;
            PG8_LDB(B0, 1, 0); PG8_SCHED; PG8_LDA(At, 1, 0); PG8_STAGE(PG8_SA(0, 1), a2 + hstepA, voffA);
            PG8_WAIT_L(8); PG8_BAR; PG8_WAIT_L(0); PG8_MMA(0, 0, At, B0); PG8_BAR; PG8_SCHED;
            PG8_LDB(B1, 1, 1); PG8_STAGE(PG8_SB(1, 0), b3, voffB);
            PG8_BAR; PG8_WAIT_L(0); PG8_MMA(0, 1, At, B1); PG8_BAR;
            PG8_LDA(At, 1, 1); PG8_STAGE(PG8_SA(1, 0), a3, voffA);
            PG8_BAR; PG8_WAIT_L(0); PG8_MMA(1, 0, At, B0); PG8_BAR; PG8_SCHED;
            PG8_STAGE(PG8_SB(1, 1), b3 + hstepB, voffB);
            PG8_WAIT_V(6); PG8_BAR; PG8_MMA(1, 1, At, B1); PG8_BAR;
        }
        E(acc, cur, wr, wc, fr, fq);
        if (!has_next) break;
#pragma unroll
        for (int a = 0; a < 2; ++a)
#pragma unroll
            for (int b = 0; b < 2; ++b)
#pragma unroll
                for (int m = 0; m < 4; ++m)
#pragma unroll
                    for (int n = 0; n < 2; ++n) acc[a][b][m][n] = (f32x4){0.f, 0.f, 0.f, 0.f};
        cur = nxt; cA = nA; cB = nB; ++ui;
    }
    PG8_WAIT_V(0);
    if (wr == 0) PG8_BAR;
    PG8_BAR;
#undef PG8_SA
#undef PG8_SB
#undef PG8_STAGE
#undef PG8_LDA
#undef PG8_LDB
#undef PG8_MMA
#undef PG8_WAIT_V
#undef PG8_WAIT_L
#undef PG8_BAR
#undef PG8_SCHED
}
}
using pg8::Unit;

__device__ __forceinline__ u32x4 pack8(f32x4 a, f32x4 b) {
    h16x8 v = {(h16)a[0], (h16)a[1], (h16)a[2], (h16)a[3], (h16)b[0], (h16)b[1], (h16)b[2], (h16)b[3]};
    return __builtin_bit_cast(u32x4, v);
}

struct AMapOne { const char* A; __device__ __forceinline__ const char* operator()(int) const { return A; } };
struct AMapMix {
    const char* A;
    __device__ __forceinline__ const char* operator()(int pn) const {
        int idx; if (pn < 8) idx = 0; else if (pn < 16) idx = 2; else if (pn < 24) idx = 3; else if (pn == 24) idx = 1; else if (pn == 25) idx = 4; else if (pn == 26) idx = 5; else idx = 3;
        return A + (size_t)idx * ((size_t)MTOK * DM * 2);
    }
};
struct AMapLora {
    const char* C1;
    __device__ __forceinline__ const char* operator()(int pn) const { return C1 + (size_t)(6144 + 256 * (pn >> 3)) * 2; }
};

#define EPI_ROWS_PERM  const int row0 = u.pm * 256 + wr * 64 + fr; const int colt = u.pn * 256 + wc * 32 + 8 * fq;
struct EpiH16 {
    static constexpr bool PERM = true;
    h16* O; int ldc;
    __device__ __forceinline__ void operator()(const f32x4 (&acc)[2][2][4][2], const Unit& u, int wr, int wc, int fr, int fq) const {
        EPI_ROWS_PERM
#pragma unroll
        for (int ai = 0; ai < 2; ++ai)
#pragma unroll
            for (int m = 0; m < 4; ++m) { h16* rowp = O + (size_t)(row0 + ai * 128 + m * 16) * ldc + colt;
#pragma unroll
                for (int bj = 0; bj < 2; ++bj) *(u32x4*)(rowp + bj * 128) = pack8(acc[ai][bj][m][0], acc[ai][bj][m][1]); }
    }
};
struct EpiG1 {
    static constexpr bool PERM = true;
    h16* O;
    __device__ __forceinline__ void operator()(const f32x4 (&acc)[2][2][4][2], const Unit& u, int wr, int wc, int fr, int fq) const {
        EPI_ROWS_PERM
        const int mode = u.pn == 24 ? 1 : (u.pn == 26 ? 2 : 0);
#pragma unroll
        for (int ai = 0; ai < 2; ++ai)
#pragma unroll
            for (int m = 0; m < 4; ++m) { h16* rowp = O + (size_t)(row0 + ai * 128 + m * 16) * LDC1 + colt;
#pragma unroll
                for (int bj = 0; bj < 2; ++bj) { f32x4 v0 = acc[ai][bj][m][0], v1 = acc[ai][bj][m][1];
                    if (mode == 1) {
#pragma unroll
                        for (int j = 0; j < 4; ++j) { v0[j] = 1.0f - 2.0f / (1.0f + __expf(2.0f * v0[j])); v1[j] = 1.0f - 2.0f / (1.0f + __expf(2.0f * v1[j])); } }
                    else if (mode == 2) {
#pragma unroll
                        for (int j = 0; j < 4; ++j) { v0[j] = sigmoidf_(v0[j]); v1[j] = sigmoidf_(v1[j]); } }
                    *(u32x4*)(rowp + bj * 128) = pack8(v0, v1); } }
    }
};
template <int GI_> struct EpiG2 {
    static constexpr bool PERM = true;
    h16* DEC; h16* Ab; h16* Gb; h16* C1; const h16* VF; const float* w0; const float* a0; const float* v0; h16* AA; const float* k_k; const float* k_a;
    template <int GI>
    __device__ __forceinline__ void body(const f32x4 (&acc)[2][2][4][2], int row0, int colt) const {
#pragma unroll
        for (int bj = 0; bj < 2; ++bj) {
            const int c = colt + bj * 128;
            f32x4 b0 = (f32x4){0.f, 0.f, 0.f, 0.f}, b1 = b0;
            if (GI == 0) { b0 = *(const f32x4*)(w0 + c); b1 = *(const f32x4*)(w0 + c + 4); }
            else if (GI == 1) { b0 = *(const f32x4*)(a0 + c); b1 = *(const f32x4*)(a0 + c + 4); }
            else if (GI == 3) { b0 = *(const f32x4*)(v0 + c); b1 = *(const f32x4*)(v0 + c + 4); }
#pragma unroll
            for (int ai = 0; ai < 2; ++ai)
#pragma unroll
                for (int m = 0; m < 4; ++m) {
                    const size_t row = (size_t)(row0 + ai * 128 + m * 16);
                    f32x4 x0 = acc[ai][bj][m][0] + b0, x1 = acc[ai][bj][m][1] + b1;
                    if (GI == 0) {
#pragma unroll
                        for (int j = 0; j < 4; ++j) {
                            x0[j] = 0.6065306597126334f * sigmoidf_(x0[j]); x1[j] = 0.6065306597126334f * sigmoidf_(x1[j]); }
                        *(u32x4*)(DEC + row * DM + c) = pack8(x0, x1);
                    } else if (GI == 1) {
#pragma unroll
                        for (int j = 0; j < 4; ++j) { x0[j] = sigmoidf_(x0[j]); x1[j] = sigmoidf_(x1[j]); }
                        *(u32x4*)(Ab + row * DM + c) = pack8(x0, x1);
                    } else if (GI == 2) {
                        *(u32x4*)(Gb + row * DM + c) = pack8(x0, x1);
                    } else {
                        h16* vp = C1 + row * LDC1 + 4096 + c;
                        const h16x8 vv = *(const h16x8*)vp; const h16x8 vf = *(const h16x8*)(VF + row * DM + c);
                        f32x4 o0, o1;
#pragma unroll
                        for (int j = 0; j < 4; ++j) { float v = (float)vv[j], f = (float)vf[j]; o0[j] = v + (f - v) * sigmoidf_(x0[j]); v = (float)vv[4 + j]; f = (float)vf[4 + j]; o1[j] = v + (f - v) * sigmoidf_(x1[j]); }
                        *(u32x4*)vp = pack8(o0, o1);
                    }
                    __builtin_amdgcn_sched_barrier(0);
                }
        }
    }
    __device__ __forceinline__ void body_a(const f32x4 (&acc)[2][2][4][2], int row0, int cb0) const {
#pragma unroll
        for (int ai = 0; ai < 2; ++ai)
#pragma unroll
            for (int m = 0; m < 4; ++m) {
                const size_t row = (size_t)(row0 + ai * 128 + m * 16);
                asm volatile("" ::: "memory");
                float a[2][8], kv[2][8], kk[2][8]; float ss = 0.f;
#pragma unroll
                for (int bj = 0; bj < 2; ++bj) {
                    const int c = cb0 + 32 * bj;
                    const f32x4 b0 = *(const f32x4*)(a0 + c), b1 = *(const f32x4*)(a0 + c + 4), q0 = *(const f32x4*)(k_k + c), q1 = *(const f32x4*)(k_k + c + 4);
                    const h16x8 kh = *(const h16x8*)(C1 + row * LDC1 + 2048 + c);
#pragma unroll
                    for (int e = 0; e < 4; ++e) {
                        a[bj][e] = sigmoidf_(acc[ai][bj][m][0][e] + b0[e]); a[bj][4 + e] = sigmoidf_(acc[ai][bj][m][1][e] + b1[e]);
                        kv[bj][e] = (float)kh[e]; kv[bj][4 + e] = (float)kh[4 + e];
                        kk[bj][e] = kv[bj][e] * q0[e]; kk[bj][4 + e] = kv[bj][4 + e] * q1[e];
                        ss += kk[bj][e] * kk[bj][e] + kk[bj][4 + e] * kk[bj][4 + e];
                    }
                }
                ss += __shfl_xor(ss, 16); ss += __shfl_xor(ss, 32);
                const float inv = 1.0f / fmaxf(sqrtf(ss), 1e-12f);
#pragma unroll
                for (int bj = 0; bj < 2; ++bj) {
                    const int c = cb0 + 32 * bj;
                    const f32x4 p0 = *(const f32x4*)(k_a + c), p1 = *(const f32x4*)(k_a + c + 4);
                    f32x4 ko0, ko1, ao0, ao1, bo0, bo1;
#pragma unroll
                    for (int e = 0; e < 4; ++e) {
                        ko0[e] = kv[bj][e] * (1.0f + (a[bj][e] - 1.0f) * p0[e]); ko1[e] = kv[bj][4 + e] * (1.0f + (a[bj][4 + e] - 1.0f) * p1[e]);
                        const float n0_ = kk[bj][e] * inv, n1_ = kk[bj][4 + e] * inv;
                        ao0[e] = -n0_; ao1[e] = -n1_; bo0[e] = n0_ * a[bj][e]; bo1[e] = n1_ * a[bj][4 + e];
                    }
                    *(u32x4*)(C1 + row * LDC1 + 2048 + c) = pack8(ko0, ko1);
                    *(u32x4*)(AA + row * DM + c) = pack8(ao0, ao1);
                    *(u32x4*)(Ab + row * DM + c) = pack8(bo0, bo1);
                }
                __builtin_amdgcn_sched_barrier(0);
            }
    }
    __device__ __forceinline__ void operator()(const f32x4 (&acc)[2][2][4][2], const Unit& u, int wr, int wc, int fr, int fq) const {
        const int row0 = u.pm * 256 + wr * 64 + fr; const int colt = u.pn * 256 + wc * 32 + 8 * fq;
        if (GI_ == 1) body_a(acc, row0, u.pn * 256 + wc * 64 + 8 * fq);
        else body<GI_>(acc, row0, colt);
    }
};
struct EpiRes {
    static constexpr bool PERM = true;
    const h16* X; h16* PRE;
    __device__ __forceinline__ void operator()(const f32x4 (&acc)[2][2][4][2], const Unit& u, int wr, int wc, int fr, int fq) const {
        EPI_ROWS_PERM
#pragma unroll
        for (int ai = 0; ai < 2; ++ai)
#pragma unroll
            for (int m = 0; m < 4; ++m) { const size_t off = (size_t)(row0 + ai * 128 + m * 16) * DM + colt;
#pragma unroll
                for (int bj = 0; bj < 2; ++bj) {
                    const h16x8 x = *(const h16x8*)(X + off + bj * 128);
                    f32x4 o0, o1;
#pragma unroll
                    for (int e = 0; e < 4; ++e) { o0[e] = (float)x[e] * ALPHA + acc[ai][bj][m][0][e]; o1[e] = (float)x[4 + e] * ALPHA + acc[ai][bj][m][1][e]; }
                    *(u32x4*)(PRE + off + bj * 128) = pack8(o0, o1); } }
    }
};
__device__ __forceinline__ float gelu_mul(float u, float gc) {
    const float t = gc * gc;
    const float z = gc * (t * (0.044715f * 1.5957691216057308f * LOG2E) + 1.5957691216057308f * LOG2E);
    return u * gc * __builtin_amdgcn_rcpf(1.0f + __builtin_amdgcn_exp2f(-z));
}
struct EpiUpConv {
    static constexpr bool PERM = true;
    h16* ACT; h16* SIDE; const float* cw; const float* cb;
    __device__ __forceinline__ void operator()(const f32x4 (&acc)[2][2][4][2], const Unit& u, int wr, int wc, int fr, int fq) const {
        const int row0 = u.pm * 256 + wr * 64 + fr, f0 = u.pn * 128 + wc * 32 + 8 * fq;
        f32x4 w0[2], w1[2], w2[2], bb[2];
#pragma unroll
        for (int n = 0; n < 2; ++n) { w0[n] = *(const f32x4*)(cw + f0 + 4 * n); w1[n] = *(const f32x4*)(cw + FF + f0 + 4 * n); w2[n] = *(const f32x4*)(cw + 2 * FF + f0 + 4 * n); bb[n] = *(const f32x4*)(cb + f0 + 4 * n); }
#pragma unroll
        for (int ai = 0; ai < 2; ++ai) {
            f32x4 p1[2], p2[2];
#pragma unroll
            for (int n = 0; n < 2; ++n) { p1[n] = (f32x4){0.f, 0.f, 0.f, 0.f}; p2[n] = p1[n]; }
#pragma unroll
            for (int m = 0; m < 4; ++m) {
                const int row = row0 + ai * 128 + m * 16;
                f32x4 r1[2], r2[2], o[2];
#pragma unroll
                for (int n = 0; n < 2; ++n)
#pragma unroll
                    for (int e = 0; e < 4; ++e) {
                        const float g = acc[ai][1][m][n][e];
                        r1[n][e] = dpp_f<0x121>(g); r2[n][e] = dpp_f<0x122>(g);
                        const float g1 = fr >= 1 ? r1[n][e] : p1[n][e], g2 = fr >= 2 ? r2[n][e] : p2[n][e];
                        const float gc = bb[n][e] + g2 * w0[n][e] + g1 * w1[n][e] + g * w2[n][e];
                        o[n][e] = gelu_mul(acc[ai][0][m][n][e], gc);
                    }
                if (m > 0 || fr >= 2) *(u32x4*)(ACT + (size_t)row * FF + f0) = pack8(o[0], o[1]);
                if (m == 0 && fr < 2) { h16* sp = SIDE + ((size_t)(row >> 6) * 4 + 2 + fr) * (2 * FF) + f0;
                    *(u32x4*)sp = pack8(acc[ai][0][m][0], acc[ai][0][m][1]); *(u32x4*)(sp + FF) = pack8(acc[ai][1][m][0], acc[ai][1][m][1]); }
                if (m == 3 && fr >= 14) { h16* sp = SIDE + ((size_t)(row >> 6) * 4 + (fr - 14)) * (2 * FF) + FF + f0;
                    *(u32x4*)sp = pack8(acc[ai][1][m][0], acc[ai][1][m][1]); }
#pragma unroll
                for (int n = 0; n < 2; ++n) { p1[n] = r1[n]; p2[n] = r2[n]; }
            }
        }
    }
};
__device__ __forceinline__ void convfix_phase(const h16* SIDE, h16* ACT, const float* cw, const float* cb) {
    constexpr int NCG = FF / 8, NT = 256 * 2 * NCG;
    for (int task = obid() * 512 + otid(); task < NT; task += gridDim.x * 512) {
        const int cgi = task % NCG, j = (task / NCG) & 1, gidx = task / (2 * NCG), f = cgi * 8;
        const bool first = (gidx & 127) == 0;
        const h16* cur = SIDE + ((size_t)gidx * 4 + 2 + j) * (2 * FF) + f;
        const h16x8 uh = *(const h16x8*)cur, g0h = *(const h16x8*)(cur + FF);
        h16x8 g1h = {}, g2h = {};
        if (j == 0) { if (!first) { g1h = *(const h16x8*)(SIDE + ((size_t)(gidx - 1) * 4 + 1) * (2 * FF) + FF + f); g2h = *(const h16x8*)(SIDE + ((size_t)(gidx - 1) * 4 + 0) * (2 * FF) + FF + f); } }
        else { g1h = *(const h16x8*)(SIDE + ((size_t)gidx * 4 + 2) * (2 * FF) + FF + f); if (!first) g2h = *(const h16x8*)(SIDE + ((size_t)(gidx - 1) * 4 + 1) * (2 * FF) + FF + f); }
        h16x8 o;
#pragma unroll
        for (int e = 0; e < 8; ++e) {
            const float gc = cb[f + e] + (float)g2h[e] * cw[f + e] + (float)g1h[e] * cw[FF + f + e] + (float)g0h[e] * cw[2 * FF + f + e];
            o[e] = (h16)gelu_mul((float)uh[e], gc);
        }
        *(h16x8*)(ACT + ((size_t)gidx * 64 + j) * FF + f) = o;
    }
}
struct EpiQKV {
    static constexpr bool PERM = true;
    h16* Qb; h16* Kb; h16* Vt;
    __device__ __forceinline__ void operator()(const f32x4 (&acc)[2][2][4][2], const Unit& u, int wr, int wc, int fr, int fq) const {
        const int row0 = u.pm * 256 + wr * 64 + fr; const int part = u.pn >> 3; const int colt = (u.pn & 7) * 256 + wc * 32 + 8 * fq;
#pragma unroll
        for (int ai = 0; ai < 2; ++ai)
#pragma unroll
            for (int m = 0; m < 4; ++m) { const int row = row0 + ai * 128 + m * 16;
#pragma unroll
                for (int bj = 0; bj < 2; ++bj) { const int c = colt + bj * 128;
                    if (part == 0) *(u32x4*)(Qb + (size_t)row * DM + c) = pack8(acc[ai][bj][m][0] * QSCALE, acc[ai][bj][m][1] * QSCALE);
                    else if (part == 1) *(u32x4*)(Kb + (size_t)row * DM + c) = pack8(acc[ai][bj][m][0], acc[ai][bj][m][1]);
                    else {
                        const int b = row >> 13, t = row & 8191, hd = c >> 8, dv = c & 255;
                        const int pos = (t & ~12) | ((t & 4) << 1) | ((t & 8) >> 1);
                        h16* vp = Vt + ((size_t)((b * 8 + hd) * 256 + dv)) * SEQ + pos;
#pragma unroll
                        for (int j = 0; j < 4; ++j) { vp[(size_t)j * SEQ] = (h16)acc[ai][bj][m][0][j]; vp[(size_t)(4 + j) * SEQ] = (h16)acc[ai][bj][m][1][j]; }
                    } } }
    }
};

__device__ __forceinline__ void cvt_job(LAS unsigned char* lds, const float* src, int Ks, int Ns, h16* dst, int Kd, int Nd, int remap = 0) {
    LAS h16* tile = (LAS h16*)lds;
    const int tid = otid(), tk = Kd >> 6, tn = Nd >> 6;
    for (int t = obid(); t < tk * tn; t += gridDim.x) {
        const int k0 = (t % tk) * 64, n0 = (t / tk) * 64;
#pragma unroll
        for (int i = 0; i < 2; ++i) {
            const int idx = tid + 512 * i, kr = idx >> 4, nc = (idx & 15) * 4, k = k0 + kr, n = n0 + nc;
            f32x4 v = (f32x4){0.f, 0.f, 0.f, 0.f};
            if (k < Ks && n < Ns) v = *(const f32x4*)(src + (size_t)k * Ns + n);
            tile[kr * 66 + nc + 0] = (h16)v[0]; tile[kr * 66 + nc + 1] = (h16)v[1]; tile[kr * 66 + nc + 2] = (h16)v[2]; tile[kr * 66 + nc + 3] = (h16)v[3];
        }
        __syncthreads();
        { const int n = tid >> 3, kg = tid & 7; h16x8 o;
#pragma unroll
          for (int e = 0; e < 8; ++e) o[e] = tile[(kg * 8 + e) * 66 + n];
          const int no = n0 + n;
          const int nd = remap == 0 ? no : (remap == 1 ? (no < FF ? (no >> 7) * 256 + (no & 127) : ((no - FF) >> 7) * 256 + 128 + ((no - FF) & 127))
                                                      : ((no & ~255) | ((no & 32) << 2) | ((no & 192) >> 1) | (no & 31)));
          *(h16x8*)(dst + (size_t)nd * Kd + k0 + kg * 8) = o; }
        __syncthreads();
    }
}
__device__ __forceinline__ void cvt_layer(LAS unsigned char* lds, const Params& p, int layer) {
    const bool ffn_here = (layer & 1) != 0;
    h16* W = (h16*)(p.ws + ((layer & 1) ? WS_X : WS_W16));
    const int j = layer >> 1;
    if ((layer & 1) == 0) {
        h16* B1 = (h16*)((char*)W + W_B1); h16* B2 = (h16*)((char*)W + W_B2);
        for (int i = 0; i < 3; ++i) cvt_job(lds, p.in[4] + ((size_t)j * 3 + i) * DM * DM, DM, DM, B1 + (size_t)i * DM * DM, DM, DM);
        cvt_job(lds, p.in[6] + (size_t)j * DM * 96, DM, 96, B1 + (size_t)6144 * DM, DM, 256);
        cvt_job(lds, p.in[9] + (size_t)j * DM * 96, DM, 96, B1 + (size_t)6400 * DM, DM, 256);
        cvt_job(lds, p.in[14] + (size_t)j * DM * 128, DM, 128, B1 + (size_t)6656 * DM, DM, 256);
        cvt_job(lds, p.in[7] + (size_t)j * 96 * DM, 96, DM, B2, 256, DM);
        cvt_job(lds, p.in[10] + (size_t)j * 96 * DM, 96, DM, B2 + (size_t)2048 * 256, 256, DM, 2);
        cvt_job(lds, p.in[15] + (size_t)j * 128 * DM, 128, DM, B2 + (size_t)4096 * 256, 256, DM);
        if (j > 0) {
            cvt_job(lds, p.in[12] + (size_t)(j - 1) * DM * 64, DM, 64, B1 + (size_t)6912 * DM, DM, 256);
            cvt_job(lds, p.in[13] + (size_t)(j - 1) * 64 * DM, 64, DM, B2 + (size_t)6144 * 256, 256, DM);
        }
        cvt_job(lds, p.in[21] + (size_t)j * DM * DM, DM, DM, (h16*)((char*)W + W_WO), DM, DM);
    } else {
        cvt_job(lds, p.in[22] + (size_t)j * DM * 6144, DM, 6144, (h16*)((char*)W + W_B1), DM, 6144);
        cvt_job(lds, p.in[25] + (size_t)j * DM * DM, DM, DM, (h16*)((char*)W + W_WO), DM, DM);
    }
    if (ffn_here) {
        cvt_job(lds, p.in[27] + (size_t)layer * DM * 2 * FF, DM, 2 * FF, (h16*)((char*)W + W_UP), DM, 2 * FF, 1);
        cvt_job(lds, p.in[30] + (size_t)layer * FF * DM, FF, DM, (h16*)((char*)W + W_DN), FF, DM);
    }
}

template <bool LN>
__device__ __forceinline__ void ln_row(const void* src, size_t row, int lane, const float* g, const float* bt, f32x4 (&v)[8]) {
    if (LN) {
        const h16x4* sp = (const h16x4*)((const h16*)src + row * DM);
#pragma unroll
        for (int i = 0; i < 8; ++i) { const h16x4 t = sp[i * 64 + lane]; v[i] = (f32x4){(float)t[0], (float)t[1], (float)t[2], (float)t[3]}; }
        float s = 0.f;
#pragma unroll
        for (int i = 0; i < 8; ++i) s += (v[i][0] + v[i][1]) + (v[i][2] + v[i][3]);
        const float mean = wave_sum(s) * (1.0f / DM);
        float q = 0.f;
#pragma unroll
        for (int i = 0; i < 8; ++i) { v[i] = v[i] - mean; q += (v[i][0] * v[i][0] + v[i][1] * v[i][1]) + (v[i][2] * v[i][2] + v[i][3] * v[i][3]); }
        const float rstd = rsqrtf(wave_sum(q) * (1.0f / DM) + 1e-5f);
#pragma unroll
        for (int i = 0; i < 8; ++i) { const f32x4 gg = ((const f32x4*)g)[i * 64 + lane], bb = ((const f32x4*)bt)[i * 64 + lane]; v[i] = v[i] * rstd * gg + bb; }
    } else {
        const f32x4* sp = (const f32x4*)((const float*)src + row * DM);
#pragma unroll
        for (int i = 0; i < 8; ++i) v[i] = sp[i * 64 + lane];
    }
}
__device__ __forceinline__ void ln_load16(const void* src, size_t row, int lane, h16x4 (&t)[8]) {
    const h16x4* sp = (const h16x4*)((const h16*)src + row * DM);
#pragma unroll
    for (int i = 0; i < 8; ++i) t[i] = sp[i * 64 + lane];
}
__device__ __forceinline__ void ln_apply16(const h16x4 (&t)[8], int lane, const float* g, const float* bt, f32x4 (&v)[8]) {
#pragma unroll
    for (int i = 0; i < 8; ++i) v[i] = (f32x4){(float)t[i][0], (float)t[i][1], (float)t[i][2], (float)t[i][3]};
    float s = 0.f;
#pragma unroll
    for (int i = 0; i < 8; ++i) s += (v[i][0] + v[i][1]) + (v[i][2] + v[i][3]);
    const float mean = wave_sum(s) * (1.0f / DM);
    float q = 0.f;
#pragma unroll
    for (int i = 0; i < 8; ++i) { v[i] = v[i] - mean; q += (v[i][0] * v[i][0] + v[i][1] * v[i][1]) + (v[i][2] * v[i][2] + v[i][3] * v[i][3]); }
    const float rstd = rsqrtf(wave_sum(q) * (1.0f / DM) + 1e-5f);
#pragma unroll
    for (int i = 0; i < 8; ++i) { const f32x4 gg = ((const f32x4*)g)[i * 64 + lane], bb = ((const f32x4*)bt)[i * 64 + lane]; v[i] = v[i] * rstd * gg + bb; }
}
template <bool LN>
__device__ __forceinline__ void ln_phase(const void* src, const float* g, const float* bt, float* xout, h16* xh, const float* mu, h16* mix) {
    const int lane = otid() & 63, gw = obid() * 8 + (otid() >> 6), GW = gridDim.x * 8;
    for (int ch = gw; ch < MTOK / 8; ch += GW) {
        const size_t t0 = (size_t)ch * 8;
        f32x4 prev[8], cur[8];
        if (mix) {
            if ((t0 & (SEQ - 1)) == 0) {
#pragma unroll
                for (int i = 0; i < 8; ++i) prev[i] = (f32x4){0.f, 0.f, 0.f, 0.f};
            } else ln_row<LN>(src, t0 - 1, lane, g, bt, prev);
        }
        h16x4 raw[8], rawn[8];
        if (LN) ln_load16(src, t0, lane, raw);
#pragma unroll 1
        for (int r = 0; r < 8; ++r) {
            const size_t row = t0 + r;
            asm volatile("" ::: "memory");
            if (LN) {
                ln_load16(src, t0 + (r < 7 ? r + 1 : 7), lane, rawn);
                ln_apply16(raw, lane, g, bt, cur);
#pragma unroll
                for (int i = 0; i < 8; ++i) raw[i] = rawn[i];
            } else ln_row<LN>(src, row, lane, g, bt, cur);
            if (xout) {
#pragma unroll
                for (int i = 0; i < 8; ++i) ((f32x4*)(xout + row * DM))[i * 64 + lane] = cur[i];
            }
            if (xh) {
#pragma unroll
                for (int i = 0; i < 8; ++i) { h16x4 o = {(h16)cur[i][0], (h16)cur[i][1], (h16)cur[i][2], (h16)cur[i][3]}; ((h16x4*)(xh + row * DM))[i * 64 + lane] = o; }
            }
            if (mix) {
#pragma unroll
                for (int i = 0; i < 8; ++i) {
                    asm volatile("" ::: "memory");
                    const f32x4 xx = prev[i] - cur[i];
#pragma unroll
                    for (int k = 0; k < 6; ++k) {
                        const f32x4 m4 = ((const f32x4*)(mu + (size_t)k * DM))[i * 64 + lane];
                        const f32x4 o4 = cur[i] + xx * m4;
                        h16x4 o = {(h16)o4[0], (h16)o4[1], (h16)o4[2], (h16)o4[3]};
                        ((h16x4*)(mix + ((size_t)k * MTOK + row) * DM))[i * 64 + lane] = o;
                    }
                    prev[i] = cur[i];
                }
            }
        }
    }
}

__device__ __forceinline__ void prep_phase(h16* C1, h16* Ab, h16* AA, h16* VF, const float* k_k, const float* k_a, bool first) {
    const int lane = otid() & 63, gw = obid() * 8 + (otid() >> 6), GW = gridDim.x * 8;
    for (int row = gw; row < MTOK; row += GW) {
#pragma unroll
        for (int i = 0; i < 8; ++i) {
            const int c = i * 256 + lane * 4;
            h16x4* kp = (h16x4*)(C1 + (size_t)row * LDC1 + 2048 + c);
            h16x4* ap = (h16x4*)(Ab + (size_t)row * DM + c);
            const h16x4 kh = *kp, ah = *ap;
            const f32x4 kkw = *(const f32x4*)(k_k + c), kaw = *(const f32x4*)(k_a + c);
            f32x4 k, a, kk;
#pragma unroll
            for (int e = 0; e < 4; ++e) { k[e] = (float)kh[e]; a[e] = (float)ah[e]; kk[e] = k[e] * kkw[e]; }
            float ss = (kk[0] * kk[0] + kk[1] * kk[1]) + (kk[2] * kk[2] + kk[3] * kk[3]);
            ss = grp16_sum(ss);
            const float inv = 1.0f / fmaxf(sqrtf(ss), 1e-12f);
            h16x4 ko, aao, bbo;
#pragma unroll
            for (int e = 0; e < 4; ++e) { const float kn = kk[e] * inv; ko[e] = (h16)(k[e] * (1.0f + (a[e] - 1.0f) * kaw[e])); aao[e] = (h16)(-kn); bbo[e] = (h16)(kn * a[e]); }
            *kp = ko; *ap = bbo; *(h16x4*)(AA + (size_t)row * DM + c) = aao;
            if (first) *(h16x4*)(VF + (size_t)row * DM + c) = *(const h16x4*)(C1 + (size_t)row * LDC1 + 4096 + c);
        }
    }
}

__device__ __forceinline__ void scan_phase(LAS unsigned char* lds, const h16* C1, const h16* DEC, const h16* AA, const h16* BB, float* Y,
                                           const float* sQKV, const float* sWO, const float* sUP, const float* sDN, char* Wn, const float* sUP0, const float* sDN0, char* Wc) {
    constexpr int CH = 32, NCH = SEQ / CH, BUF = 18976;
    LAS float* L = (LAS float*)lds;
    const int tid = otid(), wid = tid >> 6, lane = tid & 63;
    for (int item = obid(); item < 256; item += gridDim.x) {
        const int b = item >> 7, h = (item >> 2) & 31, q = item & 3;
        const size_t row0 = (size_t)b * SEQ;
        __syncthreads();
        if (wid >= 4) {
            const int lt = tid - 256, s = lt >> 3, e8 = lt & 7;
            struct StReg { h16x8 r8, k8, a8, b8, v8, d8; };
            auto gload = [&](int c) -> StReg {
                StReg R;
                const size_t row = row0 + (size_t)c * CH + s;
                R.r8 = *(const h16x8*)(C1 + row * LDC1 + h * 64 + e8 * 8);
                R.k8 = *(const h16x8*)(C1 + row * LDC1 + 2048 + h * 64 + e8 * 8);
                { const int tn = c * CH + s + 1; const size_t rown = row0 + (size_t)(tn < SEQ ? tn : SEQ - 1);
                  R.a8 = *(const h16x8*)(AA + rown * DM + h * 64 + e8 * 8); }
                R.b8 = *(const h16x8*)(BB + row * DM + h * 64 + e8 * 8);
                R.d8 = *(const h16x8*)(DEC + row * DM + h * 64 + e8 * 8);
                R.v8 = (h16x8){};
                if (lt < 64) R.v8 = *(const h16x8*)(C1 + (row0 + (size_t)c * CH + (lt >> 1)) * LDC1 + 4096 + h * 64 + q * 16 + (lt & 1) * 8);
                return R;
            };
            auto lwrite = [&](const StReg& R, int bufi) {
                LAS float* Bf = L + bufi * BUF;
                LAS float* dst = Bf + s * 64 + e8 * 8;
                *(LAS f32x4*)(dst + 0 * 2048) = (f32x4){(float)R.r8[0], (float)R.r8[1], (float)R.r8[2], (float)R.r8[3]}; *(LAS f32x4*)(dst + 0 * 2048 + 4) = (f32x4){(float)R.r8[4], (float)R.r8[5], (float)R.r8[6], (float)R.r8[7]};
                *(LAS f32x4*)(dst + 1 * 2048) = (f32x4){__expf(-(float)R.d8[0]), __expf(-(float)R.d8[1]), __expf(-(float)R.d8[2]), __expf(-(float)R.d8[3])};
                *(LAS f32x4*)(dst + 1 * 2048 + 4) = (f32x4){__expf(-(float)R.d8[4]), __expf(-(float)R.d8[5]), __expf(-(float)R.d8[6]), __expf(-(float)R.d8[7])};
                *(LAS f32x4*)(dst + 2 * 2048) = (f32x4){(float)R.k8[0], (float)R.k8[1], (float)R.k8[2], (float)R.k8[3]}; *(LAS f32x4*)(dst + 2 * 2048 + 4) = (f32x4){(float)R.k8[4], (float)R.k8[5], (float)R.k8[6], (float)R.k8[7]};
                *(LAS f32x4*)(dst + 3 * 2048) = (f32x4){(float)R.a8[0], (float)R.a8[1], (float)R.a8[2], (float)R.a8[3]}; *(LAS f32x4*)(dst + 3 * 2048 + 4) = (f32x4){(float)R.a8[4], (float)R.a8[5], (float)R.a8[6], (float)R.a8[7]};
                *(LAS f32x4*)(dst + 4 * 2048) = (f32x4){(float)R.b8[0], (float)R.b8[1], (float)R.b8[2], (float)R.b8[3]}; *(LAS f32x4*)(dst + 4 * 2048 + 4) = (f32x4){(float)R.b8[4], (float)R.b8[5], (float)R.b8[6], (float)R.b8[7]};
                { float cp = 0.f;
#pragma unroll
                  for (int e = 0; e < 8; ++e) cp += (float)R.b8[e] * (float)R.a8[e];
                  cp += __shfl_xor(cp, 1); cp += __shfl_xor(cp, 2); cp += __shfl_xor(cp, 4);
                  if (e8 == 0) Bf[18944 + s] = cp; }
                if (lt < 64) { LAS float* vd = Bf + 10240 + (lt >> 1) * 16 + (lt & 1) * 8;
                    *(LAS f32x4*)vd = (f32x4){(float)R.v8[0], (float)R.v8[1], (float)R.v8[2], (float)R.v8[3]}; *(LAS f32x4*)(vd + 4) = (f32x4){(float)R.v8[4], (float)R.v8[5], (float)R.v8[6], (float)R.v8[7]}; }
            };
            auto yout = [&](int c, int bufi) {
#pragma unroll
                for (int o2 = 0; o2 < 2; ++o2) {
                    const int o = lt + 256 * o2, ys = o >> 4, yr = o & 15;
                    LAS float* yp = L + bufi * BUF + 10752 + o * 16;
                    f32x4 acc4 = *(LAS f32x4*)(yp + (((0 + (o >> 2)) & 3) << 2));
#pragma unroll
                    for (int i = 1; i < 4; ++i) acc4 += *(LAS f32x4*)(yp + (((i + (o >> 2)) & 3) << 2));
                    Y[(row0 + (size_t)c * CH + ys) * DM + h * 64 + q * 16 + yr] = (acc4[0] + acc4[1]) + (acc4[2] + acc4[3]);
                }
            };
            const int lw = (lt >> 6), wgl = item * 4 + lw;
            LAS h16* ctile = (LAS h16*)(lds + 2 * BUF * 4) + lw * 512;
            f32x4 cv0 = (f32x4){0.f, 0.f, 0.f, 0.f}, cv1 = cv0; h16* cdst = nullptr;
            auto cvt_issue = [&](int tix) {
                constexpr int T0 = 128 * 192, T1 = 128 * 64, T2 = 128 * 344, T3 = 344 * 64;
                cdst = nullptr;
                if (tix >= T0 + T1 + 2 * (T2 + T3)) return;
                const float* src; h16* dst; int Ks, Ns, rm = 0, t = tix;
                if (t >= T0 + T1 + T2 + T3) {
                    t -= T0 + T1 + T2 + T3;
                    if (t < T2) { src = sUP0; dst = (h16*)(Wc + W_UP); Ks = DM; Ns = 2 * FF; rm = 1; }
                    else { t -= T2; src = sDN0; dst = (h16*)(Wc + W_DN); Ks = FF; Ns = DM; }
                }
                else if (t < T0) { src = sQKV; dst = (h16*)(Wn + W_B1); Ks = DM; Ns = 6144; }
                else if (t < T0 + T1) { t -= T0; src = sWO; dst = (h16*)(Wn + W_WO); Ks = DM; Ns = DM; }
                else if (t < T0 + T1 + T2) { t -= T0 + T1; src = sUP; dst = (h16*)(Wn + W_UP); Ks = DM; Ns = 2 * FF; rm = 1; }
                else { t -= T0 + T1 + T2; src = sDN; dst = (h16*)(Wn + W_DN); Ks = FF; Ns = DM; }
                const int tk = Ks >> 4, k0 = (t % tk) * 16, n0 = (t / tk) * 32;
                const int ln = lt & 63, kr = ln >> 3, nc = (ln & 7) * 4;
                cv0 = *(const f32x4*)(src + (size_t)(k0 + kr) * Ns + n0 + nc); cv1 = *(const f32x4*)(src + (size_t)(k0 + kr + 8) * Ns + n0 + nc);
                const int n = ln & 31, hf = ln >> 5, no = n0 + n;
                const int nd = rm == 0 ? no : (no < FF ? (no >> 7) * 256 + (no & 127) : ((no - FF) >> 7) * 256 + 128 + ((no - FF) & 127));
                cdst = dst + (size_t)nd * Ks + k0 + hf * 8;
            };
            auto cvt_finish = [&]() {
                if (cdst == nullptr) return;
                const int ln = lt & 63, kr = ln >> 3, nc = (ln & 7) * 4;
#pragma unroll
                for (int e = 0; e < 4; ++e) { ctile[(nc + e) * 16 + kr] = (h16)cv0[e]; ctile[(nc + e) * 16 + kr + 8] = (h16)cv1[e]; }
                asm volatile("s_waitcnt lgkmcnt(0)" ::: "memory");
                const h16x8 o = *(LAS h16x8*)(ctile + (ln & 31) * 16 + (ln >> 5) * 8);
                *(h16x8*)cdst = o;
                asm volatile("s_waitcnt lgkmcnt(0)" ::: "memory");
            };
            { const StReg R0 = gload(0); lwrite(R0, 0); }
            StReg RA = gload(1);
            __syncthreads();
            for (int c = 0; c < NCH; ++c) {
                StReg RB = RA;
                if (c + 2 < NCH) RB = gload(c + 2);
                if (c + 1 < NCH) lwrite(RA, (c + 1) & 1);
                if (c > 0) yout(c - 1, (c - 1) & 1);
                if (Wn) { cvt_finish(); cvt_issue(wgl + 1024 * c); }
                asm volatile("s_waitcnt lgkmcnt(0)" ::: "memory");
                __builtin_amdgcn_s_barrier();
                asm volatile("" ::: "memory");
                RA = RB;
            }
            yout(NCH - 1, (NCH - 1) & 1);
            if (Wn) cvt_finish();
        } else {
            const int jg = lane & 15, rl = wid * 4 + (lane >> 4);
            f32x2 Sa = (f32x2){0.f, 0.f}, Sb = (f32x2){0.f, 0.f};
            float sa = 0.f;
            __syncthreads();
            for (int c = 0; c < NCH; ++c) {
                LAS float* Bf = L + (c & 1) * BUF;
                LAS float* vec = Bf + jg * 4;
                f32x4 r4 = *(LAS f32x4*)(vec + 0 * 2048), w4 = *(LAS f32x4*)(vec + 1 * 2048), k4 = *(LAS f32x4*)(vec + 2 * 2048), a4 = *(LAS f32x4*)(vec + 3 * 2048), b4 = *(LAS f32x4*)(vec + 4 * 2048);
                float v = Bf[10240 + rl], cn = Bf[18944];
#pragma unroll 1
                for (int s0 = 0; s0 < CH; s0 += 8) {
                    float yv[8];
#pragma unroll
                    for (int u = 0; u < 8; ++u) {
                        const int s = s0 + u, sn = (s + 1 < CH) ? s + 1 : CH - 1;
                        const f32x4 r4n = *(LAS f32x4*)(vec + 0 * 2048 + sn * 64), w4n = *(LAS f32x4*)(vec + 1 * 2048 + sn * 64), k4n = *(LAS f32x4*)(vec + 2 * 2048 + sn * 64),
                                    a4n = *(LAS f32x4*)(vec + 3 * 2048 + sn * 64), b4n = *(LAS f32x4*)(vec + 4 * 2048 + sn * 64);
                        const float vn = Bf[10240 + sn * 16 + rl], cnn = Bf[18944 + sn];
                        const f32x2 aL = {a4[0], a4[1]}, aH = {a4[2], a4[3]}, wL = {w4[0], w4[1]}, wH = {w4[2], w4[3]}, kL = {k4[0], k4[1]}, kH = {k4[2], k4[3]},
                                    bL = {b4[0], b4[1]}, bH = {b4[2], b4[3]}, rL = {r4[0], r4[1]}, rH = {r4[2], r4[3]};
                        const f32x2 uL = Sa * wL + kL * v, uH = Sb * wH + kH * v;
                        const f32x2 dz = uL * aL + uH * aH;
                        const float z = row16_sum(dz[0] + dz[1]);
                        Sa = bL * sa + uL; Sb = bH * sa + uH;
                        const f32x2 dr = Sa * rL + Sb * rH;
                        yv[u] = dr[0] + dr[1];
                        sa = z + cn * sa;
                        r4 = r4n; w4 = w4n; k4 = k4n; a4 = a4n; b4 = b4n; v = vn; cn = cnn;
                    }
#pragma unroll
                    for (int u = 0; u < 8; ++u) Bf[10752 + ((s0 + u) * 16 + rl) * 16 + jg] = yv[u];
                }
                __syncthreads();
            }
        }
    }
}

__device__ __forceinline__ void gn_phase(const float* Y, const h16* C1, const h16* Gb, h16* YG, const float* r_k, const float* lnx_g, const float* lnx_b, h16* VFw) {
    const int lane = otid() & 63, gw = obid() * 8 + (otid() >> 6), GW = gridDim.x * 8;
    for (int row = gw; row < MTOK; row += GW) {
#pragma unroll
        for (int i = 0; i < 8; ++i) {
            const int c = i * 256 + lane * 4;
            const f32x4 y = *(const f32x4*)(Y + (size_t)row * DM + c);
            const h16x4 rh = *(const h16x4*)(C1 + (size_t)row * LDC1 + c), kh = *(const h16x4*)(C1 + (size_t)row * LDC1 + 2048 + c), vh = *(const h16x4*)(C1 + (size_t)row * LDC1 + 4096 + c);
            const h16x4 gh = *(const h16x4*)(Gb + (size_t)row * DM + c);
            const f32x4 rk = *(const f32x4*)(r_k + c), lg = *(const f32x4*)(lnx_g + c), lb = *(const f32x4*)(lnx_b + c);
            float s = (y[0] + y[1]) + (y[2] + y[3]);
            const float mean = grp16_sum(s) * (1.0f / 64.0f);
            const f32x4 d = y - mean;
            float qv = (d[0] * d[0] + d[1] * d[1]) + (d[2] * d[2] + d[3] * d[3]);
            const float rstd = rsqrtf(grp16_sum(qv) * (1.0f / 64.0f) + 64e-5f);
            float bs = 0.f;
#pragma unroll
            for (int e = 0; e < 4; ++e) bs += (float)rh[e] * (float)kh[e] * rk[e];
            bs = grp16_sum(bs);
            h16x4 o;
#pragma unroll
            for (int e = 0; e < 4; ++e) o[e] = (h16)((d[e] * rstd * lg[e] + lb[e] + bs * (float)vh[e]) * (float)gh[e]);
            *(h16x4*)(YG + (size_t)row * DM + c) = o;
            if (VFw) *(h16x4*)(VFw + (size_t)row * DM + c) = vh;
        }
    }
}

__device__ __forceinline__ void convglu_phase(const h16* U, h16* ACT, const float* cw, const float* cb) {
    constexpr int NCG = FF / 8, RC = 16, NT = (MTOK / RC) * NCG;
    for (int task = obid() * 512 + otid(); task < NT; task += gridDim.x * 512) {
        const int cgi = task % NCG, rc = task / NCG, f = cgi * 8, m0 = rc * RC;
        float w0[8], w1[8], w2[8], bb[8], g1[8], g2[8];
#pragma unroll
        for (int e = 0; e < 8; ++e) { w0[e] = cw[f + e]; w1[e] = cw[FF + f + e]; w2[e] = cw[2 * FF + f + e]; bb[e] = cb[f + e]; g1[e] = 0.f; g2[e] = 0.f; }
        if ((m0 & (SEQ - 1)) != 0) {
            const h16x8 a = *(const h16x8*)(U + (size_t)(m0 - 1) * (2 * FF) + FF + f), c2 = *(const h16x8*)(U + (size_t)(m0 - 2) * (2 * FF) + FF + f);
#pragma unroll
            for (int e = 0; e < 8; ++e) { g1[e] = (float)a[e]; g2[e] = (float)c2[e]; }
        }
        for (int r = 0; r < RC; ++r) {
            const size_t m = (size_t)(m0 + r);
            const h16x8 uh = *(const h16x8*)(U + m * (2 * FF) + f), gh = *(const h16x8*)(U + m * (2 * FF) + FF + f);
            h16x8 o;
#pragma unroll
            for (int e = 0; e < 8; ++e) {
                const float g0 = (float)gh[e];
                const float gc = bb[e] + g2[e] * w0[e] + g1[e] * w1[e] + g0 * w2[e];
                const float z = 1.5957691216057308f * (gc + 0.044715f * gc * gc * gc);
                const float ge = gc / (1.0f + __expf(-z));
                o[e] = (h16)((float)uh[e] * ge);
                g2[e] = g1[e]; g1[e] = g0;
            }
            *(h16x8*)(ACT + m * FF + f) = o;
        }
    }
}

__device__ __forceinline__ void attn_phase(LAS unsigned char* lds, const h16* Qb, const h16* Kb, const h16* Vt, h16* AO, const float* rel_bias, const float* lam, const float* subg, float lambda_init) {
    const int wid = __builtin_amdgcn_readfirstlane(otid() >> 6), rg = wid & 3, mp = wid >> 2;
    LAS float* lut = (LAS float*)(lds + 131072);
    LAS float* osh = (LAS float*)lds;
    for (int vc = obid(); vc < 256; vc += gridDim.x) {
        const int bh = vc & 15, jj = vc >> 4, b = bh >> 3, h = bh & 7;
        for (int it = 0; it < 4; ++it) {
            const int qb = it == 0 ? 63 - jj : (it == 1 ? 32 + jj : (it == 2 ? 31 - jj : jj));
            __syncthreads();
            const int tid = otid(), lane = tid & 63, l32 = lane & 31, hh = lane >> 5;
            const int xk = l32 & 15, yv = (l32 >> 2) & 3;
            if (tid <= 128) {
                const float* rbp_ = rel_bias; asm volatile("" : "+s"(rbp_)); const GAS float* rbp = (const GAS float*)rbp_;
                float val = 0.f;
                if (tid < 128) { int bk = tid; if (tid >= 16) { bk = 16 + (int)(__logf((float)tid * (1.0f / 16.0f)) / 2.0794415416798357f * 16.0f); bk = bk > 31 ? 31 : bk; }
                    val = (rbp[bk * 8 + h] - rbp[31 * 8 + h]) * LOG2E; }
                lut[tid] = val;
            }
            const int q0 = qb * 128, qrow = q0 + 32 * rg + l32;
            const size_t tokbase = (size_t)b * SEQ;
            LAS unsigned char* qs = lds + 65536 + wid * 8192 + lane * 16;
            { const h16* qp = Qb + (tokbase + qrow) * DM + h * 256 + mp * 128 + hh * 8;
              h16x8 qf[8];
#pragma unroll
              for (int k = 0; k < 8; ++k) qf[k] = *(const h16x8*)(qp + k * 16);
#pragma unroll
              for (int k = 0; k < 8; ++k) *(LAS h16x8*)(qs + k * 1024) = qf[k]; }
            f32x16 O[8];
#pragma unroll
            for (int i = 0; i < 8; ++i)
#pragma unroll
                for (int r = 0; r < 16; ++r) O[i][r] = 0.f;
            float mrun = -1e30f, lrun = 0.f;
            const int nks = 4 * qb + 4;
            const int kkey = wid * 2 + (lane >> 5);
            const h16* kg = Kb + (tokbase + kkey) * DM + h * 256 + (((lane & 31) ^ (kkey & 15)) << 3);
            const int vdv = wid * 16 + (lane >> 2);
            const h16* vg = Vt + ((size_t)((b * 8 + h) * 256) + vdv) * SEQ + (((lane & 3) ^ ((lane >> 4) & 3)) << 3);
#define ATT_ISSUE(KS, BUF) do { _Pragma("unroll") for (int _i = 0; _i < 2; ++_i) \
                __builtin_amdgcn_global_load_lds((const unsigned*)(kg + (size_t)(32 * (KS) + 16 * _i) * DM), (LAS unsigned*)((BUF) + (_i * 8 + wid) * 1024), 16, 0, 0); \
              _Pragma("unroll") for (int _i = 0; _i < 2; ++_i) \
                __builtin_amdgcn_global_load_lds((const unsigned*)(vg + (size_t)(128 * _i) * SEQ + 32 * (KS)), (LAS unsigned*)((BUF) + 16384 + (_i * 8 + wid) * 1024), 16, 0, 0); } while (0)
#define ATT_SCHED __builtin_amdgcn_sched_barrier(0)
            ATT_ISSUE(0, lds);
            asm volatile("s_waitcnt vmcnt(0)" ::: "memory");
            __syncthreads();
            for (int ks = 0; ks < nks; ++ks) {
                LAS unsigned char* cb = lds + (ks & 1) * 32768; LAS unsigned char* nb = lds + ((ks & 1) ^ 1) * 32768;
                if (ks + 1 < nks) ATT_ISSUE(ks + 1, nb);
                if (ks <= 4 * qb + rg) {
                    const bool near = ks >= 4 * qb - 4;
                    LAS unsigned char* kp_ = cb + l32 * 512 + mp * 256;
                    LAS unsigned char* vp_ = cb + 16384 + l32 * 64;
                    const int vo0 = ((0 + hh) ^ yv) << 4, vo1 = ((2 + hh) ^ yv) << 4;
                    h16x8 A0[4], A1[4];
#define LDQK(A, G) do { A[0] = *(LAS h16x8*)(kp_ + (((4 * (G) + hh) ^ xk) << 4)); A[1] = *(LAS h16x8*)(qs + (2 * (G)) * 1024); \
                        A[2] = *(LAS h16x8*)(kp_ + (((4 * (G) + 2 + hh) ^ xk) << 4)); A[3] = *(LAS h16x8*)(qs + (2 * (G) + 1) * 1024); } while (0)
#define LDV(A, D0, VO) do { _Pragma("unroll") for (int _d = 0; _d < 4; ++_d) A[_d] = *(LAS h16x8*)(vp_ + ((D0) + _d) * 2048 + (VO)); } while (0)
#define MMQK(A) do { S0 = __builtin_amdgcn_mfma_f32_32x32x16_f16(A[0], A[1], S0, 0, 0, 0); S0 = __builtin_amdgcn_mfma_f32_32x32x16_f16(A[2], A[3], S0, 0, 0, 0); } while (0)
#define MMV(A, D0, P) do { _Pragma("unroll") for (int _d = 0; _d < 4; ++_d) O[(D0) + _d] = __builtin_amdgcn_mfma_f32_32x32x16_f16(A[_d], P, O[(D0) + _d], 0, 0, 0); } while (0)
                    f32x16 S0;
#pragma unroll
                    for (int r = 0; r < 16; ++r) S0[r] = 0.f;
                    LDQK(A0, 0); ATT_SCHED;
                    LDQK(A1, 1); ATT_SCHED; MMQK(A0); ATT_SCHED;
                    LDQK(A0, 2); ATT_SCHED; MMQK(A1); ATT_SCHED;
                    LDQK(A1, 3); ATT_SCHED; MMQK(A0); ATT_SCHED;
                    LDV(A0, 0, vo0); ATT_SCHED; MMQK(A1); ATT_SCHED;
                    if (near) {
#pragma unroll
                        for (int r = 0; r < 16; ++r) {
                            const int kp = 32 * ks + (r >> 2) * 8 + hh * 4 + (r & 3); const int d0 = qrow - kp;
                            const int di = d0 < 0 ? 0 : (d0 > 128 ? 128 : d0);
                            const float bv = lut[di];
                            S0[r] = d0 < 0 ? -1e30f : S0[r] + bv;
                        }
                    }
                    float mt = S0[0];
#pragma unroll
                    for (int r = 1; r < 16; ++r) mt = fmaxf(mt, S0[r]);
                    mt = fmaxf(mt, __shfl_xor(mt, 32));
                    const float mn = fmaxf(mrun, mt);
                    const float al = __builtin_amdgcn_exp2f(mrun - mn);
                    mrun = mn;
                    float ps = 0.f;
#pragma unroll
                    for (int r = 0; r < 16; ++r) { S0[r] = __builtin_amdgcn_exp2f(S0[r] - mn); ps += S0[r]; }
                    lrun = lrun * al + ps;
                    if (__builtin_amdgcn_ballot_w64(al != 1.0f) != 0ull) {
#pragma unroll
                        for (int i = 0; i < 8; ++i) O[i] = O[i] * al;
                    }
                    h16x8 P0, P1;
#pragma unroll
                    for (int e = 0; e < 8; ++e) { P0[e] = (h16)S0[e]; P1[e] = (h16)S0[8 + e]; }
                    ATT_SCHED;
                    LDV(A1, 4, vo0); ATT_SCHED; MMV(A0, 0, P0); ATT_SCHED;
                    LDV(A0, 0, vo1); ATT_SCHED; MMV(A1, 4, P0); ATT_SCHED;
                    LDV(A1, 4, vo1); ATT_SCHED; MMV(A0, 0, P1); ATT_SCHED;
                    MMV(A1, 4, P1);
#undef LDQK
#undef LDV
#undef MMQK
#undef MMV
                }
                asm volatile("s_waitcnt vmcnt(0)" ::: "memory");
                __syncthreads();
            }
#undef ATT_ISSUE
#undef ATT_SCHED
            lrun += __shfl_xor(lrun, 32);
            const float inv = 1.0f / lrun;
            const int lane2 = otid() & 63, l32b = lane2 & 31, hhb = lane2 >> 5;
            const int obase = (rg * 8) * 16 * 64 + lane2;
            if (mp == 1) {
                float lf;
                { const float* lmp_ = lam; asm volatile("" : "+s"(lmp_)); const GAS float* lmp = (const GAS float*)lmp_;
                  float s1 = 0.f, s2 = 0.f; for (int i = lane2; i < 128; i += 64) { s1 += lmp[i] * lmp[128 + i]; s2 += lmp[256 + i] * lmp[384 + i]; }
                  s1 = wave_sum(s1); s2 = wave_sum(s2); lf = __expf(s1) - __expf(s2) + lambda_init; }
                const float sc = inv * lf;
#pragma unroll
                for (int dvb = 0; dvb < 8; ++dvb)
#pragma unroll
                    for (int r = 0; r < 16; ++r) osh[obase + (dvb * 16 + r) * 64] = O[dvb][r] * sc;
            }
            __syncthreads();
            if (mp == 0) {
                const float* sgp_ = subg; asm volatile("" : "+s"(sgp_)); const GAS float* sgp = (const GAS float*)sgp_;
                float ss = 0.f;
#pragma unroll
                for (int dvb = 0; dvb < 8; ++dvb)
#pragma unroll
                    for (int r = 0; r < 16; ++r) { const float o = O[dvb][r] * inv - osh[obase + (dvb * 16 + r) * 64]; O[dvb][r] = o; ss += o * o; }
                ss += __shfl_xor(ss, 32);
                const float rms = rsqrtf(ss * (1.0f / 256.0f) + 1e-5f) * (1.0f - lambda_init);
                h16* op = AO + ((size_t)b * SEQ + q0 + 32 * rg + l32b) * DM + h * 256 + hhb * 4;
#pragma unroll
                for (int dvb = 0; dvb < 8; ++dvb)
#pragma unroll
                    for (int rq = 0; rq < 4; ++rq) {
                        const int dv0 = dvb * 32 + rq * 8;
                        const f32x4 sg = *(const GAS f32x4*)(sgp + dv0 + hhb * 4);
                        h16x4 o = {(h16)(O[dvb][rq * 4 + 0] * rms * sg[0]), (h16)(O[dvb][rq * 4 + 1] * rms * sg[1]), (h16)(O[dvb][rq * 4 + 2] * rms * sg[2]), (h16)(O[dvb][rq * 4 + 3] * rms * sg[3])};
                        *(h16x4*)(op + dv0) = o;
                    }
            }
        }
    }
}

#define XB_TMO      128
#define XB_XCNT(j)  (256  + 64 * (j))
#define XB_XSUB(j)  (1280 + 64 * (j))
#define XB_XGEN(j)  (2304 + 64 * (j))
#define XB_TOP      3328
#define XB_TOPGEN   3392
#define XCD_BAR_WORDS 3456
#define XB_SPIN_CAP (1u << 18)

__device__ __forceinline__ unsigned xb_ld(unsigned* p)              { return __hip_atomic_load(p, __ATOMIC_RELAXED, __HIP_MEMORY_SCOPE_AGENT); }
__device__ __forceinline__ unsigned xb_add(unsigned* p, unsigned v) { return __hip_atomic_fetch_add(p, v, __ATOMIC_RELAXED, __HIP_MEMORY_SCOPE_AGENT); }
__device__ __forceinline__ unsigned xb_xcc_id() { return (unsigned)__builtin_amdgcn_s_getreg((3 << 11) | 20) & 0xFu; }
#define XB_SPIN(cond, bar) do { unsigned _sp = 0; while (cond) { __builtin_amdgcn_s_sleep(1); \
    if ((++_sp & 255u) == 0u) { if (xb_ld(&(bar)[XB_TMO])) break; if (_sp > XB_SPIN_CAP) { atomicAdd(&(bar)[XB_TMO], 1u); break; } } } } while (0)

struct XcdBarrier {
    unsigned* bar; unsigned x;
    volatile LAS unsigned* st;
};

__device__ __forceinline__ XcdBarrier xcd_barrier_post(unsigned* bar, volatile LAS unsigned* st) {
    XcdBarrier b; b.bar = bar; b.x = xb_xcc_id(); b.st = st;
    if (threadIdx.x == 0) (void)xb_add(&bar[XB_XCNT(b.x)], 1u);
    return b;
}
__device__ __forceinline__ void xcd_barrier_complete(unsigned* bar, unsigned x, unsigned& nloc, unsigned& nx) {
    const unsigned G = gridDim.x * gridDim.y * gridDim.z;
    unsigned sum, cnt, mine, sp = 0u;
    for (;;) {
        sum = 0u; cnt = 0u; mine = 0u;
#pragma unroll
        for (unsigned j = 0; j < 16; ++j) { const unsigned c = xb_ld(&bar[XB_XCNT(j)]); sum += c; cnt += (c > 0u) ? 1u : 0u; mine = (j == x) ? c : mine; }
        if (sum == G) break;
        __builtin_amdgcn_s_sleep(1);
        if ((++sp & 255u) == 0u) { if (xb_ld(&bar[XB_TMO])) break; if (sp > XB_SPIN_CAP) { atomicAdd(&bar[XB_TMO], 1u); break; } }
    }
    nloc = mine > 0u ? mine : 1u; nx = cnt > 0u ? cnt : 1u;
}

__device__ __forceinline__ void xcd_barrier(const XcdBarrier& b) {
    asm volatile("s_waitcnt vmcnt(0)" ::: "memory");
    __syncthreads();
    if (threadIdx.x == 0) {
        unsigned* bar = b.bar;
        __builtin_amdgcn_s_waitcnt(0);
        unsigned nloc = b.st[0], nx = b.st[1];
        if (nloc == 0u) { xcd_barrier_complete(bar, b.x, nloc, nx); b.st[0] = nloc; b.st[1] = nx; }
        const unsigned old = xb_add(&bar[XB_XSUB(b.x)], 1u);
        const unsigned gen = old / nloc;
        if (old + 1u == (gen + 1u) * nloc) {
            __builtin_amdgcn_fence(__ATOMIC_RELEASE, "agent");
            asm volatile("s_waitcnt vmcnt(0)" ::: "memory");
            const unsigned og = xb_add(&bar[XB_TOP], 1u);
            const unsigned tg = og / nx;
            if (og + 1u == (tg + 1u) * nx) xb_add(&bar[XB_TOPGEN], 1u);
            else XB_SPIN(xb_ld(&bar[XB_TOPGEN]) == tg, bar);
            __builtin_amdgcn_fence(__ATOMIC_ACQUIRE, "agent");
            xb_add(&bar[XB_XGEN(b.x)], 1u);
            asm volatile("s_waitcnt vmcnt(0)" ::: "memory");
        } else {
            XB_SPIN(xb_ld(&bar[XB_XGEN(b.x)]) == gen, bar);
            __builtin_amdgcn_fence(__ATOMIC_ACQUIRE, "agent");
            asm volatile("s_waitcnt vmcnt(0)" ::: "memory");
        }
    }
    __syncthreads();
}


__device__ __forceinline__ void gbar(unsigned* ctr, unsigned target) {
    asm volatile("s_waitcnt vmcnt(0)" ::: "memory");
    __syncthreads();
    if (threadIdx.x == 0) {
        __builtin_amdgcn_fence(__ATOMIC_RELEASE, "agent");
        asm volatile("s_waitcnt vmcnt(0)" ::: "memory");
        __hip_atomic_fetch_add(ctr, 1u, __ATOMIC_RELAXED, __HIP_MEMORY_SCOPE_AGENT);
        while (__hip_atomic_load(ctr, __ATOMIC_RELAXED, __HIP_MEMORY_SCOPE_AGENT) < target) __builtin_amdgcn_s_sleep(1);
        __builtin_amdgcn_fence(__ATOMIC_ACQUIRE, "agent");
        asm volatile("s_waitcnt vmcnt(0)" ::: "memory");
    }
    __syncthreads();
}

#ifndef ONLY_GI
#define ENG(k) true
#else
#define ENG(k) ((k) == ONLY_GI)
#endif
#ifndef ONLY_KIND
#define EN(k) true
#else
#define EN(k) ((k) == ONLY_KIND)
#endif
__global__ void __launch_bounds__(512, 2) fwd_megakernel(Params p) {
    extern __shared__ __attribute__((aligned(16))) unsigned char shm[];
    LAS unsigned char* lds = (LAS unsigned char*)shm;
    cg::grid_group grid = cg::this_grid();
    unsigned char* ws = p.ws;
    h16* PRE = (h16*)(ws + WS_PRE); h16* XH = (h16*)(ws + WS_XH); h16* VF = (h16*)(ws + WS_VF);
    unsigned char* R1 = ws + WS_R1; unsigned char* R2 = ws + WS_R2; float* Y = (float*)(ws + WS_Y);
    h16* MIX = (h16*)R1; h16* SIDE = (h16*)R1; h16* AO = (h16*)R1;
    h16* DEC = (h16*)(R1 + R1_DEC); h16* Ab = (h16*)(R1 + R1_A); h16* Gb = (h16*)(R1 + R1_G); h16* AA = (h16*)(R1 + R1_AA); h16* YG = (h16*)(R1 + R1_YG);
    h16* C1 = (h16*)R2; h16* ACT = (h16*)R2; h16* Qb = (h16*)R2; h16* Kb = Qb + (size_t)MTOK * DM; h16* Vt = Kb + (size_t)MTOK * DM;

    volatile LAS unsigned* xst = (volatile LAS unsigned*)(lds + LDS_BYTES - 16);
    if (threadIdx.x == 0) { xst[0] = 0u; xst[1] = 0u; }
    __syncthreads();
    const XcdBarrier xb = xcd_barrier_post((unsigned*)(ws + WS_BAR), xst);
    for (int ph = p.ph_lo; ph < p.ph_hi; ++ph) {
        int layer, kind;
        if (ph < 11) { layer = 0; kind = (int)((0xDCBA9854210ull >> (4 * ph)) & 15ull); }
        else if (ph < 19) { layer = 1; kind = (int)((0xDCBA9876ull >> (4 * (ph - 11))) & 15ull); }
        else if (ph < 29) { layer = 2; kind = (int)((0xDCBA985421ull >> (4 * (ph - 19))) & 15ull); }
        else { layer = 3; kind = (int)((0xDCBA9876ull >> (4 * (ph - 29))) & 15ull); }
        const int j = layer >> 1;
        const char* W = (const char*)(ws + ((layer & 1) ? WS_X : WS_W16));
        const h16* wB1 = (const h16*)(W + W_B1); const h16* wB2 = (const h16*)(W + W_B2); const h16* wWO = (const h16*)(W + W_WO);
        const h16* wUP = (const h16*)(W + W_UP); const h16* wDN = (const h16*)(W + W_DN);
        const int nrep = ((PROBE_MASK >> kind) & 1) ? 2 : 1;
        for (int rep = 0; rep < nrep; ++rep)
        switch (kind) {
        case 0: if (EN(0)) {
            cvt_layer(lds, p, 0);
            ln_phase<false>(p.in[0], nullptr, nullptr, nullptr, XH, p.in[3], MIX);
        } break;
        case 1: if (EN(1)) {
            AMapMix am{(const char*)MIX}; EpiG1 e{C1};
            pg8::gemm_phase(lds, am, DM, wB1, DM, MTOK, j == 0 ? 6912 : 7168, DM, e);
        } break;
        case 2: if (EN(2)) {
            const float* w0 = p.in[5] + (size_t)j * DM; const float* a0 = p.in[8] + (size_t)j * DM; const float* v0 = p.in[11] + (size_t)(j > 0 ? j - 1 : 0) * DM;
            int k2 = 256; asm volatile("" : "+s"(k2));
            if (ENG(0)) { AMapOne am{(const char*)(C1 + 6144)}; EpiG2<0> e{DEC, Ab, Gb, C1, VF, w0, a0, v0, AA, p.in[16] + (size_t)j * DM, p.in[17] + (size_t)j * DM}; pg8::gemm_phase(lds, am, LDC1, wB2, 256, MTOK, DM, k2, e); }
            if (ENG(1)) { AMapOne am{(const char*)(C1 + 6400)}; EpiG2<1> e{DEC, Ab, Gb, C1, VF, w0, a0, v0, AA, p.in[16] + (size_t)j * DM, p.in[17] + (size_t)j * DM}; pg8::gemm_phase(lds, am, LDC1, wB2 + (size_t)2048 * 256, 256, MTOK, DM, k2, e); }
            if (ENG(2)) { AMapOne am{(const char*)(C1 + 6656)}; EpiG2<2> e{DEC, Ab, Gb, C1, VF, w0, a0, v0, AA, p.in[16] + (size_t)j * DM, p.in[17] + (size_t)j * DM}; pg8::gemm_phase(lds, am, LDC1, wB2 + (size_t)4096 * 256, 256, MTOK, DM, k2, e); }
            if (ENG(3) && j > 0) { AMapOne am{(const char*)(C1 + 6912)}; EpiG2<3> e{DEC, Ab, Gb, C1, VF, w0, a0, v0, AA, p.in[16] + (size_t)j * DM, p.in[17] + (size_t)j * DM}; pg8::gemm_phase(lds, am, LDC1, wB2 + (size_t)6144 * 256, 256, MTOK, DM, k2, e); }
        } break;
        case 3: if (EN(3)) prep_phase(C1, Ab, AA, VF, p.in[16] + (size_t)j * DM, p.in[17] + (size_t)j * DM, j == 0); break;
        case 4: if (EN(4)) scan_phase(lds, C1, DEC, AA, Ab, Y, p.in[22] + (size_t)j * DM * 6144, p.in[25] + (size_t)j * DM * DM, p.in[27] + (size_t)(layer + 1) * DM * 2 * FF, p.in[30] + (size_t)(layer + 1) * FF * DM, (char*)(ws + WS_X),
                                       p.in[27] + (size_t)layer * DM * 2 * FF, p.in[30] + (size_t)layer * FF * DM, (char*)(ws + WS_W16)); break;
        case 5: if (EN(5)) gn_phase(Y, C1, Gb, YG, p.in[18] + (size_t)j * DM, p.in[19] + (size_t)j * DM, p.in[20] + (size_t)j * DM, j == 0 ? VF : nullptr); break;
        case 6: if (EN(6)) {
            AMapOne am{(const char*)XH}; EpiQKV e{Qb, Kb, Vt};
            pg8::gemm_phase(lds, am, DM, wB1, DM, MTOK, 6144, DM, e);
        } break;
        case 7: if (EN(7)) {
            const float li = layer == 1 ? 0.35550906759096926f : 0.5560581861995943f;
            attn_phase(lds, Qb, Kb, Vt, AO, p.in[26], p.in[23] + (size_t)j * 512, p.in[24] + (size_t)j * 256, li);
        } break;
        case 8: if (EN(8)) {
            AMapOne am{(const char*)((layer & 1) ? AO : YG)}; EpiRes e{XH, PRE};
            pg8::gemm_phase(lds, am, DM, wWO, DM, MTOK, DM, DM, e);
        } break;
        case 9: case 13: if (EN(9)) {
            const int sub = kind == 9 ? 0 : 1;
            const float* g = p.in[1] + (size_t)(layer * 2 + sub) * DM; const float* bt = p.in[2] + (size_t)(layer * 2 + sub) * DM;
            float* xo = nullptr; h16* xh = XH; const float* mu = nullptr; h16* mx = nullptr;
            if (kind == 13) {
                if (layer == 3) { xo = p.out; xh = nullptr; }
                else {
                    if (layer == 1) cvt_layer(lds, p, layer + 1);
                    if (layer == 1) { mu = p.in[3] + (size_t)1 * 6 * DM; mx = MIX; }
                }
            }
            ln_phase<true>(PRE, g, bt, xo, xh, mu, mx);
        } break;
        case 10: if (EN(10)) {
            AMapOne am{(const char*)XH}; EpiUpConv e{ACT, SIDE, p.in[28] + (size_t)layer * 3 * FF, p.in[29] + (size_t)layer * FF};
            pg8::gemm_phase(lds, am, DM, wUP, DM, MTOK, 2 * FF, DM, e);
        } break;
        case 11: if (EN(11)) convfix_phase(SIDE, ACT, p.in[28] + (size_t)layer * 3 * FF, p.in[29] + (size_t)layer * FF); break;
        case 12: if (EN(12)) {
            AMapOne am{(const char*)ACT}; EpiRes e{XH, PRE};
            pg8::gemm_phase(lds, am, FF, wDN, FF, MTOK, DM, FF, e);
        } break;
        }
        if (ph + 1 < p.ph_hi) {
            if (ph == p.ph_lo) grid.sync();
            else xcd_barrier(xb);
        }
    }
}

constexpr int NPHASES = 37;

extern "C" void kernel_launch(void* const* d_in, const int* in_sizes, int n_in, void* d_out, int out_size, void* d_ws, size_t ws_size, hipStream_t stream) {
    static int grid_blocks = 0;
    if (!grid_blocks) {
        if (n_in != 31 || ws_size < WS_END) { fprintf(stderr, "kernel_launch: unexpected n_in %d / ws_size %zu (need %zu)\n", n_in, ws_size, (size_t)WS_END); grid_blocks = -1; return; }
        int dev = 0, cus = 0, per_cu = 0;
        hipGetDevice(&dev);
        hipDeviceGetAttribute(&cus, hipDeviceAttributeMultiprocessorCount, dev);
        if (hipFuncSetAttribute((const void*)fwd_megakernel, hipFuncAttributeMaxDynamicSharedMemorySize, LDS_BYTES) != hipSuccess) { fprintf(stderr, "kernel_launch: hipFuncSetAttribute failed\n"); grid_blocks = -1; return; }
        if (hipOccupancyMaxActiveBlocksPerMultiprocessor(&per_cu, (const void*)fwd_megakernel, 512, LDS_BYTES) != hipSuccess || per_cu < 1) { fprintf(stderr, "kernel_launch: occupancy query gave %d\n", per_cu); per_cu = 1; (void)hipGetLastError(); }
        grid_blocks = cus * per_cu;
        if (grid_blocks > 256) grid_blocks = 256;
    }
    if (grid_blocks < 0) return;
    Params p{};
    for (int i = 0; i < 31; ++i) p.in[i] = (const float*)d_in[i];
    p.out = (float*)d_out; p.ws = (unsigned char*)d_ws; p.ph_lo = 0; p.ph_hi = NPHASES;
    if (hipMemsetAsync((char*)d_ws + WS_BAR, 0, 16384, stream) != hipSuccess) { fprintf(stderr, "kernel_launch: memset failed\n"); return; }
    void* args[] = {&p};
    hipError_t e = hipLaunchCooperativeKernel((const void*)fwd_megakernel, dim3(grid_blocks), dim3(512), args, LDS_BYTES, stream);
    if (e != hipSuccess) fprintf(stderr, "cooperative launch failed: %s (grid %d)\n", hipGetErrorString(e), grid_blocks);
}
```

```cpp
#include <hip/hip_runtime.h>
#include <hip/hip_cooperative_groups.h>
#include <cstdio>
namespace cg = cooperative_groups;

#define LAS __attribute__((address_space(3)))
#define GAS __attribute__((address_space(1)))
typedef _Float16 h16;
typedef _Float16 h16x8 __attribute__((ext_vector_type(8)));
typedef _Float16 h16x4 __attribute__((ext_vector_type(4)));
typedef float f32x4 __attribute__((ext_vector_type(4)));
typedef float f32x2 __attribute__((ext_vector_type(2)));
typedef float f32x16 __attribute__((ext_vector_type(16)));
typedef unsigned u32x4 __attribute__((ext_vector_type(4)));

constexpr int MTOK = 16384, DM = 2048, SEQ = 8192, FF = 5504, LDC1 = 7168;
constexpr float ALPHA = 1.681792830507429f;
constexpr float LOG2E = 1.4426950408889634f;
constexpr float QSCALE = 0.08838834764831845f * LOG2E;
constexpr int LDS_BYTES = 157696;
#define PROBE_MASK 0x0000

constexpr size_t W_B1 = 0, W_B2 = 29360128, W_WO = 33554432, W_UP = 41943040, W_DN = 87031808;
constexpr size_t WS_W16 = 0, WS_X = 117440512, WS_PRE = WS_X + 134217728, WS_XH = WS_PRE + 134217728, WS_VF = WS_XH + 67108864,
                 WS_R1 = WS_VF + 67108864, WS_R2 = WS_R1 + 402653184, WS_Y = WS_R2 + 234881024, WS_BAR = WS_Y + 134217728, WS_END = WS_BAR + 16384;
constexpr size_t R1_DEC = 0, R1_A = 134217728, R1_G = R1_A + 67108864, R1_AA = R1_G + 67108864, R1_YG = R1_AA + 67108864;

struct Params {
    const float* in[31];
    float* out;
    unsigned char* ws;
    int ph_lo, ph_hi;
};

__device__ __forceinline__ int otid() { int t = (int)threadIdx.x; asm volatile("" : "+v"(t)); return t; }
__device__ __forceinline__ int obid() { int t = (int)blockIdx.x; asm volatile("" : "+s"(t)); return t; }
__device__ __forceinline__ float wave_sum(float x) {
#pragma unroll
    for (int o = 32; o >= 1; o >>= 1) x += __shfl_xor(x, o);
    return x;
}
__device__ __forceinline__ float grp16_sum(float x) {
#pragma unroll
    for (int o = 8; o >= 1; o >>= 1) x += __shfl_xor(x, o);
    return x;
}
template <int CTRL> __device__ __forceinline__ float dpp_f(float x) { return __int_as_float(__builtin_amdgcn_update_dpp(0, __float_as_int(x), CTRL, 0xF, 0xF, true)); }
__device__ __forceinline__ float row16_sum(float x) { x += dpp_f<0xB1>(x); x += dpp_f<0x4E>(x); x += dpp_f<0x141>(x); x += dpp_f<0x140>(x); return x; }
__device__ __forceinline__ float sigmoidf_(float x) { return 1.0f / (1.0f + __expf(-x)); }

namespace pg8 {
constexpr int BM = 256, BK = 64, HALF = 128, HTB = HALF * BK * 2, NXCD = 8, WGM = 4;
__device__ __forceinline__ int lds_byte(int r, int c) { const int st = (r >> 4) * 2 + (c >> 5), rr = r & 15, cc = c & 31, ob = rr * 64 + cc * 2; return st * 1024 + (ob ^ (((ob >> 9) & 1) << 5)); }
__device__ __forceinline__ void stage_rc(int b, int& R, int& C) { const int st = b / 1024, sb = b % 1024, swz = sb ^ (((sb >> 9) & 1) << 5); R = (st >> 1) * 16 + swz / 64; C = (st & 1) * 32 + (swz % 64) / 2; }
__device__ __forceinline__ int perm32(int rho) { const int n = rho >> 4, i = rho & 15; return 8 * (i >> 2) + 4 * n + (i & 3); }
struct Unit { int pm, pn; };
struct Order {
    int nM, nN, nwg, G, c;
    __device__ void init(int M, int N, int G_, int c_) { nM = M / BM; nN = N / BM; nwg = nM * nN; G = G_; c = c_; }
    __device__ bool next(int i, Unit& u) const {
        const long L = (long)i * G + c; if (L >= nwg) return false;
        int wgid = (int)L; { const int q = nwg / NXCD, r = nwg % NXCD, xcd = wgid % NXCD, off = wgid / NXCD; wgid = (xcd < r ? xcd * (q + 1) : r * (q + 1) + (xcd - r) * q) + off; }
        const int nig = WGM * nN, gid = wgid / nig, fm = gid * WGM, gsz = (nM - fm) < WGM ? (nM - fm) : WGM;
        u.pm = fm + ((wgid % nig) % gsz); u.pn = (wgid % nig) / gsz; return true;
    }
};

template <class Epi, class AMap>
__device__ __forceinline__ void gemm_phase(LAS unsigned char* lds, const AMap am, const int lda, const h16* Bt, const int ldb, const int M, const int N, const int K, const Epi& E) {
    const int tid = otid(), wid = __builtin_amdgcn_readfirstlane(tid >> 6), lane = tid & 63, wr = wid >> 2, wc = wid & 3, fr = lane & 15, fq = lane >> 4;
    const int nt = K / BK;
    Order S; S.init(M, N, (int)gridDim.x, obid());
    unsigned voffA[2], voffB[2];
#pragma unroll
    for (int i = 0; i < 2; ++i) { int R, C; stage_rc(tid * 16 + i * 8192, R, C); const int Rb = Epi::PERM ? ((R & ~31) + perm32(R & 31)) : R;
        voffA[i] = (unsigned)(R * lda + C) * 2u; voffB[i] = (unsigned)(Rb * ldb + C) * 2u; }
    const size_t kstep = (size_t)(BK * 2);
    const size_t hstepA = (size_t)HALF * lda * 2, hstepB = (size_t)HALF * ldb * 2;
    const size_t tstepA = 2 * hstepA, tstepB = 2 * hstepB;
    const unsigned ldsw = (unsigned)wid * 1024u;
    const int aoff = lds_byte(wr * 64 + fr, fq * 8), boff = lds_byte(wc * 32 + fr, fq * 8);
#define PG8_SA(b, h) (((b) * 2 + (h)) * HTB)
#define PG8_SB(b, h) ((4 + (b) * 2 + (h)) * HTB)
#define PG8_STAGE(bufoff, gbase, voff) do { _Pragma("unroll") for (int _i = 0; _i < 2; ++_i) \
        __builtin_amdgcn_global_load_lds((const unsigned*)((const char*)(gbase) + (voff)[_i]), (LAS unsigned*)(lds + (bufoff) + ldsw + _i * 8192), 16, 0, 0); } while (0)
#define PG8_LDA(dst, b, h) do { _Pragma("unroll") for (int m = 0; m < 4; ++m) _Pragma("unroll") for (int k = 0; k < 2; ++k) dst[m][k] = *(const LAS h16x8*)(lds + PG8_SA(b, h) + aoff + m * 2048 + k * 1024); } while (0)
#define PG8_LDB(dst, b, h) do { _Pragma("unroll") for (int n = 0; n < 2; ++n) _Pragma("unroll") for (int k = 0; k < 2; ++k) dst[n][k] = *(const LAS h16x8*)(lds + PG8_SB(b, h) + boff + n * 2048 + k * 1024); } while (0)
#define PG8_MMA(ai, bj, At, Bt_) do { __builtin_amdgcn_s_setprio(1); _Pragma("unroll") for (int m = 0; m < 4; ++m) _Pragma("unroll") for (int n = 0; n < 2; ++n) _Pragma("unroll") for (int k = 0; k < 2; ++k) \
        acc[ai][bj][m][n] = __builtin_amdgcn_mfma_f32_16x16x32_f16(Bt_[n][k], At[m][k], acc[ai][bj][m][n], 0, 0, 0); __builtin_amdgcn_s_setprio(0); } while (0)
#define PG8_WAIT_V(n) asm volatile("s_waitcnt vmcnt(" #n ")" ::: "memory")
#define PG8_WAIT_L(n) asm volatile("s_waitcnt lgkmcnt(" #n ")" ::: "memory")
#define PG8_BAR __builtin_amdgcn_s_barrier()
#define PG8_SCHED __builtin_amdgcn_sched_barrier(0)
    Unit cur, nxt; int ui = 0;
    if (!S.next(0, cur)) return;
    f32x4 acc[2][2][4][2];
#pragma unroll
    for (int a = 0; a < 2; ++a)
#pragma unroll
        for (int b = 0; b < 2; ++b)
#pragma unroll
            for (int m = 0; m < 4; ++m)
#pragma unroll
                for (int n = 0; n < 2; ++n) acc[a][b][m][n] = (f32x4){0.f, 0.f, 0.f, 0.f};
    h16x8 At[4][2], B0[2][2], B1[2][2];
    const char* cA = am(cur.pn) + (size_t)cur.pm * tstepA; const char* cB = (const char*)Bt + (size_t)cur.pn * tstepB;
    PG8_STAGE(PG8_SB(0, 0), cB, voffB); PG8_STAGE(PG8_SA(0, 0), cA, voffA); PG8_STAGE(PG8_SB(0, 1), cB + hstepB, voffB); PG8_STAGE(PG8_SA(0, 1), cA + hstepA, voffA);
    if (wr == 1) PG8_BAR;
    PG8_WAIT_V(4); PG8_BAR;
    PG8_STAGE(PG8_SB(1, 0), cB + kstep, voffB); PG8_STAGE(PG8_SA(1, 0), cA + kstep, voffA); PG8_STAGE(PG8_SB(1, 1), cB + hstepB + kstep, voffB);
    PG8_WAIT_V(6); PG8_BAR;
    for (;;) {
        const bool has_next = S.next(ui + 1, nxt);
        const char* nA = has_next ? am(nxt.pn) + (size_t)nxt.pm * tstepA : cA; const char* nB = has_next ? (const char*)Bt + (size_t)nxt.pn * tstepB : cB;
#pragma unroll 1
        for (int t = 0; t < nt; t += 2) {
            const bool last = (t == nt - 2);
            const char* a1 = cA + (size_t)(t + 1) * kstep;
            const char* a2 = last ? nA : cA + (size_t)(t + 2) * kstep; const char* b2 = last ? nB : cB + (size_t)(t + 2) * kstep;
            const char* a3 = a2 + kstep; const char* b3 = b2 + kstep;
            PG8_LDB(B0, 0, 0); PG8_SCHED; PG8_LDA(At, 0, 0); PG8_STAGE(PG8_SA(1, 1), a1 + hstepA, voffA);
            PG8_WAIT_L(8); PG8_BAR; PG8_WAIT_L(0); PG8_MMA(0, 0, At, B0); PG8_BAR; PG8_SCHED;
            PG8_LDB(B1, 0, 1); PG8_STAGE(PG8_SB(0, 0), b2, voffB);
            PG8_BAR; PG8_WAIT_L(0); PG8_MMA(0, 1, At, B1); PG8_BAR;
            PG8_LDA(At, 0, 1); PG8_STAGE(PG8_SA(0, 0), a2, voffA);
            PG8_BAR; PG8_WAIT_L(0); PG8_MMA(1, 0, At, B0); PG8_BAR; PG8_SCHED;
            PG8_STAGE(PG8_SB(0, 1), b2 + hstepB, voffB);
            PG8_WAIT_V(6); PG8_BAR; PG8_MMA(1, 1, At, B1); PG8_BAR;
            PG8_LDB(B0, 1, 0); PG8_SCHED; PG8_LDA(At, 1, 0); PG8_STAGE(PG8_SA(0, 1), a2 + hstepA, voffA);
            PG8_WAIT_L(8); PG8_BAR; PG8_WAIT_L(0); PG8_MMA(0, 0, At, B0); PG8_BAR; PG8_SCHED;
            PG8_LDB(B1, 1, 1); PG8_STAGE(PG8_SB(1, 0), b3, voffB);
            PG8_BAR; PG8_WAIT_L(0); PG8_MMA(0, 1, At, B1); PG8_BAR;
            PG8_LDA(At, 1, 1); PG8_STAGE(PG8_SA(1, 0), a3, voffA);
            PG8_BAR; PG8_WAIT_L(0); PG8_MMA(1, 0, At, B0); PG8_BAR; PG8_SCHED;
            PG8_STAGE(PG8_SB(1, 1), b3 + hstepB, voffB);
            PG8_WAIT_V(6); PG8_BAR; PG8_MMA(1, 1, At, B1); PG8_BAR;
        }
        E(acc, cur, wr, wc, fr, fq);
        if (!has_next) break;
#pragma unroll
        for (int a = 0; a < 2; ++a)
#pragma unroll
            for (int b = 0; b < 2; ++b)
#pragma unroll
                for (int m = 0; m < 4; ++m)
#pragma unroll
                    for (int n = 0; n < 2; ++n) acc[a][b][m][n] = (f32x4){0.f, 0.f, 0.f, 0.f};
        cur = nxt; cA = nA; cB = nB; ++ui;
    }
    PG8_WAIT_V(0);
    if (wr == 0) PG8_BAR;
    PG8_BAR;
#undef PG8_SA
#undef PG8_SB
#undef PG8_STAGE
#undef PG8_LDA
#undef PG8_LDB
#undef PG8_MMA
#undef PG8_WAIT_V
#undef PG8_WAIT_L
#undef PG8_BAR
#undef PG8_SCHED
}
}
using pg8::Unit;

__device__ __forceinline__ u32x4 pack8(f32x4 a, f32x4 b) {
    h16x8 v = {(h16)a[0], (h16)a[1], (h16)a[2], (h16)a[3], (h16)b[0], (h16)b[1], (h16)b[2], (h16)b[3]};
    return __builtin_bit_cast(u32x4, v);
}

struct AMapOne { const char* A; __device__ __forceinline__ const char* operator()(int) const { return A; } };
struct AMapMix {
    const char* A;
    __device__ __forceinline__ const char* operator()(int pn) const {
        int idx; if (pn < 8) idx = 0; else if (pn < 16) idx = 2; else if (pn < 24) idx = 3; else if (pn == 24) idx = 1; else if (pn == 25) idx = 4; else if (pn == 26) idx = 5; else idx = 3;
        return A + (size_t)idx * ((size_t)MTOK * DM * 2);
    }
};
struct AMapLora {
    const char* C1;
    __device__ __forceinline__ const char* operator()(int pn) const { return C1 + (size_t)(6144 + 256 * (pn >> 3)) * 2; }
};

#define EPI_ROWS_PERM  const int row0 = u.pm * 256 + wr * 64 + fr; const int colt = u.pn * 256 + wc * 32 + 8 * fq;
struct EpiH16 {
    static constexpr bool PERM = true;
    h16* O; int ldc;
    __device__ __forceinline__ void operator()(const f32x4 (&acc)[2][2][4][2], const Unit& u, int wr, int wc, int fr, int fq) const {
        EPI_ROWS_PERM
#pragma unroll
        for (int ai = 0; ai < 2; ++ai)
#pragma unroll
            for (int m = 0; m < 4; ++m) { h16* rowp = O + (size_t)(row0 + ai * 128 + m * 16) * ldc + colt;
#pragma unroll
                for (int bj = 0; bj < 2; ++bj) *(u32x4*)(rowp + bj * 128) = pack8(acc[ai][bj][m][0], acc[ai][bj][m][1]); }
    }
};
struct EpiG1 {
    static constexpr bool PERM = true;
    h16* O;
    __device__ __forceinline__ void operator()(const f32x4 (&acc)[2][2][4][2], const Unit& u, int wr, int wc, int fr, int fq) const {
        EPI_ROWS_PERM
        const int mode = u.pn == 24 ? 1 : (u.pn == 26 ? 2 : 0);
#pragma unroll
        for (int ai = 0; ai < 2; ++ai)
#pragma unroll
            for (int m = 0; m < 4; ++m) { h16* rowp = O + (size_t)(row0 + ai * 128 + m * 16) * LDC1 + colt;
#pragma unroll
                for (int bj = 0; bj < 2; ++bj) { f32x4 v0 = acc[ai][bj][m][0], v1 = acc[ai][bj][m][1];
                    if (mode == 1) {
#pragma unroll
                        for (int j = 0; j < 4; ++j) { v0[j] = 1.0f - 2.0f / (1.0f + __expf(2.0f * v0[j])); v1[j] = 1.0f - 2.0f / (1.0f + __expf(2.0f * v1[j])); } }
                    else if (mode == 2) {
#pragma unroll
                        for (int j = 0; j < 4; ++j) { v0[j] = sigmoidf_(v0[j]); v1[j] = sigmoidf_(v1[j]); } }
                    *(u32x4*)(rowp + bj * 128) = pack8(v0, v1); } }
    }
};
template <int GI_> struct EpiG2 {
    static constexpr bool PERM = true;
    h16* DEC; h16* Ab; h16* Gb; h16* C1; const h16* VF; const float* w0; const float* a0; const float* v0; h16* AA; const float* k_k; const float* k_a;
    template <int GI>
    __device__ __forceinline__ void body(const f32x4 (&acc)[2][2][4][2], int row0, int colt) const {
#pragma unroll
        for (int bj = 0; bj < 2; ++bj) {
            const int c = colt + bj * 128;
            f32x4 b0 = (f32x4){0.f, 0.f, 0.f, 0.f}, b1 = b0;
            if (GI == 0) { b0 = *(const f32x4*)(w0 + c); b1 = *(const f32x4*)(w0 + c + 4); }
            else if (GI == 1) { b0 = *(const f32x4*)(a0 + c); b1 = *(const f32x4*)(a0 + c + 4); }
            else if (GI == 3) { b0 = *(const f32x4*)(v0 + c); b1 = *(const f32x4*)(v0 + c + 4); }
#pragma unroll
            for (int ai = 0; ai < 2; ++ai)
#pragma unroll
                for (int m = 0; m < 4; ++m) {
                    const size_t row = (size_t)(row0 + ai * 128 + m * 16);
                    f32x4 x0 = acc[ai][bj][m][0] + b0, x1 = acc[ai][bj][m][1] + b1;
                    if (GI == 0) {
#pragma unroll
                        for (int j = 0; j < 4; ++j) {
                            x0[j] = 0.6065306597126334f * sigmoidf_(x0[j]); x1[j] = 0.6065306597126334f * sigmoidf_(x1[j]); }
                        *(u32x4*)(DEC + row * DM + c) = pack8(x0, x1);
                    } else if (GI == 1) {
#pragma unroll
                        for (int j = 0; j < 4; ++j) { x0[j] = sigmoidf_(x0[j]); x1[j] = sigmoidf_(x1[j]); }
                        *(u32x4*)(Ab + row * DM + c) = pack8(x0, x1);
                    } else if (GI == 2) {
                        *(u32x4*)(Gb + row * DM + c) = pack8(x0, x1);
                    } else {
                        h16* vp = C1 + row * LDC1 + 4096 + c;
                        const h16x8 vv = *(const h16x8*)vp; const h16x8 vf = *(const h16x8*)(VF + row * DM + c);
                        f32x4 o0, o1;
#pragma unroll
                        for (int j = 0; j < 4; ++j) { float v = (float)vv[j], f = (float)vf[j]; o0[j] = v + (f - v) * sigmoidf_(x0[j]); v = (float)vv[4 + j]; f = (float)vf[4 + j]; o1[j] = v + (f - v) * sigmoidf_(x1[j]); }
                        *(u32x4*)vp = pack8(o0, o1);
                    }
                    __builtin_amdgcn_sched_barrier(0);
                }
        }
    }
    __device__ __forceinline__ void body_a(const f32x4 (&acc)[2][2][4][2], int row0, int cb0) const {
#pragma unroll
        for (int ai = 0; ai < 2; ++ai)
#pragma unroll
            for (int m = 0; m < 4; ++m) {
                const size_t row = (size_t)(row0 + ai * 128 + m * 16);
                asm volatile("" ::: "memory");
                float a[2][8], kv[2][8], kk[2][8]; float ss = 0.f;
#pragma unroll
                for (int bj = 0; bj < 2; ++bj) {
                    const int c = cb0 + 32 * bj;
                    const f32x4 b0 = *(const f32x4*)(a0 + c), b1 = *(const f32x4*)(a0 + c + 4), q0 = *(const f32x4*)(k_k + c), q1 = *(const f32x4*)(k_k + c + 4);
                    const h16x8 kh = *(const h16x8*)(C1 + row * LDC1 + 2048 + c);
#pragma unroll
                    for (int e = 0; e < 4; ++e) {
                        a[bj][e] = sigmoidf_(acc[ai][bj][m][0][e] + b0[e]); a[bj][4 + e] = sigmoidf_(acc[ai][bj][m][1][e] + b1[e]);
                        kv[bj][e] = (float)kh[e]; kv[bj][4 + e] = (float)kh[4 + e];
                        kk[bj][e] = kv[bj][e] * q0[e]; kk[bj][4 + e] = kv[bj][4 + e] * q1[e];
                        ss += kk[bj][e] * kk[bj][e] + kk[bj][4 + e] * kk[bj][4 + e];
                    }
                }
                ss += __shfl_xor(ss, 16); ss += __shfl_xor(ss, 32);
                const float inv = 1.0f / fmaxf(sqrtf(ss), 1e-12f);
#pragma unroll
                for (int bj = 0; bj < 2; ++bj) {
                    const int c = cb0 + 32 * bj;
                    const f32x4 p0 = *(const f32x4*)(k_a + c), p1 = *(const f32x4*)(k_a + c + 4);
                    f32x4 ko0, ko1, ao0, ao1, bo0, bo1;
#pragma unroll
                    for (int e = 0; e < 4; ++e) {
                        ko0[e] = kv[bj][e] * (1.0f + (a[bj][e] - 1.0f) * p0[e]); ko1[e] = kv[bj][4 + e] * (1.0f + (a[bj][4 + e] - 1.0f) * p1[e]);
                        const float n0_ = kk[bj][e] * inv, n1_ = kk[bj][4 + e] * inv;
                        ao0[e] = -n0_; ao1[e] = -n1_; bo0[e] = n0_ * a[bj][e]; bo1[e] = n1_ * a[bj][4 + e];
                    }
                    *(u32x4*)(C1 + row * LDC1 + 2048 + c) = pack8(ko0, ko1);
                    *(u32x4*)(AA + row * DM + c) = pack8(ao0, ao1);
                    *(u32x4*)(Ab + row * DM + c) = pack8(bo0, bo1);
                }
                __builtin_amdgcn_sched_barrier(0);
            }
    }
    __device__ __forceinline__ void operator()(const f32x4 (&acc)[2][2][4][2], const Unit& u, int wr, int wc, int fr, int fq) const {
        const int row0 = u.pm * 256 + wr * 64 + fr; const int colt = u.pn * 256 + wc * 32 + 8 * fq;
        if (GI_ == 1) body_a(acc, row0, u.pn * 256 + wc * 64 + 8 * fq);
        else body<GI_>(acc, row0, colt);
    }
};
struct EpiRes {
    static constexpr bool PERM = true;
    const h16* X; h16* PRE;
    __device__ __forceinline__ void operator()(const f32x4 (&acc)[2][2][4][2], const Unit& u, int wr, int wc, int fr, int fq) const {
        EPI_ROWS_PERM
#pragma unroll
        for (int ai = 0; ai < 2; ++ai)
#pragma unroll
            for (int m = 0; m < 4; ++m) { const size_t off = (size_t)(row0 + ai * 128 + m * 16) * DM + colt;
#pragma unroll
                for (int bj = 0; bj < 2; ++bj) {
                    const h16x8 x = *(const h16x8*)(X + off + bj * 128);
                    f32x4 o0, o1;
#pragma unroll
                    for (int e = 0; e < 4; ++e) { o0[e] = (float)x[e] * ALPHA + acc[ai][bj][m][0][e]; o1[e] = (float)x[4 + e] * ALPHA + acc[ai][bj][m][1][e]; }
                    *(u32x4*)(PRE + off + bj * 128) = pack8(o0, o1); } }
    }
};
__device__ __forceinline__ float gelu_mul(float u, float gc) {
    const float t = gc * gc;
    const float z = gc * (t * (0.044715f * 1.5957691216057308f * LOG2E) + 1.5957691216057308f * LOG2E);
    return u * gc * __builtin_amdgcn_rcpf(1.0f + __builtin_amdgcn_exp2f(-z));
}
struct EpiUpConv {
    static constexpr bool PERM = true;
    h16* ACT; h16* SIDE; const float* cw; const float* cb;
    __device__ __forceinline__ void operator()(const f32x4 (&acc)[2][2][4][2], const Unit& u, int wr, int wc, int fr, int fq) const {
        const int row0 = u.pm * 256 + wr * 64 + fr, f0 = u.pn * 128 + wc * 32 + 8 * fq;
        f32x4 w0[2], w1[2], w2[2], bb[2];
#pragma unroll
        for (int n = 0; n < 2; ++n) { w0[n] = *(const f32x4*)(cw + f0 + 4 * n); w1[n] = *(const f32x4*)(cw + FF + f0 + 4 * n); w2[n] = *(const f32x4*)(cw + 2 * FF + f0 + 4 * n); bb[n] = *(const f32x4*)(cb + f0 + 4 * n); }
#pragma unroll
        for (int ai = 0; ai < 2; ++ai) {
            f32x4 p1[2], p2[2];
#pragma unroll
            for (int n = 0; n < 2; ++n) { p1[n] = (f32x4){0.f, 0.f, 0.f, 0.f}; p2[n] = p1[n]; }
#pragma unroll
            for (int m = 0; m < 4; ++m) {
                const int row = row0 + ai * 128 + m * 16;
                f32x4 r1[2], r2[2], o[2];
#pragma unroll
                for (int n = 0; n < 2; ++n)
#pragma unroll
                    for (int e = 0; e < 4; ++e) {
                        const float g = acc[ai][1][m][n][e];
                        r1[n][e] = dpp_f<0x121>(g); r2[n][e] = dpp_f<0x122>(g);
                        const float g1 = fr >= 1 ? r1[n][e] : p1[n][e], g2 = fr >= 2 ? r2[n][e] : p2[n][e];
                        const float gc = bb[n][e] + g2 * w0[n][e] + g1 * w1[n][e] + g * w2[n][e];
                        o[n][e] = gelu_mul(acc[ai][0][m][n][e], gc);
                    }
                if (m > 0 || fr >= 2) *(u32x4*)(ACT + (size_t)row * FF + f0) = pack8(o[0], o[1]);
                if (m == 0 && fr < 2) { h16* sp = SIDE + ((size_t)(row >> 6) * 4 + 2 + fr) * (2 * FF) + f0;
                    *(u32x4*)sp = pack8(acc[ai][0][m][0], acc[ai][0][m][1]); *(u32x4*)(sp + FF) = pack8(acc[ai][1][m][0], acc[ai][1][m][1]); }
                if (m == 3 && fr >= 14) { h16* sp = SIDE + ((size_t)(row >> 6) * 4 + (fr - 14)) * (2 * FF) + FF + f0;
                    *(u32x4*)sp = pack8(acc[ai][1][m][0], acc[ai][1][m][1]); }
#pragma unroll
                for (int n = 0; n < 2; ++n) { p1[n] = r1[n]; p2[n] = r2[n]; }
            }
        }
    }
};
__device__ __forceinline__ void convfix_phase(const h16* SIDE, h16* ACT, const float* cw, const float* cb) {
    constexpr int NCG = FF / 8, NT = 256 * 2 * NCG;
    for (int task = obid() * 512 + otid(); task < NT; task += gridDim.x * 512) {
        const int cgi = task % NCG, j = (task / NCG) & 1, gidx = task / (2 * NCG), f = cgi * 8;
        const bool first = (gidx & 127) == 0;
        const h16* cur = SIDE + ((size_t)gidx * 4 + 2 + j) * (2 * FF) + f;
        const h16x8 uh = *(const h16x8*)cur, g0h = *(const h16x8*)(cur + FF);
        h16x8 g1h = {}, g2h = {};
        if (j == 0) { if (!first) { g1h = *(const h16x8*)(SIDE + ((size_t)(gidx - 1) * 4 + 1) * (2 * FF) + FF + f); g2h = *(const h16x8*)(SIDE + ((size_t)(gidx - 1) * 4 + 0) * (2 * FF) + FF + f); } }
        else { g1h = *(const h16x8*)(SIDE + ((size_t)gidx * 4 + 2) * (2 * FF) + FF + f); if (!first) g2h = *(const h16x8*)(SIDE + ((size_t)(gidx - 1) * 4 + 1) * (2 * FF) + FF + f); }
        h16x8 o;
#pragma unroll
        for (int e = 0; e < 8; ++e) {
            const float gc = cb[f + e] + (float)g2h[e] * cw[f + e] + (float)g1h[e] * cw[FF + f + e] + (float)g0h[e] * cw[2 * FF + f + e];
            o[e] = (h16)gelu_mul((float)uh[e], gc);
        }
        *(h16x8*)(ACT + ((size_t)gidx * 64 + j) * FF + f) = o;
    }
}
struct EpiQKV {
    static constexpr bool PERM = true;
    h16* Qb; h16* Kb; h16* Vt;
    __device__ __forceinline__ void operator()(const f32x4 (&acc)[2][2][4][2], const Unit& u, int wr, int wc, int fr, int fq) const {
        const int row0 = u.pm * 256 + wr * 64 + fr; const int part = u.pn >> 3; const int colt = (u.pn & 7) * 256 + wc * 32 + 8 * fq;
#pragma unroll
        for (int ai = 0; ai < 2; ++ai)
#pragma unroll
            for (int m = 0; m < 4; ++m) { const int row = row0 + ai * 128 + m * 16;
#pragma unroll
                for (int bj = 0; bj < 2; ++bj) { const int c = colt + bj * 128;
                    if (part == 0) *(u32x4*)(Qb + (size_t)row * DM + c) = pack8(acc[ai][bj][m][0] * QSCALE, acc[ai][bj][m][1] * QSCALE);
                    else if (part == 1) *(u32x4*)(Kb + (size_t)row * DM + c) = pack8(acc[ai][bj][m][0], acc[ai][bj][m][1]);
                    else {
                        const int b = row >> 13, t = row & 8191, hd = c >> 8, dv = c & 255;
                        const int pos = (t & ~12) | ((t & 4) << 1) | ((t & 8) >> 1);
                        h16* vp = Vt + ((size_t)((b * 8 + hd) * 256 + dv)) * SEQ + pos;
#pragma unroll
                        for (int j = 0; j < 4; ++j) { vp[(size_t)j * SEQ] = (h16)acc[ai][bj][m][0][j]; vp[(size_t)(4 + j) * SEQ] = (h16)acc[ai][bj][m][1][j]; }
                    } } }
    }
};

__device__ __forceinline__ void cvt_job(LAS unsigned char* lds, const float* src, int Ks, int Ns, h16* dst, int Kd, int Nd, int remap = 0) {
    LAS h16* tile = (LAS h16*)lds;
    const int tid = otid(), tk = Kd >> 6, tn = Nd >> 6;
    for (int t = obid(); t < tk * tn; t += gridDim.x) {
        const int k0 = (t % tk) * 64, n0 = (t / tk) * 64;
#pragma unroll
        for (int i = 0; i < 2; ++i) {
            const int idx = tid + 512 * i, kr = idx >> 4, nc = (idx & 15) * 4, k = k0 + kr, n = n0 + nc;
            f32x4 v = (f32x4){0.f, 0.f, 0.f, 0.f};
            if (k < Ks && n < Ns) v = *(const f32x4*)(src + (size_t)k * Ns + n);
            tile[kr * 66 + nc + 0] = (h16)v[0]; tile[kr * 66 + nc + 1] = (h16)v[1]; tile[kr * 66 + nc + 2] = (h16)v[2]; tile[kr * 66 + nc + 3] = (h16)v[3];
        }
        __syncthreads();
        { const int n = tid >> 3, kg = tid & 7; h16x8 o;
#pragma unroll
          for (int e = 0; e < 8; ++e) o[e] = tile[(kg * 8 + e) * 66 + n];
          const int no = n0 + n;
          const int nd = remap == 0 ? no : (remap == 1 ? (no < FF ? (no >> 7) * 256 + (no & 127) : ((no - FF) >> 7) * 256 + 128 + ((no - FF) & 127))
                                                      : ((no & ~255) | ((no & 32) << 2) | ((no & 192) >> 1) | (no & 31)));
          *(h16x8*)(dst + (size_t)nd * Kd + k0 + kg * 8) = o; }
        __syncthreads();
    }
}
__device__ __forceinline__ void cvt_layer(LAS unsigned char* lds, const Params& p, int layer) {
    const bool ffn_here = (layer & 1) != 0;
    h16* W = (h16*)(p.ws + ((layer & 1) ? WS_X : WS_W16));
    const int j = layer >> 1;
    if ((layer & 1) == 0) {
        h16* B1 = (h16*)((char*)W + W_B1); h16* B2 = (h16*)((char*)W + W_B2);
        for (int i = 0; i < 3; ++i) cvt_job(lds, p.in[4] + ((size_t)j * 3 + i) * DM * DM, DM, DM, B1 + (size_t)i * DM * DM, DM, DM);
        cvt_job(lds, p.in[6] + (size_t)j * DM * 96, DM, 96, B1 + (size_t)6144 * DM, DM, 256);
        cvt_job(lds, p.in[9] + (size_t)j * DM * 96, DM, 96, B1 + (size_t)6400 * DM, DM, 256);
        cvt_job(lds, p.in[14] + (size_t)j * DM * 128, DM, 128, B1 + (size_t)6656 * DM, DM, 256);
        cvt_job(lds, p.in[7] + (size_t)j * 96 * DM, 96, DM, B2, 256, DM);
        cvt_job(lds, p.in[10] + (size_t)j * 96 * DM, 96, DM, B2 + (size_t)2048 * 256, 256, DM, 2);
        cvt_job(lds, p.in[15] + (size_t)j * 128 * DM, 128, DM, B2 + (size_t)4096 * 256, 256, DM);
        if (j > 0) {
            cvt_job(lds, p.in[12] + (size_t)(j - 1) * DM * 64, DM, 64, B1 + (size_t)6912 * DM, DM, 256);
            cvt_job(lds, p.in[13] + (size_t)(j - 1) * 64 * DM, 64, DM, B2 + (size_t)6144 * 256, 256, DM);
        }
        cvt_job(lds, p.in[21] + (size_t)j * DM * DM, DM, DM, (h16*)((char*)W + W_WO), DM, DM);
    } else {
        cvt_job(lds, p.in[22] + (size_t)j * DM * 6144, DM, 6144, (h16*)((char*)W + W_B1), DM, 6144);
        cvt_job(lds, p.in[25] + (size_t)j * DM * DM, DM, DM, (h16*)((char*)W + W_WO), DM, DM);
    }
    if (ffn_here) {
        cvt_job(lds, p.in[27] + (size_t)layer * DM * 2 * FF, DM, 2 * FF, (h16*)((char*)W + W_UP), DM, 2 * FF, 1);
        cvt_job(lds, p.in[30] + (size_t)layer * FF * DM, FF, DM, (h16*)((char*)W + W_DN), FF, DM);
    }
}

template <bool LN>
__device__ __forceinline__ void ln_row(const void* src, size_t row, int lane, const float* g, const float* bt, f32x4 (&v)[8]) {
    if (LN) {
        const h16x4* sp = (const h16x4*)((const h16*)src + row * DM);
#pragma unroll
        for (int i = 0; i < 8; ++i) { const h16x4 t = sp[i * 64 + lane]; v[i] = (f32x4){(float)t[0], (float)t[1], (float)t[2], (float)t[3]}; }
        float s = 0.f;
#pragma unroll
        for (int i = 0; i < 8; ++i) s += (v[i][0] + v[i][1]) + (v[i][2] + v[i][3]);
        const float mean = wave_sum(s) * (1.0f / DM);
        float q = 0.f;
#pragma unroll
        for (int i = 0; i < 8; ++i) { v[i] = v[i] - mean; q += (v[i][0] * v[i][0] + v[i][1] * v[i][1]) + (v[i][2] * v[i][2] + v[i][3] * v[i][3]); }
        const float rstd = rsqrtf(wave_sum(q) * (1.0f / DM) + 1e-5f);
#pragma unroll
        for (int i = 0; i < 8; ++i) { const f32x4 gg = ((const f32x4*)g)[i * 64 + lane], bb = ((const f32x4*)bt)[i * 64 + lane]; v[i] = v[i] * rstd * gg + bb; }
    } else {
        const f32x4* sp = (const f32x4*)((const float*)src + row * DM);
#pragma unroll
        for (int i = 0; i < 8; ++i) v[i] = sp[i * 64 + lane];
    }
}
__device__ __forceinline__ void ln_load16(const void* src, size_t row, int lane, h16x4 (&t)[8]) {
    const h16x4* sp = (const h16x4*)((const h16*)src + row * DM);
#pragma unroll
    for (int i = 0; i < 8; ++i) t[i] = sp[i * 64 + lane];
}
__device__ __forceinline__ void ln_apply16(const h16x4 (&t)[8], int lane, const float* g, const float* bt, f32x4 (&v)[8]) {
#pragma unroll
    for (int i = 0; i < 8; ++i) v[i] = (f32x4){(float)t[i][0], (float)t[i][1], (float)t[i][2], (float)t[i][3]};
    float s = 0.f;
#pragma unroll
    for (int i = 0; i < 8; ++i) s += (v[i][0] + v[i][1]) + (v[i][2] + v[i][3]);
    const float mean = wave_sum(s) * (1.0f / DM);
    float q = 0.f;
#pragma unroll
    for (int i = 0; i < 8; ++i) { v[i] = v[i] - mean; q += (v[i][0] * v[i][0] + v[i][1] * v[i][1]) + (v[i][2] * v[i][2] + v[i][3] * v[i][3]); }
    const float rstd = rsqrtf(wave_sum(q) * (1.0f / DM) + 1e-5f);
#pragma unroll
    for (int i = 0; i < 8; ++i) { const f32x4 gg = ((const f32x4*)g)[i * 64 + lane], bb = ((const f32x4*)bt)[i * 64 + lane]; v[i] = v[i] * rstd * gg + bb; }
}
template <bool LN>
__device__ __forceinline__ void ln_phase(const void* src, const float* g, const float* bt, float* xout, h16* xh, const float* mu, h16* mix) {
    const int lane = otid() & 63, gw = obid() * 8 + (otid() >> 6), GW = gridDim.x * 8;
    for (int ch = gw; ch < MTOK / 8; ch += GW) {
        const size_t t0 = (size_t)ch * 8;
        f32x4 prev[8], cur[8];
        if (mix) {
            if ((t0 & (SEQ - 1)) == 0) {
#pragma unroll
                for (int i = 0; i < 8; ++i) prev[i] = (f32x4){0.f, 0.f, 0.f, 0.f};
            } else ln_row<LN>(src, t0 - 1, lane, g, bt, prev);
        }
        h16x4 raw[8], rawn[8];
        if (LN) ln_load16(src, t0, lane, raw);
#pragma unroll 1
        for (int r = 0; r < 8; ++r) {
            const size_t row = t0 + r;
            asm volatile("" ::: "memory");
            if (LN) {
                ln_load16(src, t0 + (r < 7 ? r + 1 : 7), lane, rawn);
                ln_apply16(raw, lane, g, bt, cur);
#pragma unroll
                for (int i = 0; i < 8; ++i) raw[i] = rawn[i];
            } else ln_row<LN>(src, row, lane, g, bt, cur);
            if (xout) {
#pragma unroll
                for (int i = 0; i < 8; ++i) ((f32x4*)(xout + row * DM))[i * 64 + lane] = cur[i];
            }
            if (xh) {
#pragma unroll
                for (int i = 0; i < 8; ++i) { h16x4 o = {(h16)cur[i][0], (h16)cur[i][1], (h16)cur[i][2], (h16)cur[i][3]}; ((h16x4*)(xh + row * DM))[i * 64 + lane] = o; }
            }
            if (mix) {
#pragma unroll
                for (int i = 0; i < 8; ++i) {
                    asm volatile("" ::: "memory");
                    const f32x4 xx = prev[i] - cur[i];
#pragma unroll
                    for (int k = 0; k < 6; ++k) {
                        const f32x4 m4 = ((const f32x4*)(mu + (size_t)k * DM))[i * 64 + lane];
                        const f32x4 o4 = cur[i] + xx * m4;
                        h16x4 o = {(h16)o4[0], (h16)o4[1], (h16)o4[2], (h16)o4[3]};
                        ((h16x4*)(mix + ((size_t)k * MTOK + row) * DM))[i * 64 + lane] = o;
                    }
                    prev[i] = cur[i];
                }
            }
        }
    }
}

__device__ __forceinline__ void prep_phase(h16* C1, h16* Ab, h16* AA, h16* VF, const float* k_k, const float* k_a, bool first) {
    const int lane = otid() & 63, gw = obid() * 8 + (otid() >> 6), GW = gridDim.x * 8;
    for (int row = gw; row < MTOK; row += GW) {
#pragma unroll
        for (int i = 0; i < 8; ++i) {
            const int c = i * 256 + lane * 4;
            h16x4* kp = (h16x4*)(C1 + (size_t)row * LDC1 + 2048 + c);
            h16x4* ap = (h16x4*)(Ab + (size_t)row * DM + c);
            const h16x4 kh = *kp, ah = *ap;
            const f32x4 kkw = *(const f32x4*)(k_k + c), kaw = *(const f32x4*)(k_a + c);
            f32x4 k, a, kk;
#pragma unroll
            for (int e = 0; e < 4; ++e) { k[e] = (float)kh[e]; a[e] = (float)ah[e]; kk[e] = k[e] * kkw[e]; }
            float ss = (kk[0] * kk[0] + kk[1] * kk[1]) + (kk[2] * kk[2] + kk[3] * kk[3]);
            ss = grp16_sum(ss);
            const float inv = 1.0f / fmaxf(sqrtf(ss), 1e-12f);
            h16x4 ko, aao, bbo;
#pragma unroll
            for (int e = 0; e < 4; ++e) { const float kn = kk[e] * inv; ko[e] = (h16)(k[e] * (1.0f + (a[e] - 1.0f) * kaw[e])); aao[e] = (h16)(-kn); bbo[e] = (h16)(kn * a[e]); }
            *kp = ko; *ap = bbo; *(h16x4*)(AA + (size_t)row * DM + c) = aao;
            if (first) *(h16x4*)(VF + (size_t)row * DM + c) = *(const h16x4*)(C1 + (size_t)row * LDC1 + 4096 + c);
        }
    }
}

__device__ __forceinline__ void scan_phase(LAS unsigned char* lds, const h16* C1, const h16* DEC, const h16* AA, const h16* BB, float* Y,
                                           const float* sQKV, const float* sWO, const float* sUP, const float* sDN, char* Wn, const float* sUP0, const float* sDN0, char* Wc) {
    constexpr int CH = 32, NCH = SEQ / CH, BUF = 18976;
    LAS float* L = (LAS float*)lds;
    const int tid = otid(), wid = tid >> 6, lane = tid & 63;
    for (int item = obid(); item < 256; item += gridDim.x) {
        const int b = item >> 7, h = (item >> 2) & 31, q = item & 3;
        const size_t row0 = (size_t)b * SEQ;
        __syncthreads();
        if (wid >= 4) {
            const int lt = tid - 256, s = lt >> 3, e8 = lt & 7;
            struct StReg { h16x8 r8, k8, a8, b8, v8, d8; };
            auto gload = [&](int c) -> StReg {
                StReg R;
                const size_t row = row0 + (size_t)c * CH + s;
                R.r8 = *(const h16x8*)(C1 + row * LDC1 + h * 64 + e8 * 8);
                R.k8 = *(const h16x8*)(C1 + row * LDC1 + 2048 + h * 64 + e8 * 8);
                { const int tn = c * CH + s + 1; const size_t rown = row0 + (size_t)(tn < SEQ ? tn : SEQ - 1);
                  R.a8 = *(const h16x8*)(AA + rown * DM + h * 64 + e8 * 8); }
                R.b8 = *(const h16x8*)(BB + row * DM + h * 64 + e8 * 8);
                R.d8 = *(const h16x8*)(DEC + row * DM + h * 64 + e8 * 8);
                R.v8 = (h16x8){};
                if (lt < 64) R.v8 = *(const h16x8*)(C1 + (row0 + (size_t)c * CH + (lt >> 1)) * LDC1 + 4096 + h * 64 + q * 16 + (lt & 1) * 8);
                return R;
            };
            auto lwrite = [&](const StReg& R, int bufi) {
                LAS float* Bf = L + bufi * BUF;
                LAS float* dst = Bf + s * 64 + e8 * 8;
                *(LAS f32x4*)(dst + 0 * 2048) = (f32x4){(float)R.r8[0], (float)R.r8[1], (float)R.r8[2], (float)R.r8[3]}; *(LAS f32x4*)(dst + 0 * 2048 + 4) = (f32x4){(float)R.r8[4], (float)R.r8[5], (float)R.r8[6], (float)R.r8[7]};
                *(LAS f32x4*)(dst + 1 * 2048) = (f32x4){__expf(-(float)R.d8[0]), __expf(-(float)R.d8[1]), __expf(-(float)R.d8[2]), __expf(-(float)R.d8[3])};
                *(LAS f32x4*)(dst + 1 * 2048 + 4) = (f32x4){__expf(-(float)R.d8[4]), __expf(-(float)R.d8[5]), __expf(-(float)R.d8[6]), __expf(-(float)R.d8[7])};
                *(LAS f32x4*)(dst + 2 * 2048) = (f32x4){(float)R.k8[0], (float)R.k8[1], (float)R.k8[2], (float)R.k8[3]}; *(LAS f32x4*)(dst + 2 * 2048 + 4) = (f32x4){(float)R.k8[4], (float)R.k8[5], (float)R.k8[6], (float)R.k8[7]};
                *(LAS f32x4*)(dst + 3 * 2048) = (f32x4){(float)R.a8[0], (float)R.a8[1], (float)R.a8[2], (float)R.a8[3]}; *(LAS f32x4*)(dst + 3 * 2048 + 4) = (f32x4){(float)R.a8[4], (float)R.a8[5], (float)R.a8[6], (float)R.a8[7]};
                *(LAS f32x4*)(dst + 4 * 2048) = (f32x4){(float)R.b8[0], (float)R.b8[1], (float)R.b8[2], (float)R.b8[3]}; *(LAS f32x4*)(dst + 4 * 2048 + 4) = (f32x4){(float)R.b8[4], (float)R.b8[5], (float)R.b8[6], (float)R.b8[7]};
                { float cp = 0.f;
#pragma unroll
                  for (int e = 0; e < 8; ++e) cp += (float)R.b8[e] * (float)R.a8[e];
                  cp += __shfl_xor(cp, 1); cp += __shfl_xor(cp, 2); cp += __shfl_xor(cp, 4);
                  if (e8 == 0) Bf[18944 + s] = cp; }
                if (lt < 64) { LAS float* vd = Bf + 10240 + (lt >> 1) * 16 + (lt & 1) * 8;
                    *(LAS f32x4*)vd = (f32x4){(float)R.v8[0], (float)R.v8[1], (float)R.v8[2], (float)R.v8[3]}; *(LAS f32x4*)(vd + 4) = (f32x4){(float)R.v8[4], (float)R.v8[5], (float)R.v8[6], (float)R.v8[7]}; }
            };
            auto yout = [&](int c, int bufi) {
#pragma unroll
                for (int o2 = 0; o2 < 2; ++o2) {
                    const int o = lt + 256 * o2, ys = o >> 4, yr = o & 15;
                    LAS float* yp = L + bufi * BUF + 10752 + o * 16;
                    f32x4 acc4 = *(LAS f32x4*)(yp + (((0 + (o >> 2)) & 3) << 2));
#pragma unroll
                    for (int i = 1; i < 4; ++i) acc4 += *(LAS f32x4*)(yp + (((i + (o >> 2)) & 3) << 2));
                    Y[(row0 + (size_t)c * CH + ys) * DM + h * 64 + q * 16 + yr] = (acc4[0] + acc4[1]) + (acc4[2] + acc4[3]);
                }
            };
            const int lw = (lt >> 6), wgl = item * 4 + lw;
            LAS h16* ctile = (LAS h16*)(lds + 2 * BUF * 4) + lw * 512;
            f32x4 cv0 = (f32x4){0.f, 0.f, 0.f, 0.f}, cv1 = cv0; h16* cdst = nullptr;
            auto cvt_issue = [&](int tix) {
                constexpr int T0 = 128 * 192, T1 = 128 * 64, T2 = 128 * 344, T3 = 344 * 64;
                cdst = nullptr;
                if (tix >= T0 + T1 + 2 * (T2 + T3)) return;
                const float* src; h16* dst; int Ks, Ns, rm = 0, t = tix;
                if (t >= T0 + T1 + T2 + T3) {
                    t -= T0 + T1 + T2 + T3;
                    if (t < T2) { src = sUP0; dst = (h16*)(Wc + W_UP); Ks = DM; Ns = 2 * FF; rm = 1; }
                    else { t -= T2; src = sDN0; dst = (h16*)(Wc + W_DN); Ks = FF; Ns = DM; }
                }
                else if (t < T0) { src = sQKV; dst = (h16*)(Wn + W_B1); Ks = DM; Ns = 6144; }
                else if (t < T0 + T1) { t -= T0; src = sWO; dst = (h16*)(Wn + W_WO); Ks = DM; Ns = DM; }
                else if (t < T0 + T1 + T2) { t -= T0 + T1; src = sUP; dst = (h16*)(Wn + W_UP); Ks = DM; Ns = 2 * FF; rm = 1; }
                else { t -= T0 + T1 + T2; src = sDN; dst = (h16*)(Wn + W_DN); Ks = FF; Ns = DM; }
                const int tk = Ks >> 4, k0 = (t % tk) * 16, n0 = (t / tk) * 32;
                const int ln = lt & 63, kr = ln >> 3, nc = (ln & 7) * 4;
                cv0 = *(const f32x4*)(src + (size_t)(k0 + kr) * Ns + n0 + nc); cv1 = *(const f32x4*)(src + (size_t)(k0 + kr + 8) * Ns + n0 + nc);
                const int n = ln & 31, hf = ln >> 5, no = n0 + n;
                const int nd = rm == 0 ? no : (no < FF ? (no >> 7) * 256 + (no & 127) : ((no - FF) >> 7) * 256 + 128 + ((no - FF) & 127));
                cdst = dst + (size_t)nd * Ks + k0 + hf * 8;
            };
            auto cvt_finish = [&]() {
                if (cdst == nullptr) return;
                const int ln = lt & 63, kr = ln >> 3, nc = (ln & 7) * 4;
#pragma unroll
                for (int e = 0; e < 4; ++e) { ctile[(nc + e) * 16 + kr] = (h16)cv0[e]; ctile[(nc + e) * 16 + kr + 8] = (h16)cv1[e]; }
                asm volatile("s_waitcnt lgkmcnt(0)" ::: "memory");
                const h16x8 o = *(LAS h16x8*)(ctile + (ln & 31) * 16 + (ln >> 5) * 8);
                *(h16x8*)cdst = o;
                asm volatile("s_waitcnt lgkmcnt(0)" ::: "memory");
            };
            { const StReg R0 = gload(0); lwrite(R0, 0); }
            StReg RA = gload(1);
            __syncthreads();
            for (int c = 0; c < NCH; ++c) {
                StReg RB = RA;
                if (c + 2 < NCH) RB = gload(c + 2);
                if (c + 1 < NCH) lwrite(RA, (c + 1) & 1);
                if (c > 0) yout(c - 1, (c - 1) & 1);
                if (Wn) { cvt_finish(); cvt_issue(wgl + 1024 * c); }
                asm volatile("s_waitcnt lgkmcnt(0)" ::: "memory");
                __builtin_amdgcn_s_barrier();
                asm volatile("" ::: "memory");
                RA = RB;
            }
            yout(NCH - 1, (NCH - 1) & 1);
            if (Wn) cvt_finish();
        } else {
            const int jg = lane & 15, rl = wid * 4 + (lane >> 4);
            f32x2 Sa = (f32x2){0.f, 0.f}, Sb = (f32x2){0.f, 0.f};
            float sa = 0.f;
            __syncthreads();
            for (int c = 0; c < NCH; ++c) {
                LAS float* Bf = L + (c & 1) * BUF;
                LAS float* vec = Bf + jg * 4;
                f32x4 r4 = *(LAS f32x4*)(vec + 0 * 2048), w4 = *(LAS f32x4*)(vec + 1 * 2048), k4 = *(LAS f32x4*)(vec + 2 * 2048), a4 = *(LAS f32x4*)(vec + 3 * 2048), b4 = *(LAS f32x4*)(vec + 4 * 2048);
                float v = Bf[10240 + rl], cn = Bf[18944];
#pragma unroll 1
                for (int s0 = 0; s0 < CH; s0 += 8) {
                    float yv[8];
#pragma unroll
                    for (int u = 0; u < 8; ++u) {
                        const int s = s0 + u, sn = (s + 1 < CH) ? s + 1 : CH - 1;
                        const f32x4 r4n = *(LAS f32x4*)(vec + 0 * 2048 + sn * 64), w4n = *(LAS f32x4*)(vec + 1 * 2048 + sn * 64), k4n = *(LAS f32x4*)(vec + 2 * 2048 + sn * 64),
                                    a4n = *(LAS f32x4*)(vec + 3 * 2048 + sn * 64), b4n = *(LAS f32x4*)(vec + 4 * 2048 + sn * 64);
                        const float vn = Bf[10240 + sn * 16 + rl], cnn = Bf[18944 + sn];
                        const f32x2 aL = {a4[0], a4[1]}, aH = {a4[2], a4[3]}, wL = {w4[0], w4[1]}, wH = {w4[2], w4[3]}, kL = {k4[0], k4[1]}, kH = {k4[2], k4[3]},
                                    bL = {b4[0], b4[1]}, bH = {b4[2], b4[3]}, rL = {r4[0], r4[1]}, rH = {r4[2], r4[3]};
                        const f32x2 uL = Sa * wL + kL * v, uH = Sb * wH + kH * v;
                        const f32x2 dz = uL * aL + uH * aH;
                        const float z = row16_sum(dz[0] + dz[1]);
                        Sa = bL * sa + uL; Sb = bH * sa + uH;
                        const f32x2 dr = Sa * rL + Sb * rH;
                        yv[u] = dr[0] + dr[1];
                        sa = z + cn * sa;
                        r4 = r4n; w4 = w4n; k4 = k4n; a4 = a4n; b4 = b4n; v = vn; cn = cnn;
                    }
#pragma unroll
                    for (int u = 0; u < 8; ++u) Bf[10752 + ((s0 + u) * 16 + rl) * 16 + jg] = yv[u];
                }
                __syncthreads();
            }
        }
    }
}

__device__ __forceinline__ void gn_phase(const float* Y, const h16* C1, const h16* Gb, h16* YG, const float* r_k, const float* lnx_g, const float* lnx_b, h16* VFw) {
    const int lane = otid() & 63, gw = obid() * 8 + (otid() >> 6), GW = gridDim.x * 8;
    for (int row = gw; row < MTOK; row += GW) {
#pragma unroll
        for (int i = 0; i < 8; ++i) {
            const int c = i * 256 + lane * 4;
            const f32x4 y = *(const f32x4*)(Y + (size_t)row * DM + c);
            const h16x4 rh = *(const h16x4*)(C1 + (size_t)row * LDC1 + c), kh = *(const h16x4*)(C1 + (size_t)row * LDC1 + 2048 + c), vh = *(const h16x4*)(C1 + (size_t)row * LDC1 + 4096 + c);
            const h16x4 gh = *(const h16x4*)(Gb + (size_t)row * DM + c);
            const f32x4 rk = *(const f32x4*)(r_k + c), lg = *(const f32x4*)(lnx_g + c), lb = *(const f32x4*)(lnx_b + c);
            float s = (y[0] + y[1]) + (y[2] + y[3]);
            const float mean = grp16_sum(s) * (1.0f / 64.0f);
            const f32x4 d = y - mean;
            float qv = (d[0] * d[0] + d[1] * d[1]) + (d[2] * d[2] + d[3] * d[3]);
            const float rstd = rsqrtf(grp16_sum(qv) * (1.0f / 64.0f) + 64e-5f);
            float bs = 0.f;
#pragma unroll
            for (int e = 0; e < 4; ++e) bs += (float)rh[e] * (float)kh[e] * rk[e];
            bs = grp16_sum(bs);
            h16x4 o;
#pragma unroll
            for (int e = 0; e < 4; ++e) o[e] = (h16)((d[e] * rstd * lg[e] + lb[e] + bs * (float)vh[e]) * (float)gh[e]);
            *(h16x4*)(YG + (size_t)row * DM + c) = o;
            if (VFw) *(h16x4*)(VFw + (size_t)row * DM + c) = vh;
        }
    }
}

__device__ __forceinline__ void convglu_phase(const h16* U, h16* ACT, const float* cw, const float* cb) {
    constexpr int NCG = FF / 8, RC = 16, NT = (MTOK / RC) * NCG;
    for (int task = obid() * 512 + otid(); task < NT; task += gridDim.x * 512) {
        const int cgi = task % NCG, rc = task / NCG, f = cgi * 8, m0 = rc * RC;
        float w0[8], w1[8], w2[8], bb[8], g1[8], g2[8];
#pragma unroll
        for (int e = 0; e < 8; ++e) { w0[e] = cw[f + e]; w1[e] = cw[FF + f + e]; w2[e] = cw[2 * FF + f + e]; bb[e] = cb[f + e]; g1[e] = 0.f; g2[e] = 0.f; }
        if ((m0 & (SEQ - 1)) != 0) {
            const h16x8 a = *(const h16x8*)(U + (size_t)(m0 - 1) * (2 * FF) + FF + f), c2 = *(const h16x8*)(U + (size_t)(m0 - 2) * (2 * FF) + FF + f);
#pragma unroll
            for (int e = 0; e < 8; ++e) { g1[e] = (float)a[e]; g2[e] = (float)c2[e]; }
        }
        for (int r = 0; r < RC; ++r) {
            const size_t m = (size_t)(m0 + r);
            const h16x8 uh = *(const h16x8*)(U + m * (2 * FF) + f), gh = *(const h16x8*)(U + m * (2 * FF) + FF + f);
            h16x8 o;
#pragma unroll
            for (int e = 0; e < 8; ++e) {
                const float g0 = (float)gh[e];
                const float gc = bb[e] + g2[e] * w0[e] + g1[e] * w1[e] + g0 * w2[e];
                const float z = 1.5957691216057308f * (gc + 0.044715f * gc * gc * gc);
                const float ge = gc / (1.0f + __expf(-z));
                o[e] = (h16)((float)uh[e] * ge);
                g2[e] = g1[e]; g1[e] = g0;
            }
            *(h16x8*)(ACT + m * FF + f) = o;
        }
    }
}

__device__ __forceinline__ void attn_phase(LAS unsigned char* lds, const h16* Qb, const h16* Kb, const h16* Vt, h16* AO, const float* rel_bias, const float* lam, const float* subg, float lambda_init) {
    const int wid = __builtin_amdgcn_readfirstlane(otid() >> 6), rg = wid & 3, mp = wid >> 2;
    LAS float* lut = (LAS float*)(lds + 131072);
    LAS float* osh = (LAS float*)lds;
    for (int vc = obid(); vc < 256; vc += gridDim.x) {
        const int bh = vc & 15, jj = vc >> 4, b = bh >> 3, h = bh & 7;
        for (int it = 0; it < 4; ++it) {
            const int qb = it == 0 ? 63 - jj : (it == 1 ? 32 + jj : (it == 2 ? 31 - jj : jj));
            __syncthreads();
            const int tid = otid(), lane = tid & 63, l32 = lane & 31, hh = lane >> 5;
            const int xk = l32 & 15, yv = (l32 >> 2) & 3;
            if (tid <= 128) {
                const float* rbp_ = rel_bias; asm volatile("" : "+s"(rbp_)); const GAS float* rbp = (const GAS float*)rbp_;
                float val = 0.f;
                if (tid < 128) { int bk = tid; if (tid >= 16) { bk = 16 + (int)(__logf((float)tid * (1.0f / 16.0f)) / 2.0794415416798357f * 16.0f); bk = bk > 31 ? 31 : bk; }
                    val = (rbp[bk * 8 + h] - rbp[31 * 8 + h]) * LOG2E; }
                lut[tid] = val;
            }
            const int q0 = qb * 128, qrow = q0 + 32 * rg + l32;
            const size_t tokbase = (size_t)b * SEQ;
            LAS unsigned char* qs = lds + 65536 + wid * 8192 + lane * 16;
            { const h16* qp = Qb + (tokbase + qrow) * DM + h * 256 + mp * 128 + hh * 8;
              h16x8 qf[8];
#pragma unroll
              for (int k = 0; k < 8; ++k) qf[k] = *(const h16x8*)(qp + k * 16);
#pragma unroll
              for (int k = 0; k < 8; ++k) *(LAS h16x8*)(qs + k * 1024) = qf[k]; }
            f32x16 O[8];
#pragma unroll
            for (int i = 0; i < 8; ++i)
#pragma unroll
                for (int r = 0; r < 16; ++r) O[i][r] = 0.f;
            float mrun = -1e30f, lrun = 0.f;
            const int nks = 4 * qb + 4;
            const int kkey = wid * 2 + (lane >> 5);
            const h16* kg = Kb + (tokbase + kkey) * DM + h * 256 + (((lane & 31) ^ (kkey & 15)) << 3);
            const int vdv = wid * 16 + (lane >> 2);
            const h16* vg = Vt + ((size_t)((b * 8 + h) * 256) + vdv) * SEQ + (((lane & 3) ^ ((lane >> 4) & 3)) << 3);
#define ATT_ISSUE(KS, BUF) do { _Pragma("unroll") for (int _i = 0; _i < 2; ++_i) \
                __builtin_amdgcn_global_load_lds((const unsigned*)(kg + (size_t)(32 * (KS) + 16 * _i) * DM), (LAS unsigned*)((BUF) + (_i * 8 + wid) * 1024), 16, 0, 0); \
              _Pragma("unroll") for (int _i = 0; _i < 2; ++_i) \
                __builtin_amdgcn_global_load_lds((const unsigned*)(vg + (size_t)(128 * _i) * SEQ + 32 * (KS)), (LAS unsigned*)((BUF) + 16384 + (_i * 8 + wid) * 1024), 16, 0, 0); } while (0)
#define ATT_SCHED __builtin_amdgcn_sched_barrier(0)
            ATT_ISSUE(0, lds);
            asm volatile("s_waitcnt vmcnt(0)" ::: "memory");
            __syncthreads();
            for (int ks = 0; ks < nks; ++ks) {
                LAS unsigned char* cb = lds + (ks & 1) * 32768; LAS unsigned char* nb = lds + ((ks & 1) ^ 1) * 32768;
                if (ks + 1 < nks) ATT_ISSUE(ks + 1, nb);
                if (ks <= 4 * qb + rg) {
                    const bool near = ks >= 4 * qb - 4;
                    LAS unsigned char* kp_ = cb + l32 * 512 + mp * 256;
                    LAS unsigned char* vp_ = cb + 16384 + l32 * 64;
                    const int vo0 = ((0 + hh) ^ yv) << 4, vo1 = ((2 + hh) ^ yv) << 4;
                    h16x8 A0[4], A1[4];
#define LDQK(A, G) do { A[0] = *(LAS h16x8*)(kp_ + (((4 * (G) + hh) ^ xk) << 4)); A[1] = *(LAS h16x8*)(qs + (2 * (G)) * 1024); \
                        A[2] = *(LAS h16x8*)(kp_ + (((4 * (G) + 2 + hh) ^ xk) << 4)); A[3] = *(LAS h16x8*)(qs + (2 * (G) + 1) * 1024); } while (0)
#define LDV(A, D0, VO) do { _Pragma("unroll") for (int _d = 0; _d < 4; ++_d) A[_d] = *(LAS h16x8*)(vp_ + ((D0) + _d) * 2048 + (VO)); } while (0)
#define MMQK(A) do { S0 = __builtin_amdgcn_mfma_f32_32x32x16_f16(A[0], A[1], S0, 0, 0, 0); S0 = __builtin_amdgcn_mfma_f32_32x32x16_f16(A[2], A[3], S0, 0, 0, 0); } while (0)
#define MMV(A, D0, P) do { _Pragma("unroll") for (int _d = 0; _d < 4; ++_d) O[(D0) + _d] = __builtin_amdgcn_mfma_f32_32x32x16_f16(A[_d], P, O[(D0) + _d], 0, 0, 0); } while (0)
                    f32x16 S0;
#pragma unroll
                    for (int r = 0; r < 16; ++r) S0[r] = 0.f;
                    LDQK(A0, 0); ATT_SCHED;
                    LDQK(A1, 1); ATT_SCHED; MMQK(A0); ATT_SCHED;
                    LDQK(A0, 2); ATT_SCHED; MMQK(A1); ATT_SCHED;
                    LDQK(A1, 3); ATT_SCHED; MMQK(A0); ATT_SCHED;
                    LDV(A0, 0, vo0); ATT_SCHED; MMQK(A1); ATT_SCHED;
                    if (near) {
#pragma unroll
                        for (int r = 0; r < 16; ++r) {
                            const int kp = 32 * ks + (r >> 2) * 8 + hh * 4 + (r & 3); const int d0 = qrow - kp;
                            const int di = d0 < 0 ? 0 : (d0 > 128 ? 128 : d0);
                            const float bv = lut[di];
                            S0[r] = d0 < 0 ? -1e30f : S0[r] + bv;
                        }
                    }
                    float mt = S0[0];
#pragma unroll
                    for (int r = 1; r < 16; ++r) mt = fmaxf(mt, S0[r]);
                    if (__builtin_amdgcn_ballot_w64(mt - mrun > 10.0f) != 0ull) {
                        const float mo = fmaxf(mt, __shfl_xor(mt, 32));
                        const float mn = fmaxf(mrun, mo);
                        const float al = __builtin_amdgcn_exp2f(mrun - mn);
                        mrun = mn; lrun *= al;
#pragma unroll
                        for (int i = 0; i < 8; ++i) O[i] = O[i] * al;
                    }
                    float ps = 0.f;
#pragma unroll
                    for (int r = 0; r < 16; ++r) { S0[r] = __builtin_amdgcn_exp2f(S0[r] - mrun); ps += S0[r]; }
                    lrun += ps;
                    h16x8 P0, P1;
#pragma unroll
                    for (int e = 0; e < 8; ++e) { P0[e] = (h16)S0[e]; P1[e] = (h16)S0[8 + e]; }
                    ATT_SCHED;
                    LDV(A1, 4, vo0); ATT_SCHED; MMV(A0, 0, P0); ATT_SCHED;
                    LDV(A0, 0, vo1); ATT_SCHED; MMV(A1, 4, P0); ATT_SCHED;
                    LDV(A1, 4, vo1); ATT_SCHED; MMV(A0, 0, P1); ATT_SCHED;
                    MMV(A1, 4, P1);
#undef LDQK
#undef LDV
#undef MMQK
#undef MMV
                }
                asm volatile("s_waitcnt vmcnt(0)" ::: "memory");
                __syncthreads();
            }
#undef ATT_ISSUE
#undef ATT_SCHED
            lrun += __shfl_xor(lrun, 32);
            const float inv = 1.0f / lrun;
            const int lane2 = otid() & 63, l32b = lane2 & 31, hhb = lane2 >> 5;
            const int obase = (rg * 8) * 16 * 64 + lane2;
            if (mp == 1) {
                float lf;
                { const float* lmp_ = lam; asm volatile("" : "+s"(lmp_)); const GAS float* lmp = (const GAS float*)lmp_;
                  float s1 = 0.f, s2 = 0.f; for (int i = lane2; i < 128; i += 64) { s1 += lmp[i] * lmp[128 + i]; s2 += lmp[256 + i] * lmp[384 + i]; }
                  s1 = wave_sum(s1); s2 = wave_sum(s2); lf = __expf(s1) - __expf(s2) + lambda_init; }
                const float sc = inv * lf;
#pragma unroll
                for (int dvb = 0; dvb < 8; ++dvb)
#pragma unroll
                    for (int r = 0; r < 16; ++r) osh[obase + (dvb * 16 + r) * 64] = O[dvb][r] * sc;
            }
            __syncthreads();
            if (mp == 0) {
                const float* sgp_ = subg; asm volatile("" : "+s"(sgp_)); const GAS float* sgp = (const GAS float*)sgp_;
                float ss = 0.f;
#pragma unroll
                for (int dvb = 0; dvb < 8; ++dvb)
#pragma unroll
                    for (int r = 0; r < 16; ++r) { const float o = O[dvb][r] * inv - osh[obase + (dvb * 16 + r) * 64]; O[dvb][r] = o; ss += o * o; }
                ss += __shfl_xor(ss, 32);
                const float rms = rsqrtf(ss * (1.0f / 256.0f) + 1e-5f) * (1.0f - lambda_init);
                h16* op = AO + ((size_t)b * SEQ + q0 + 32 * rg + l32b) * DM + h * 256 + hhb * 4;
#pragma unroll
                for (int dvb = 0; dvb < 8; ++dvb)
#pragma unroll
                    for (int rq = 0; rq < 4; ++rq) {
                        const int dv0 = dvb * 32 + rq * 8;
                        const f32x4 sg = *(const GAS f32x4*)(sgp + dv0 + hhb * 4);
                        h16x4 o = {(h16)(O[dvb][rq * 4 + 0] * rms * sg[0]), (h16)(O[dvb][rq * 4 + 1] * rms * sg[1]), (h16)(O[dvb][rq * 4 + 2] * rms * sg[2]), (h16)(O[dvb][rq * 4 + 3] * rms * sg[3])};
                        *(h16x4*)(op + dv0) = o;
                    }
            }
        }
    }
}

#define XB_TMO      128
#define XB_XCNT(j)  (256  + 64 * (j))
#define XB_XSUB(j)  (1280 + 64 * (j))
#define XB_XGEN(j)  (2304 + 64 * (j))
#define XB_TOP      3328
#define XB_TOPGEN   3392
#define XCD_BAR_WORDS 3456
#define XB_SPIN_CAP (1u << 18)

__device__ __forceinline__ unsigned xb_ld(unsigned* p)              { return __hip_atomic_load(p, __ATOMIC_RELAXED, __HIP_MEMORY_SCOPE_AGENT); }
__device__ __forceinline__ unsigned xb_add(unsigned* p, unsigned v) { return __hip_atomic_fetch_add(p, v, __ATOMIC_RELAXED, __HIP_MEMORY_SCOPE_AGENT); }
__device__ __forceinline__ unsigned xb_xcc_id() { return (unsigned)__builtin_amdgcn_s_getreg((3 << 11) | 20) & 0xFu; }
#define XB_SPIN(cond, bar) do { unsigned _sp = 0; while (cond) { __builtin_amdgcn_s_sleep(1); \
    if ((++_sp & 255u) == 0u) { if (xb_ld(&(bar)[XB_TMO])) break; if (_sp > XB_SPIN_CAP) { atomicAdd(&(bar)[XB_TMO], 1u); break; } } } } while (0)

struct XcdBarrier {
    unsigned* bar; unsigned x;
    volatile LAS unsigned* st;
};

__device__ __forceinline__ XcdBarrier xcd_barrier_post(unsigned* bar, volatile LAS unsigned* st) {
    XcdBarrier b; b.bar = bar; b.x = xb_xcc_id(); b.st = st;
    if (threadIdx.x == 0) (void)xb_add(&bar[XB_XCNT(b.x)], 1u);
    return b;
}
__device__ __forceinline__ void xcd_barrier_complete(unsigned* bar, unsigned x, unsigned& nloc, unsigned& nx) {
    const unsigned G = gridDim.x * gridDim.y * gridDim.z;
    unsigned sum, cnt, mine, sp = 0u;
    for (;;) {
        sum = 0u; cnt = 0u; mine = 0u;
#pragma unroll
        for (unsigned j = 0; j < 16; ++j) { const unsigned c = xb_ld(&bar[XB_XCNT(j)]); sum += c; cnt += (c > 0u) ? 1u : 0u; mine = (j == x) ? c : mine; }
        if (sum == G) break;
        __builtin_amdgcn_s_sleep(1);
        if ((++sp & 255u) == 0u) { if (xb_ld(&bar[XB_TMO])) break; if (sp > XB_SPIN_CAP) { atomicAdd(&bar[XB_TMO], 1u); break; } }
    }
    nloc = mine > 0u ? mine : 1u; nx = cnt > 0u ? cnt : 1u;
}

__device__ __forceinline__ void xcd_barrier(const XcdBarrier& b) {
    asm volatile("s_waitcnt vmcnt(0)" ::: "memory");
    __syncthreads();
    if (threadIdx.x == 0) {
        unsigned* bar = b.bar;
        __builtin_amdgcn_s_waitcnt(0);
        unsigned nloc = b.st[0], nx = b.st[1];
        if (nloc == 0u) { xcd_barrier_complete(bar, b.x, nloc, nx); b.st[0] = nloc; b.st[1] = nx; }
        const unsigned old = xb_add(&bar[XB_XSUB(b.x)], 1u);
        const unsigned gen = old / nloc;
        if (old + 1u == (gen + 1u) * nloc) {
            __builtin_amdgcn_fence(__ATOMIC_RELEASE, "agent");
            asm volatile("s_waitcnt vmcnt(0)" ::: "memory");
            const unsigned og = xb_add(&bar[XB_TOP], 1u);
            const unsigned tg = og / nx;
            if (og + 1u == (tg + 1u) * nx) xb_add(&bar[XB_TOPGEN], 1u);
            else XB_SPIN(xb_ld(&bar[XB_TOPGEN]) == tg, bar);
            __builtin_amdgcn_fence(__ATOMIC_ACQUIRE, "agent");
            xb_add(&bar[XB_XGEN(b.x)], 1u);
            asm volatile("s_waitcnt vmcnt(0)" ::: "memory");
        } else {
            XB_SPIN(xb_ld(&bar[XB_XGEN(b.x)]) == gen, bar);
            __builtin_amdgcn_fence(__ATOMIC_ACQUIRE, "agent");
            asm volatile("s_waitcnt vmcnt(0)" ::: "memory");
        }
    }
    __syncthreads();
}


__device__ __forceinline__ void gbar(unsigned* ctr, unsigned target) {
    asm volatile("s_waitcnt vmcnt(0)" ::: "memory");
    __syncthreads();
    if (threadIdx.x == 0) {
        __builtin_amdgcn_fence(__ATOMIC_RELEASE, "agent");
        asm volatile("s_waitcnt vmcnt(0)" ::: "memory");
        __hip_atomic_fetch_add(ctr, 1u, __ATOMIC_RELAXED, __HIP_MEMORY_SCOPE_AGENT);
        while (__hip_atomic_load(ctr, __ATOMIC_RELAXED, __HIP_MEMORY_SCOPE_AGENT) < target) __builtin_amdgcn_s_sleep(1);
        __builtin_amdgcn_fence(__ATOMIC_ACQUIRE, "agent");
        asm volatile("s_waitcnt vmcnt(0)" ::: "memory");
    }
    __syncthreads();
}

#ifndef ONLY_GI
#define ENG(k) true
#else
#define ENG(k) ((k) == ONLY_GI)
#endif
#ifndef ONLY_KIND
#define EN(k) true
#else
#define EN(k) ((k) == ONLY_KIND)
#endif
__global__ void __launch_bounds__(512, 2) fwd_megakernel(Params p) {
    extern __shared__ __attribute__((aligned(16))) unsigned char shm[];
    LAS unsigned char* lds = (LAS unsigned char*)shm;
    cg::grid_group grid = cg::this_grid();
    unsigned char* ws = p.ws;
    h16* PRE = (h16*)(ws + WS_PRE); h16* XH = (h16*)(ws + WS_XH); h16* VF = (h16*)(ws + WS_VF);
    unsigned char* R1 = ws + WS_R1; unsigned char* R2 = ws + WS_R2; float* Y = (float*)(ws + WS_Y);
    h16* MIX = (h16*)R1; h16* SIDE = (h16*)R1; h16* AO = (h16*)R1;
    h16* DEC = (h16*)(R1 + R1_DEC); h16* Ab = (h16*)(R1 + R1_A); h16* Gb = (h16*)(R1 + R1_G); h16* AA = (h16*)(R1 + R1_AA); h16* YG = (h16*)(R1 + R1_YG);
    h16* C1 = (h16*)R2; h16* ACT = (h16*)R2; h16* Qb = (h16*)R2; h16* Kb = Qb + (size_t)MTOK * DM; h16* Vt = Kb + (size_t)MTOK * DM;

    volatile LAS unsigned* xst = (volatile LAS unsigned*)(lds + LDS_BYTES - 16);
    if (threadIdx.x == 0) { xst[0] = 0u; xst[1] = 0u; }
    __syncthreads();
    const XcdBarrier xb = xcd_barrier_post((unsigned*)(ws + WS_BAR), xst);
    for (int ph = p.ph_lo; ph < p.ph_hi; ++ph) {
        int layer, kind;
        if (ph < 11) { layer = 0; kind = (int)((0xDCBA9854210ull >> (4 * ph)) & 15ull); }
        else if (ph < 19) { layer = 1; kind = (int)((0xDCBA9876ull >> (4 * (ph - 11))) & 15ull); }
        else if (ph < 29) { layer = 2; kind = (int)((0xDCBA985421ull >> (4 * (ph - 19))) & 15ull); }
        else { layer = 3; kind = (int)((0xDCBA9876ull >> (4 * (ph - 29))) & 15ull); }
        const int j = layer >> 1;
        const char* W = (const char*)(ws + ((layer & 1) ? WS_X : WS_W16));
        const h16* wB1 = (const h16*)(W + W_B1); const h16* wB2 = (const h16*)(W + W_B2); const h16* wWO = (const h16*)(W + W_WO);
        const h16* wUP = (const h16*)(W + W_UP); const h16* wDN = (const h16*)(W + W_DN);
        const int nrep = ((PROBE_MASK >> kind) & 1) ? 2 : 1;
        for (int rep = 0; rep < nrep; ++rep)
        switch (kind) {
        case 0: if (EN(0)) {
            cvt_layer(lds, p, 0);
            ln_phase<false>(p.in[0], nullptr, nullptr, nullptr, XH, p.in[3], MIX);
        } break;
        case 1: if (EN(1)) {
            AMapMix am{(const char*)MIX}; EpiG1 e{C1};
            pg8::gemm_phase(lds, am, DM, wB1, DM, MTOK, j == 0 ? 6912 : 7168, DM, e);
        } break;
        case 2: if (EN(2)) {
            const float* w0 = p.in[5] + (size_t)j * DM; const float* a0 = p.in[8] + (size_t)j * DM; const float* v0 = p.in[11] + (size_t)(j > 0 ? j - 1 : 0) * DM;
            int k2 = 256; asm volatile("" : "+s"(k2));
            if (ENG(0)) { AMapOne am{(const char*)(C1 + 6144)}; EpiG2<0> e{DEC, Ab, Gb, C1, VF, w0, a0, v0, AA, p.in[16] + (size_t)j * DM, p.in[17] + (size_t)j * DM}; pg8::gemm_phase(lds, am, LDC1, wB2, 256, MTOK, DM, k2, e); }
            if (ENG(1)) { AMapOne am{(const char*)(C1 + 6400)}; EpiG2<1> e{DEC, Ab, Gb, C1, VF, w0, a0, v0, AA, p.in[16] + (size_t)j * DM, p.in[17] + (size_t)j * DM}; pg8::gemm_phase(lds, am, LDC1, wB2 + (size_t)2048 * 256, 256, MTOK, DM, k2, e); }
            if (ENG(2)) { AMapOne am{(const char*)(C1 + 6656)}; EpiG2<2> e{DEC, Ab, Gb, C1, VF, w0, a0, v0, AA, p.in[16] + (size_t)j * DM, p.in[17] + (size_t)j * DM}; pg8::gemm_phase(lds, am, LDC1, wB2 + (size_t)4096 * 256, 256, MTOK, DM, k2, e); }
            if (ENG(3) && j > 0) { AMapOne am{(const char*)(C1 + 6912)}; EpiG2<3> e{DEC, Ab, Gb, C1, VF, w0, a0, v0, AA, p.in[16] + (size_t)j * DM, p.in[17] + (size_t)j * DM}; pg8::gemm_phase(lds, am, LDC1, wB2 + (size_t)6144 * 256, 256, MTOK, DM, k2, e); }
        } break;
        case 3: if (EN(3)) prep_phase(C1, Ab, AA, VF, p.in[16] + (size_t)j * DM, p.in[17] + (size_t)j * DM, j == 0); break;
        case 4: if (EN(4)) scan_phase(lds, C1, DEC, AA, Ab, Y, p.in[22] + (size_t)j * DM * 6144, p.in[25] + (size_t)j * DM * DM, p.in[27] + (size_t)(layer + 1) * DM * 2 * FF, p.in[30] + (size_t)(layer + 1) * FF * DM, (char*)(ws + WS_X),
                                       p.in[27] + (size_t)layer * DM * 2 * FF, p.in[30] + (size_t)layer * FF * DM, (char*)(ws + WS_W16)); break;
        case 5: if (EN(5)) gn_phase(Y, C1, Gb, YG, p.in[18] + (size_t)j * DM, p.in[19] + (size_t)j * DM, p.in[20] + (size_t)j * DM, j == 0 ? VF : nullptr); break;
        case 6: if (EN(6)) {
            AMapOne am{(const char*)XH}; EpiQKV e{Qb, Kb, Vt};
            pg8::gemm_phase(lds, am, DM, wB1, DM, MTOK, 6144, DM, e);
        } break;
        case 7: if (EN(7)) {
            const float li = layer == 1 ? 0.35550906759096926f : 0.5560581861995943f;
            attn_phase(lds, Qb, Kb, Vt, AO, p.in[26], p.in[23] + (size_t)j * 512, p.in[24] + (size_t)j * 256, li);
        } break;
        case 8: if (EN(8)) {
            AMapOne am{(const char*)((layer & 1) ? AO : YG)}; EpiRes e{XH, PRE};
            pg8::gemm_phase(lds, am, DM, wWO, DM, MTOK, DM, DM, e);
        } break;
        case 9: case 13: if (EN(9)) {
            const int sub = kind == 9 ? 0 : 1;
            const float* g = p.in[1] + (size_t)(layer * 2 + sub) * DM; const float* bt = p.in[2] + (size_t)(layer * 2 + sub) * DM;
            float* xo = nullptr; h16* xh = XH; const float* mu = nullptr; h16* mx = nullptr;
            if (kind == 13) {
                if (layer == 3) { xo = p.out; xh = nullptr; }
                else {
                    if (layer == 1) cvt_layer(lds, p, layer + 1);
                    if (layer == 1) { mu = p.in[3] + (size_t)1 * 6 * DM; mx = MIX; }
                }
            }
            ln_phase<true>(PRE, g, bt, xo, xh, mu, mx);
        } break;
        case 10: if (EN(10)) {
            AMapOne am{(const char*)XH}; EpiUpConv e{ACT, SIDE, p.in[28] + (size_t)layer * 3 * FF, p.in[29] + (size_t)layer * FF};
            pg8::gemm_phase(lds, am, DM, wUP, DM, MTOK, 2 * FF, DM, e);
        } break;
        case 11: if (EN(11)) convfix_phase(SIDE, ACT, p.in[28] + (size_t)layer * 3 * FF, p.in[29] + (size_t)layer * FF); break;
        case 12: if (EN(12)) {
            AMapOne am{(const char*)ACT}; EpiRes e{XH, PRE};
            pg8::gemm_phase(lds, am, FF, wDN, FF, MTOK, DM, FF, e);
        } break;
        }
        if (ph + 1 < p.ph_hi) {
            if (ph == p.ph_lo) grid.sync();
            else xcd_barrier(xb);
        }
    }
}

constexpr int NPHASES = 37;

extern "C" void kernel_launch(void* const* d_in, const int* in_sizes, int n_in, void* d_out, int out_size, void* d_ws, size_t ws_size, hipStream_t stream) {
    static int grid_blocks = 0;
    if (!grid_blocks) {
        if (n_in != 31 || ws_size < WS_END) { fprintf(stderr, "kernel_launch: unexpected n_in %d / ws_size %zu (need %zu)\n", n_in, ws_size, (size_t)WS_END); grid_blocks = -1; return; }
        int dev = 0, cus = 0, per_cu = 0;
        hipGetDevice(&dev);
        hipDeviceGetAttribute(&cus, hipDeviceAttributeMultiprocessorCount, dev);
        if (hipFuncSetAttribute((const void*)fwd_megakernel, hipFuncAttributeMaxDynamicSharedMemorySize, LDS_BYTES) != hipSuccess) { fprintf(stderr, "kernel_launch: hipFuncSetAttribute failed\n"); grid_blocks = -1; return; }
        if (hipOccupancyMaxActiveBlocksPerMultiprocessor(&per_cu, (const void*)fwd_megakernel, 512, LDS_BYTES) != hipSuccess || per_cu < 1) { fprintf(stderr, "kernel_launch: occupancy query gave %d\n", per_cu); per_cu = 1; (void)hipGetLastError(); }
        grid_blocks = cus * per_cu;
        if (grid_blocks > 256) grid_blocks = 256;
    }
    if (grid_blocks < 0) return;
    Params p{};
    for (int i = 0; i < 31; ++i) p.in[i] = (const float*)d_in[i];
    p.out = (float*)d_out; p.ws = (unsigned char*)d_ws; p.ph_lo = 0; p.ph_hi = NPHASES;
    if (hipMemsetAsync((char*)d_ws + WS_BAR, 0, 16384, stream) != hipSuccess) { fprintf(stderr, "kernel_launch: memset failed\n"); return; }
    void* args[] = {&p};
    hipError_t e = hipLaunchCooperativeKernel((const void*)fwd_megakernel, dim3(grid_blocks), dim3(512), args, LDS_BYTES, stream);
    if (e != hipSuccess) fprintf(stderr, "cooperative launch failed: %s (grid %d)\n", hipGetErrorString(e), grid_blocks);
}
```

```cpp
#include <hip/hip_runtime.h>
#include <hip/hip_cooperative_groups.h>
#include <cstdio>
namespace cg = cooperative_groups;

#define LAS __attribute__((address_space(3)))
#define GAS __attribute__((address_space(1)))
typedef _Float16 h16;
typedef _Float16 h16x8 __attribute__((ext_vector_type(8)));
typedef _Float16 h16x4 __attribute__((ext_vector_type(4)));
typedef float f32x4 __attribute__((ext_vector_type(4)));
typedef float f32x2 __attribute__((ext_vector_type(2)));
typedef float f32x16 __attribute__((ext_vector_type(16)));
typedef unsigned u32x4 __attribute__((ext_vector_type(4)));

constexpr int MTOK = 16384, DM = 2048, SEQ = 8192, FF = 5504, LDC1 = 7168;
constexpr float ALPHA = 1.681792830507429f;
constexpr float LOG2E = 1.4426950408889634f;
constexpr float QSCALE = 0.08838834764831845f * LOG2E;
constexpr int LDS_BYTES = 157696;
#define PROBE_MASK 0x0000

constexpr size_t W_B1 = 0, W_B2 = 29360128, W_WO = 33554432, W_UP = 41943040, W_DN = 87031808;
constexpr size_t WS_W16 = 0, WS_X = 117440512, WS_PRE = WS_X + 134217728, WS_XH = WS_PRE + 134217728, WS_VF = WS_XH + 67108864,
                 WS_R1 = WS_VF + 67108864, WS_R2 = WS_R1 + 402653184, WS_Y = WS_R2 + 234881024, WS_BAR = WS_Y + 134217728, WS_END = WS_BAR + 16384;
constexpr size_t R1_DEC = 0, R1_A = 134217728, R1_G = R1_A + 67108864, R1_AA = R1_G + 67108864, R1_YG = R1_AA + 67108864;

struct Params {
    const float* in[31];
    float* out;
    unsigned char* ws;
    int ph_lo, ph_hi;
};

__device__ __forceinline__ int otid() { int t = (int)threadIdx.x; asm volatile("" : "+v"(t)); return t; }
__device__ __forceinline__ int obid() { int t = (int)blockIdx.x; asm volatile("" : "+s"(t)); return t; }
template <int CTRL> __device__ __forceinline__ float dpp_f(float x) { return __int_as_float(__builtin_amdgcn_update_dpp(0, __float_as_int(x), CTRL, 0xF, 0xF, true)); }
__device__ __forceinline__ float row16_sum(float x) { x += dpp_f<0xB1>(x); x += dpp_f<0x4E>(x); x += dpp_f<0x141>(x); x += dpp_f<0x140>(x); return x; }
__device__ __forceinline__ float grp16_sum(float x) { return row16_sum(x); }
__device__ __forceinline__ float wave_sum(float x) { x = row16_sum(x); x += __shfl_xor(x, 16); x += __shfl_xor(x, 32); return x; }
__device__ __forceinline__ float sigmoidf_(float x) { return 1.0f / (1.0f + __expf(-x)); }

namespace pg8 {
constexpr int BM = 256, BK = 64, HALF = 128, HTB = HALF * BK * 2, NXCD = 8, WGM = 4;
__device__ __forceinline__ int lds_byte(int r, int c) { const int st = (r >> 4) * 2 + (c >> 5), rr = r & 15, cc = c & 31, ob = rr * 64 + cc * 2; return st * 1024 + (ob ^ (((ob >> 9) & 1) << 5)); }
__device__ __forceinline__ void stage_rc(int b, int& R, int& C) { const int st = b / 1024, sb = b % 1024, swz = sb ^ (((sb >> 9) & 1) << 5); R = (st >> 1) * 16 + swz / 64; C = (st & 1) * 32 + (swz % 64) / 2; }
__device__ __forceinline__ int perm32(int rho) { const int n = rho >> 4, i = rho & 15; return 8 * (i >> 2) + 4 * n + (i & 3); }
struct Unit { int pm, pn; };
struct Order {
    int nM, nN, nwg, G, c;
    __device__ void init(int M, int N, int G_, int c_) { nM = M / BM; nN = N / BM; nwg = nM * nN; G = G_; c = c_; }
    __device__ bool next(int i, Unit& u) const {
        const long L = (long)i * G + c; if (L >= nwg) return false;
        int wgid = (int)L; { const int q = nwg / NXCD, r = nwg % NXCD, xcd = wgid % NXCD, off = wgid / NXCD; wgid = (xcd < r ? xcd * (q + 1) : r * (q + 1) + (xcd - r) * q) + off; }
        const int nig = WGM * nN, gid = wgid / nig, fm = gid * WGM, gsz = (nM - fm) < WGM ? (nM - fm) : WGM;
        u.pm = fm + ((wgid % nig) % gsz); u.pn = (wgid % nig) / gsz; return true;
    }
};

template <class Epi, class AMap>
__device__ __forceinline__ void gemm_phase(LAS unsigned char* lds, const AMap am, const int lda, const h16* Bt, const int ldb, const int M, const int N, const int K, const Epi& E) {
    const int tid = otid(), wid = __builtin_amdgcn_readfirstlane(tid >> 6), lane = tid & 63, wr = wid >> 2, wc = wid & 3, fr = lane & 15, fq = lane >> 4;
    const int nt = K / BK;
    Order S; S.init(M, N, (int)gridDim.x, obid());
    unsigned voffA[2], voffB[2];
#pragma unroll
    for (int i = 0; i < 2; ++i) { int R, C; stage_rc(tid * 16 + i * 8192, R, C); const int Rb = Epi::PERM ? ((R & ~31) + perm32(R & 31)) : R;
        voffA[i] = (unsigned)(R * lda + C) * 2u; voffB[i] = (unsigned)(Rb * ldb + C) * 2u; }
    const size_t kstep = (size_t)(BK * 2);
    const size_t hstepA = (size_t)HALF * lda * 2, hstepB = (size_t)HALF * ldb * 2;
    const size_t tstepA = 2 * hstepA, tstepB = 2 * hstepB;
    const unsigned ldsw = (unsigned)wid * 1024u;
    const int aoff = lds_byte(wr * 64 + fr, fq * 8), boff = lds_byte(wc * 32 + fr, fq * 8);
#define PG8_SA(b, h) (((b) * 2 + (h)) * HTB)
#define PG8_SB(b, h) ((4 + (b) * 2 + (h)) * HTB)
#define PG8_STAGE(bufoff, gbase, voff) do { _Pragma("unroll") for (int _i = 0; _i < 2; ++_i) \
        __builtin_amdgcn_global_load_lds((const unsigned*)((const char*)(gbase) + (voff)[_i]), (LAS unsigned*)(lds + (bufoff) + ldsw + _i * 8192), 16, 0, 0); } while (0)
#define PG8_LDA(dst, b, h) do { _Pragma("unroll") for (int m = 0; m < 4; ++m) _Pragma("unroll") for (int k = 0; k < 2; ++k) dst[m][k] = *(const LAS h16x8*)(lds + PG8_SA(b, h) + aoff + m * 2048 + k * 1024); } while (0)
#define PG8_LDB(dst, b, h) do { _Pragma("unroll") for (int n = 0; n < 2; ++n) _Pragma("unroll") for (int k = 0; k < 2; ++k) dst[n][k] = *(const LAS h16x8*)(lds + PG8_SB(b, h) + boff + n * 2048 + k * 1024); } while (0)
#define PG8_MMA(ai, bj, At, Bt_) do { __builtin_amdgcn_s_setprio(1); _Pragma("unroll") for (int m = 0; m < 4; ++m) _Pragma("unroll") for (int n = 0; n < 2; ++n) _Pragma("unroll") for (int k = 0; k < 2; ++k) \
        acc[ai][bj][m][n] = __builtin_amdgcn_mfma_f32_16x16x32_f16(Bt_[n][k], At[m][k], acc[ai][bj][m][n], 0, 0, 0); __builtin_amdgcn_s_setprio(0); } while (0)
#define PG8_WAIT_V(n) asm volatile("s_waitcnt vmcnt(" #n ")" ::: "memory")
#define PG8_WAIT_L(n) asm volatile("s_waitcnt lgkmcnt(" #n ")" ::: "memory")
#define PG8_BAR __builtin_amdgcn_s_barrier()
#define PG8_SCHED __builtin_amdgcn_sched_barrier(0)
    Unit cur, nxt; int ui = 0;
    if (!S.next(0, cur)) return;
    f32x4 acc[2][2][4][2];
#pragma unroll
    for (int a = 0; a < 2; ++a)
#pragma unroll
        for (int b = 0; b < 2; ++b)
#pragma unroll
            for (int m = 0; m < 4; ++m)
#pragma unroll
                for (int n = 0; n < 2; ++n) acc[a][b][m][n] = (f32x4){0.f, 0.f, 0.f, 0.f};
    h16x8 At[4][2], B0[2][2], B1[2][2];
    const char* cA = am(cur.pn) + (size_t)cur.pm * tstepA; const char* cB = (const char*)Bt + (size_t)cur.pn * tstepB;
    PG8_STAGE(PG8_SB(0, 0), cB, voffB); PG8_STAGE(PG8_SA(0, 0), cA, voffA); PG8_STAGE(PG8_SB(0, 1), cB + hstepB, voffB); PG8_STAGE(PG8_SA(0, 1), cA + hstepA, voffA);
    if (wr == 1) PG8_BAR;
    PG8_WAIT_V(4); PG8_BAR;
    PG8_STAGE(PG8_SB(1, 0), cB + kstep, voffB); PG8_STAGE(PG8_SA(1, 0), cA + kstep, voffA); PG8_STAGE(PG8_SB(1, 1), cB + hstepB + kstep, voffB);
    PG8_WAIT_V(6); PG8_BAR;
    for (;;) {
        const bool has_next = S.next(ui + 1, nxt);
        const char* nA = has_next ? am(nxt.pn) + (size_t)nxt.pm * tstepA : cA; const char* nB = has_next ? (const char*)Bt + (size_t)nxt.pn * tstepB : cB;
#pragma unroll 1
        for (int t = 0; t < nt; t += 2) {
            const bool last = (t == nt - 2);
            const char* a1 = cA + (size_t)(t + 1) * kstep;
            const char* a2 = last ? nA : cA + (size_t)(t + 2) * kstep; const char* b2 = last ? nB : cB + (size_t)(t + 2) * kstep;
            const char* a3 = a2 + kstep; const char* b3 = b2 + kstep;
            PG8_LDB(B0, 0, 0); PG8_SCHED; PG8_LDA(At, 0, 0); PG8_STAGE(PG8_SA(1, 1), a1 + hstepA, voffA);
            PG8_WAIT_L(8); PG8_BAR; PG8_WAIT_L(0); PG8_MMA(0, 0, At, B0); PG8_BAR; PG8_SCHED;
            PG8_LDB(B1, 0, 1); PG8_STAGE(PG8_SB(0, 0), b2, voffB);
            PG8_BAR; PG8_WAIT_L(0); PG8_MMA(0, 1, At, B1); PG8_BAR;
            PG8_LDA(At, 0, 1); PG8_STAGE(PG8_SA(0, 0), a2, voffA);
            PG8_BAR; PG8_WAIT_L(0); PG8_MMA(1, 0, At, B0); PG8_BAR; PG8_SCHED;
            PG8_STAGE(PG8_SB(0, 1), b2 + hstepB, voffB);
            PG8_WAIT_V(6); PG8_BAR; PG8_MMA(1, 1, At, B1); PG8_BAR;
            PG8_LDB(B0, 1, 0); PG8_SCHED; PG8_LDA(At, 1, 0); PG8_STAGE(PG8_SA(0, 1), a2 + hstepA, voffA);
            PG8_WAIT_L(8); PG8_BAR; PG8_WAIT_L(0); PG8_MMA(0, 0, At, B0); PG8_BAR; PG8_SCHED;
            PG8_LDB(B1, 1, 1); PG8_STAGE(PG8_SB(1, 0), b3, voffB);
            PG8_BAR; PG8_WAIT_L(0); PG8_MMA(0, 1, At, B1); PG8_BAR;
            PG8_LDA(At, 1, 1); PG8_STAGE(PG8_SA(1, 0), a3, voffA);
            PG8_BAR; PG8_WAIT_L(0); PG8_MMA(1, 0, At, B0); PG8_BAR; PG8_SCHED;
            PG8_STAGE(PG8_SB(1, 1), b3 + hstepB, voffB);
            PG8_WAIT_V(6); PG8_BAR; PG8_MMA(1, 1, At, B1); PG8_BAR;
        }
        E(acc, cur, wr, wc, fr, fq);
        if (!has_next) break;
#pragma unroll
        for (int a = 0; a < 2; ++a)
#pragma unroll
            for (int b = 0; b < 2; ++b)
#pragma unroll
                for (int m = 0; m < 4; ++m)
#pragma unroll
                    for (int n = 0; n < 2; ++n) acc[a][b][m][n] = (f32x4){0.f, 0.f, 0.f, 0.f};
        cur = nxt; cA = nA; cB = nB; ++ui;
    }
    PG8_WAIT_V(0);
    if (wr == 0) PG8_BAR;
    PG8_BAR;
#undef PG8_SA
#undef PG8_SB
#undef PG8_STAGE
#undef PG8_LDA
#undef PG8_LDB
#undef PG8_MMA
#undef PG8_WAIT_V
#undef PG8_WAIT_L
#undef PG8_BAR
#undef PG8_SCHED
}
}
using pg8::Unit;

__device__ __forceinline__ u32x4 pack8(f32x4 a, f32x4 b) {
    h16x8 v = {(h16)a[0], (h16)a[1], (h16)a[2], (h16)a[3], (h16)b[0], (h16)b[1], (h16)b[2], (h16)b[3]};
    return __builtin_bit_cast(u32x4, v);
}

struct AMapOne { const char* A; __device__ __forceinline__ const char* operator()(int) const { return A; } };
struct AMapMix {
    const char* A;
    __device__ __forceinline__ const char* operator()(int pn) const {
        int idx; if (pn < 8) idx = 0; else if (pn < 16) idx = 2; else if (pn < 24) idx = 3; else if (pn == 24) idx = 1; else if (pn == 25) idx = 4; else if (pn == 26) idx = 5; else idx = 3;
        return A + (size_t)idx * ((size_t)MTOK * DM * 2);
    }
};
struct AMapLora {
    const char* C1;
    __device__ __forceinline__ const char* operator()(int pn) const { return C1 + (size_t)(6144 + 256 * (pn >> 3)) * 2; }
};

#define EPI_ROWS_PERM  const int row0 = u.pm * 256 + wr * 64 + fr; const int colt = u.pn * 256 + wc * 32 + 8 * fq;
struct EpiH16 {
    static constexpr bool PERM = true;
    h16* O; int ldc;
    __device__ __forceinline__ void operator()(const f32x4 (&acc)[2][2][4][2], const Unit& u, int wr, int wc, int fr, int fq) const {
        EPI_ROWS_PERM
#pragma unroll
        for (int ai = 0; ai < 2; ++ai)
#pragma unroll
            for (int m = 0; m < 4; ++m) { h16* rowp = O + (size_t)(row0 + ai * 128 + m * 16) * ldc + colt;
#pragma unroll
                for (int bj = 0; bj < 2; ++bj) *(u32x4*)(rowp + bj * 128) = pack8(acc[ai][bj][m][0], acc[ai][bj][m][1]); }
    }
};
struct EpiG1 {
    static constexpr bool PERM = true;
    h16* O;
    __device__ __forceinline__ void operator()(const f32x4 (&acc)[2][2][4][2], const Unit& u, int wr, int wc, int fr, int fq) const {
        EPI_ROWS_PERM
        const int mode = u.pn == 24 ? 1 : (u.pn == 26 ? 2 : 0);
#pragma unroll
        for (int ai = 0; ai < 2; ++ai)
#pragma unroll
            for (int m = 0; m < 4; ++m) { h16* rowp = O + (size_t)(row0 + ai * 128 + m * 16) * LDC1 + colt;
#pragma unroll
                for (int bj = 0; bj < 2; ++bj) { f32x4 v0 = acc[ai][bj][m][0], v1 = acc[ai][bj][m][1];
                    if (mode == 1) {
#pragma unroll
                        for (int j = 0; j < 4; ++j) { v0[j] = 1.0f - 2.0f / (1.0f + __expf(2.0f * v0[j])); v1[j] = 1.0f - 2.0f / (1.0f + __expf(2.0f * v1[j])); } }
                    else if (mode == 2) {
#pragma unroll
                        for (int j = 0; j < 4; ++j) { v0[j] = sigmoidf_(v0[j]); v1[j] = sigmoidf_(v1[j]); } }
                    *(u32x4*)(rowp + bj * 128) = pack8(v0, v1); } }
    }
};
template <int GI_> struct EpiG2 {
    static constexpr bool PERM = true;
    h16* DEC; h16* Ab; h16* Gb; h16* C1; const h16* VF; const float* w0; const float* a0; const float* v0; h16* AA; const float* k_k; const float* k_a;
    template <int GI>
    __device__ __forceinline__ void body(const f32x4 (&acc)[2][2][4][2], int row0, int colt) const {
#pragma unroll
        for (int bj = 0; bj < 2; ++bj) {
            const int c = colt + bj * 128;
            f32x4 b0 = (f32x4){0.f, 0.f, 0.f, 0.f}, b1 = b0;
            if (GI == 0) { b0 = *(const f32x4*)(w0 + c); b1 = *(const f32x4*)(w0 + c + 4); }
            else if (GI == 1) { b0 = *(const f32x4*)(a0 + c); b1 = *(const f32x4*)(a0 + c + 4); }
            else if (GI == 3) { b0 = *(const f32x4*)(v0 + c); b1 = *(const f32x4*)(v0 + c + 4); }
#pragma unroll
            for (int ai = 0; ai < 2; ++ai)
#pragma unroll
                for (int m = 0; m < 4; ++m) {
                    const size_t row = (size_t)(row0 + ai * 128 + m * 16);
                    f32x4 x0 = acc[ai][bj][m][0] + b0, x1 = acc[ai][bj][m][1] + b1;
                    if (GI == 0) {
#pragma unroll
                        for (int j = 0; j < 4; ++j) {
                            x0[j] = 0.6065306597126334f * sigmoidf_(x0[j]); x1[j] = 0.6065306597126334f * sigmoidf_(x1[j]); }
                        *(u32x4*)(DEC + row * DM + c) = pack8(x0, x1);
                    } else if (GI == 1) {
#pragma unroll
                        for (int j = 0; j < 4; ++j) { x0[j] = sigmoidf_(x0[j]); x1[j] = sigmoidf_(x1[j]); }
                        *(u32x4*)(Ab + row * DM + c) = pack8(x0, x1);
                    } else if (GI == 2) {
                        *(u32x4*)(Gb + row * DM + c) = pack8(x0, x1);
                    } else {
                        h16* vp = C1 + row * LDC1 + 4096 + c;
                        const h16x8 vv = *(const h16x8*)vp; const h16x8 vf = *(const h16x8*)(VF + row * DM + c);
                        f32x4 o0, o1;
#pragma unroll
                        for (int j = 0; j < 4; ++j) { float v = (float)vv[j], f = (float)vf[j]; o0[j] = v + (f - v) * sigmoidf_(x0[j]); v = (float)vv[4 + j]; f = (float)vf[4 + j]; o1[j] = v + (f - v) * sigmoidf_(x1[j]); }
                        *(u32x4*)vp = pack8(o0, o1);
                    }
                    __builtin_amdgcn_sched_barrier(0);
                }
        }
    }
    __device__ __forceinline__ void body_a(const f32x4 (&acc)[2][2][4][2], int row0, int cb0) const {
#pragma unroll
        for (int ai = 0; ai < 2; ++ai)
#pragma unroll
            for (int m = 0; m < 4; ++m) {
                const size_t row = (size_t)(row0 + ai * 128 + m * 16);
                asm volatile("" ::: "memory");
                float a[2][8], kv[2][8], kk[2][8]; float ss = 0.f;
#pragma unroll
                for (int bj = 0; bj < 2; ++bj) {
                    const int c = cb0 + 32 * bj;
                    const f32x4 b0 = *(const f32x4*)(a0 + c), b1 = *(const f32x4*)(a0 + c + 4), q0 = *(const f32x4*)(k_k + c), q1 = *(const f32x4*)(k_k + c + 4);
                    const h16x8 kh = *(const h16x8*)(C1 + row * LDC1 + 2048 + c);
#pragma unroll
                    for (int e = 0; e < 4; ++e) {
                        a[bj][e] = sigmoidf_(acc[ai][bj][m][0][e] + b0[e]); a[bj][4 + e] = sigmoidf_(acc[ai][bj][m][1][e] + b1[e]);
                        kv[bj][e] = (float)kh[e]; kv[bj][4 + e] = (float)kh[4 + e];
                        kk[bj][e] = kv[bj][e] * q0[e]; kk[bj][4 + e] = kv[bj][4 + e] * q1[e];
                        ss += kk[bj][e] * kk[bj][e] + kk[bj][4 + e] * kk[bj][4 + e];
                    }
                }
                ss += __shfl_xor(ss, 16); ss += __shfl_xor(ss, 32);
                const float inv = 1.0f / fmaxf(sqrtf(ss), 1e-12f);
#pragma unroll
                for (int bj = 0; bj < 2; ++bj) {
                    const int c = cb0 + 32 * bj;
                    const f32x4 p0 = *(const f32x4*)(k_a + c), p1 = *(const f32x4*)(k_a + c + 4);
                    f32x4 ko0, ko1, ao0, ao1, bo0, bo1;
#pragma unroll
                    for (int e = 0; e < 4; ++e) {
                        ko0[e] = kv[bj][e] * (1.0f + (a[bj][e] - 1.0f) * p0[e]); ko1[e] = kv[bj][4 + e] * (1.0f + (a[bj][4 + e] - 1.0f) * p1[e]);
                        const float n0_ = kk[bj][e] * inv, n1_ = kk[bj][4 + e] * inv;
                        ao0[e] = -n0_; ao1[e] = -n1_; bo0[e] = n0_ * a[bj][e]; bo1[e] = n1_ * a[bj][4 + e];
                    }
                    *(u32x4*)(C1 + row * LDC1 + 2048 + c) = pack8(ko0, ko1);
                    *(u32x4*)(AA + row * DM + c) = pack8(ao0, ao1);
                    *(u32x4*)(Ab + row * DM + c) = pack8(bo0, bo1);
                }
                __builtin_amdgcn_sched_barrier(0);
            }
    }
    __device__ __forceinline__ void operator()(const f32x4 (&acc)[2][2][4][2], const Unit& u, int wr, int wc, int fr, int fq) const {
        const int row0 = u.pm * 256 + wr * 64 + fr; const int colt = u.pn * 256 + wc * 32 + 8 * fq;
        if (GI_ == 1) body_a(acc, row0, u.pn * 256 + wc * 64 + 8 * fq);
        else body<GI_>(acc, row0, colt);
    }
};
struct EpiRes {
    static constexpr bool PERM = true;
    const h16* X; h16* PRE;
    __device__ __forceinline__ void operator()(const f32x4 (&acc)[2][2][4][2], const Unit& u, int wr, int wc, int fr, int fq) const {
        EPI_ROWS_PERM
#pragma unroll
        for (int ai = 0; ai < 2; ++ai)
#pragma unroll
            for (int m = 0; m < 4; ++m) { const size_t off = (size_t)(row0 + ai * 128 + m * 16) * DM + colt;
#pragma unroll
                for (int bj = 0; bj < 2; ++bj) {
                    const h16x8 x = *(const h16x8*)(X + off + bj * 128);
                    f32x4 o0, o1;
#pragma unroll
                    for (int e = 0; e < 4; ++e) { o0[e] = (float)x[e] * ALPHA + acc[ai][bj][m][0][e]; o1[e] = (float)x[4 + e] * ALPHA + acc[ai][bj][m][1][e]; }
                    *(u32x4*)(PRE + off + bj * 128) = pack8(o0, o1); } }
    }
};
__device__ __forceinline__ float gelu_mul(float u, float gc) {
    const float t = gc * gc;
    const float z = gc * (t * (0.044715f * 1.5957691216057308f * LOG2E) + 1.5957691216057308f * LOG2E);
    return u * gc * __builtin_amdgcn_rcpf(1.0f + __builtin_amdgcn_exp2f(-z));
}
struct EpiUpConv {
    static constexpr bool PERM = true;
    h16* ACT; h16* SIDE; const float* cw; const float* cb;
    __device__ __forceinline__ void operator()(const f32x4 (&acc)[2][2][4][2], const Unit& u, int wr, int wc, int fr, int fq) const {
        const int row0 = u.pm * 256 + wr * 64 + fr, f0 = u.pn * 128 + wc * 32 + 8 * fq;
        f32x4 w0[2], w1[2], w2[2], bb[2];
#pragma unroll
        for (int n = 0; n < 2; ++n) { w0[n] = *(const f32x4*)(cw + f0 + 4 * n); w1[n] = *(const f32x4*)(cw + FF + f0 + 4 * n); w2[n] = *(const f32x4*)(cw + 2 * FF + f0 + 4 * n); bb[n] = *(const f32x4*)(cb + f0 + 4 * n); }
#pragma unroll
        for (int ai = 0; ai < 2; ++ai) {
            f32x4 p1[2], p2[2];
#pragma unroll
            for (int n = 0; n < 2; ++n) { p1[n] = (f32x4){0.f, 0.f, 0.f, 0.f}; p2[n] = p1[n]; }
#pragma unroll
            for (int m = 0; m < 4; ++m) {
                const int row = row0 + ai * 128 + m * 16;
                f32x4 r1[2], r2[2], o[2];
#pragma unroll
                for (int n = 0; n < 2; ++n)
#pragma unroll
                    for (int e = 0; e < 4; ++e) {
                        const float g = acc[ai][1][m][n][e];
                        r1[n][e] = dpp_f<0x121>(g); r2[n][e] = dpp_f<0x122>(g);
                        const float g1 = fr >= 1 ? r1[n][e] : p1[n][e], g2 = fr >= 2 ? r2[n][e] : p2[n][e];
                        const float gc = bb[n][e] + g2 * w0[n][e] + g1 * w1[n][e] + g * w2[n][e];
                        o[n][e] = gelu_mul(acc[ai][0][m][n][e], gc);
                    }
                if (m > 0 || fr >= 2) *(u32x4*)(ACT + (size_t)row * FF + f0) = pack8(o[0], o[1]);
                if (m == 0 && fr < 2) { h16* sp = SIDE + ((size_t)(row >> 6) * 4 + 2 + fr) * (2 * FF) + f0;
                    *(u32x4*)sp = pack8(acc[ai][0][m][0], acc[ai][0][m][1]); *(u32x4*)(sp + FF) = pack8(acc[ai][1][m][0], acc[ai][1][m][1]); }
                if (m == 3 && fr >= 14) { h16* sp = SIDE + ((size_t)(row >> 6) * 4 + (fr - 14)) * (2 * FF) + FF + f0;
                    *(u32x4*)sp = pack8(acc[ai][1][m][0], acc[ai][1][m][1]); }
#pragma unroll
                for (int n = 0; n < 2; ++n) { p1[n] = r1[n]; p2[n] = r2[n]; }
            }
        }
    }
};
__device__ __forceinline__ void convfix_phase(const h16* SIDE, h16* ACT, const float* cw, const float* cb) {
    constexpr int NCG = FF / 8, NT = 256 * 2 * NCG;
    for (int task = obid() * 512 + otid(); task < NT; task += gridDim.x * 512) {
        const int cgi = task % NCG, j = (task / NCG) & 1, gidx = task / (2 * NCG), f = cgi * 8;
        const bool first = (gidx & 127) == 0;
        const h16* cur = SIDE + ((size_t)gidx * 4 + 2 + j) * (2 * FF) + f;
        const h16x8 uh = *(const h16x8*)cur, g0h = *(const h16x8*)(cur + FF);
        h16x8 g1h = {}, g2h = {};
        if (j == 0) { if (!first) { g1h = *(const h16x8*)(SIDE + ((size_t)(gidx - 1) * 4 + 1) * (2 * FF) + FF + f); g2h = *(const h16x8*)(SIDE + ((size_t)(gidx - 1) * 4 + 0) * (2 * FF) + FF + f); } }
        else { g1h = *(const h16x8*)(SIDE + ((size_t)gidx * 4 + 2) * (2 * FF) + FF + f); if (!first) g2h = *(const h16x8*)(SIDE + ((size_t)(gidx - 1) * 4 + 1) * (2 * FF) + FF + f); }
        h16x8 o;
#pragma unroll
        for (int e = 0; e < 8; ++e) {
            const float gc = cb[f + e] + (float)g2h[e] * cw[f + e] + (float)g1h[e] * cw[FF + f + e] + (float)g0h[e] * cw[2 * FF + f + e];
            o[e] = (h16)gelu_mul((float)uh[e], gc);
        }
        *(h16x8*)(ACT + ((size_t)gidx * 64 + j) * FF + f) = o;
    }
}
struct EpiQKV {
    static constexpr bool PERM = true;
    h16* Qb; h16* Kb; h16* Vt;
    __device__ __forceinline__ void operator()(const f32x4 (&acc)[2][2][4][2], const Unit& u, int wr, int wc, int fr, int fq) const {
        const int row0 = u.pm * 256 + wr * 64 + fr; const int part = u.pn >> 3; const int colt = (u.pn & 7) * 256 + wc * 32 + 8 * fq;
#pragma unroll
        for (int ai = 0; ai < 2; ++ai)
#pragma unroll
            for (int m = 0; m < 4; ++m) { const int row = row0 + ai * 128 + m * 16;
#pragma unroll
                for (int bj = 0; bj < 2; ++bj) { const int c = colt + bj * 128;
                    if (part == 0) *(u32x4*)(Qb + (size_t)row * DM + c) = pack8(acc[ai][bj][m][0] * QSCALE, acc[ai][bj][m][1] * QSCALE);
                    else if (part == 1) *(u32x4*)(Kb + (size_t)row * DM + c) = pack8(acc[ai][bj][m][0], acc[ai][bj][m][1]);
                    else {
                        const int b = row >> 13, t = row & 8191, hd = c >> 8, dv = c & 255;
                        const int pos = (t & ~12) | ((t & 4) << 1) | ((t & 8) >> 1);
                        h16* vp = Vt + ((size_t)((b * 8 + hd) * 256 + dv)) * SEQ + pos;
#pragma unroll
                        for (int j = 0; j < 4; ++j) { vp[(size_t)j * SEQ] = (h16)acc[ai][bj][m][0][j]; vp[(size_t)(4 + j) * SEQ] = (h16)acc[ai][bj][m][1][j]; }
                    } } }
    }
};

__device__ __forceinline__ void cvt_job(LAS unsigned char* lds, const float* src, int Ks, int Ns, h16* dst, int Kd, int Nd, int remap = 0) {
    LAS h16* tile = (LAS h16*)lds;
    const int tid = otid(), tk = Kd >> 6, tn = Nd >> 6;
    for (int t = obid(); t < tk * tn; t += gridDim.x) {
        const int k0 = (t % tk) * 64, n0 = (t / tk) * 64;
#pragma unroll
        for (int i = 0; i < 2; ++i) {
            const int idx = tid + 512 * i, kr = idx >> 4, nc = (idx & 15) * 4, k = k0 + kr, n = n0 + nc;
            f32x4 v = (f32x4){0.f, 0.f, 0.f, 0.f};
            if (k < Ks && n < Ns) v = *(const f32x4*)(src + (size_t)k * Ns + n);
            tile[kr * 66 + nc + 0] = (h16)v[0]; tile[kr * 66 + nc + 1] = (h16)v[1]; tile[kr * 66 + nc + 2] = (h16)v[2]; tile[kr * 66 + nc + 3] = (h16)v[3];
        }
        __syncthreads();
        { const int n = tid >> 3, kg = tid & 7; h16x8 o;
#pragma unroll
          for (int e = 0; e < 8; ++e) o[e] = tile[(kg * 8 + e) * 66 + n];
          const int no = n0 + n;
          const int nd = remap == 0 ? no : (remap == 1 ? (no < FF ? (no >> 7) * 256 + (no & 127) : ((no - FF) >> 7) * 256 + 128 + ((no - FF) & 127))
                                                      : ((no & ~255) | ((no & 32) << 2) | ((no & 192) >> 1) | (no & 31)));
          *(h16x8*)(dst + (size_t)nd * Kd + k0 + kg * 8) = o; }
        __syncthreads();
    }
}
__device__ __forceinline__ void cvt_layer(LAS unsigned char* lds, const Params& p, int layer) {
    const bool ffn_here = (layer & 1) != 0;
    h16* W = (h16*)(p.ws + ((layer & 1) ? WS_X : WS_W16));
    const int j = layer >> 1;
    if ((layer & 1) == 0) {
        h16* B1 = (h16*)((char*)W + W_B1); h16* B2 = (h16*)((char*)W + W_B2);
        for (int i = 0; i < 3; ++i) cvt_job(lds, p.in[4] + ((size_t)j * 3 + i) * DM * DM, DM, DM, B1 + (size_t)i * DM * DM, DM, DM);
        cvt_job(lds, p.in[6] + (size_t)j * DM * 96, DM, 96, B1 + (size_t)6144 * DM, DM, 256);
        cvt_job(lds, p.in[9] + (size_t)j * DM * 96, DM, 96, B1 + (size_t)6400 * DM, DM, 256);
        cvt_job(lds, p.in[14] + (size_t)j * DM * 128, DM, 128, B1 + (size_t)6656 * DM, DM, 256);
        cvt_job(lds, p.in[7] + (size_t)j * 96 * DM, 96, DM, B2, 256, DM);
        cvt_job(lds, p.in[10] + (size_t)j * 96 * DM, 96, DM, B2 + (size_t)2048 * 256, 256, DM, 2);
        cvt_job(lds, p.in[15] + (size_t)j * 128 * DM, 128, DM, B2 + (size_t)4096 * 256, 256, DM);
        if (j > 0) {
            cvt_job(lds, p.in[12] + (size_t)(j - 1) * DM * 64, DM, 64, B1 + (size_t)6912 * DM, DM, 256);
            cvt_job(lds, p.in[13] + (size_t)(j - 1) * 64 * DM, 64, DM, B2 + (size_t)6144 * 256, 256, DM);
        }
        cvt_job(lds, p.in[21] + (size_t)j * DM * DM, DM, DM, (h16*)((char*)W + W_WO), DM, DM);
    } else {
        cvt_job(lds, p.in[22] + (size_t)j * DM * 6144, DM, 6144, (h16*)((char*)W + W_B1), DM, 6144);
        cvt_job(lds, p.in[25] + (size_t)j * DM * DM, DM, DM, (h16*)((char*)W + W_WO), DM, DM);
    }
    if (ffn_here) {
        cvt_job(lds, p.in[27] + (size_t)layer * DM * 2 * FF, DM, 2 * FF, (h16*)((char*)W + W_UP), DM, 2 * FF, 1);
        cvt_job(lds, p.in[30] + (size_t)layer * FF * DM, FF, DM, (h16*)((char*)W + W_DN), FF, DM);
    }
}

template <bool LN>
__device__ __forceinline__ void ln_row(const void* src, size_t row, int lane, const float* g, const float* bt, f32x4 (&v)[8]) {
    if (LN) {
        const h16x4* sp = (const h16x4*)((const h16*)src + row * DM);
#pragma unroll
        for (int i = 0; i < 8; ++i) { const h16x4 t = sp[i * 64 + lane]; v[i] = (f32x4){(float)t[0], (float)t[1], (float)t[2], (float)t[3]}; }
        float s = 0.f;
#pragma unroll
        for (int i = 0; i < 8; ++i) s += (v[i][0] + v[i][1]) + (v[i][2] + v[i][3]);
        const float mean = wave_sum(s) * (1.0f / DM);
        float q = 0.f;
#pragma unroll
        for (int i = 0; i < 8; ++i) { v[i] = v[i] - mean; q += (v[i][0] * v[i][0] + v[i][1] * v[i][1]) + (v[i][2] * v[i][2] + v[i][3] * v[i][3]); }
        const float rstd = rsqrtf(wave_sum(q) * (1.0f / DM) + 1e-5f);
#pragma unroll
        for (int i = 0; i < 8; ++i) { const f32x4 gg = ((const f32x4*)g)[i * 64 + lane], bb = ((const f32x4*)bt)[i * 64 + lane]; v[i] = v[i] * rstd * gg + bb; }
    } else {
        const f32x4* sp = (const f32x4*)((const float*)src + row * DM);
#pragma unroll
        for (int i = 0; i < 8; ++i) v[i] = sp[i * 64 + lane];
    }
}
__device__ __forceinline__ void ln_load16(const void* src, size_t row, int lane, h16x4 (&t)[8]) {
    const h16x4* sp = (const h16x4*)((const h16*)src + row * DM);
#pragma unroll
    for (int i = 0; i < 8; ++i) t[i] = sp[i * 64 + lane];
}
__device__ __forceinline__ void ln_apply16(const h16x4 (&t)[8], int lane, const float* g, const float* bt, f32x4 (&v)[8]) {
#pragma unroll
    for (int i = 0; i < 8; ++i) v[i] = (f32x4){(float)t[i][0], (float)t[i][1], (float)t[i][2], (float)t[i][3]};
    float s = 0.f;
#pragma unroll
    for (int i = 0; i < 8; ++i) s += (v[i][0] + v[i][1]) + (v[i][2] + v[i][3]);
    const float mean = wave_sum(s) * (1.0f / DM);
    float q = 0.f;
#pragma unroll
    for (int i = 0; i < 8; ++i) { v[i] = v[i] - mean; q += (v[i][0] * v[i][0] + v[i][1] * v[i][1]) + (v[i][2] * v[i][2] + v[i][3] * v[i][3]); }
    const float rstd = rsqrtf(wave_sum(q) * (1.0f / DM) + 1e-5f);
#pragma unroll
    for (int i = 0; i < 8; ++i) { const f32x4 gg = ((const f32x4*)g)[i * 64 + lane], bb = ((const f32x4*)bt)[i * 64 + lane]; v[i] = v[i] * rstd * gg + bb; }
}
template <bool LN>
__device__ __forceinline__ void ln_phase(const void* src, const float* g, const float* bt, float* xout, h16* xh, const float* mu, h16* mix) {
    const int lane = otid() & 63, gw = obid() * 8 + (otid() >> 6), GW = gridDim.x * 8;
    for (int ch = gw; ch < MTOK / 8; ch += GW) {
        const size_t t0 = (size_t)ch * 8;
        f32x4 prev[8], cur[8];
        if (mix) {
            if ((t0 & (SEQ - 1)) == 0) {
#pragma unroll
                for (int i = 0; i < 8; ++i) prev[i] = (f32x4){0.f, 0.f, 0.f, 0.f};
            } else ln_row<LN>(src, t0 - 1, lane, g, bt, prev);
        }
        h16x4 raw[8], rawn[8];
        if (LN) ln_load16(src, t0, lane, raw);
#pragma unroll 1
        for (int r = 0; r < 8; ++r) {
            const size_t row = t0 + r;
            asm volatile("" ::: "memory");
            if (LN) {
                ln_load16(src, t0 + (r < 7 ? r + 1 : 7), lane, rawn);
                ln_apply16(raw, lane, g, bt, cur);
#pragma unroll
                for (int i = 0; i < 8; ++i) raw[i] = rawn[i];
            } else ln_row<LN>(src, row, lane, g, bt, cur);
            if (xout) {
#pragma unroll
                for (int i = 0; i < 8; ++i) ((f32x4*)(xout + row * DM))[i * 64 + lane] = cur[i];
            }
            if (xh) {
#pragma unroll
                for (int i = 0; i < 8; ++i) { h16x4 o = {(h16)cur[i][0], (h16)cur[i][1], (h16)cur[i][2], (h16)cur[i][3]}; ((h16x4*)(xh + row * DM))[i * 64 + lane] = o; }
            }
            if (mix) {
#pragma unroll
                for (int i = 0; i < 8; ++i) {
                    asm volatile("" ::: "memory");
                    const f32x4 xx = prev[i] - cur[i];
#pragma unroll
                    for (int k = 0; k < 6; ++k) {
                        const f32x4 m4 = ((const f32x4*)(mu + (size_t)k * DM))[i * 64 + lane];
                        const f32x4 o4 = cur[i] + xx * m4;
                        h16x4 o = {(h16)o4[0], (h16)o4[1], (h16)o4[2], (h16)o4[3]};
                        ((h16x4*)(mix + ((size_t)k * MTOK + row) * DM))[i * 64 + lane] = o;
                    }
                    prev[i] = cur[i];
                }
            }
        }
    }
}

__device__ __forceinline__ void prep_phase(h16* C1, h16* Ab, h16* AA, h16* VF, const float* k_k, const float* k_a, bool first) {
    const int lane = otid() & 63, gw = obid() * 8 + (otid() >> 6), GW = gridDim.x * 8;
    for (int row = gw; row < MTOK; row += GW) {
#pragma unroll
        for (int i = 0; i < 8; ++i) {
            const int c = i * 256 + lane * 4;
            h16x4* kp = (h16x4*)(C1 + (size_t)row * LDC1 + 2048 + c);
            h16x4* ap = (h16x4*)(Ab + (size_t)row * DM + c);
            const h16x4 kh = *kp, ah = *ap;
            const f32x4 kkw = *(const f32x4*)(k_k + c), kaw = *(const f32x4*)(k_a + c);
            f32x4 k, a, kk;
#pragma unroll
            for (int e = 0; e < 4; ++e) { k[e] = (float)kh[e]; a[e] = (float)ah[e]; kk[e] = k[e] * kkw[e]; }
            float ss = (kk[0] * kk[0] + kk[1] * kk[1]) + (kk[2] * kk[2] + kk[3] * kk[3]);
            ss = grp16_sum(ss);
            const float inv = 1.0f / fmaxf(sqrtf(ss), 1e-12f);
            h16x4 ko, aao, bbo;
#pragma unroll
            for (int e = 0; e < 4; ++e) { const float kn = kk[e] * inv; ko[e] = (h16)(k[e] * (1.0f + (a[e] - 1.0f) * kaw[e])); aao[e] = (h16)(-kn); bbo[e] = (h16)(kn * a[e]); }
            *kp = ko; *ap = bbo; *(h16x4*)(AA + (size_t)row * DM + c) = aao;
            if (first) *(h16x4*)(VF + (size_t)row * DM + c) = *(const h16x4*)(C1 + (size_t)row * LDC1 + 4096 + c);
        }
    }
}

__device__ __forceinline__ void scan_phase(LAS unsigned char* lds, const h16* C1, const h16* DEC, const h16* AA, const h16* BB, float* Y,
                                           const float* sQKV, const float* sWO, const float* sUP, const float* sDN, char* Wn, const float* sUP0, const float* sDN0, char* Wc) {
    constexpr int CH = 32, NCH = SEQ / CH, BUF = 18976;
    LAS float* L = (LAS float*)lds;
    const int tid = otid(), wid = tid >> 6, lane = tid & 63;
    for (int item = obid(); item < 256; item += gridDim.x) {
        const int b = item >> 7, h = (item >> 2) & 31, q = item & 3;
        const size_t row0 = (size_t)b * SEQ;
        __syncthreads();
        if (wid >= 4) {
            const int lt = tid - 256, s = lt >> 3, e8 = lt & 7;
            struct StReg { h16x8 r8, k8, a8, b8, v8, d8; };
            auto gload = [&](int c) -> StReg {
                StReg R;
                const size_t row = row0 + (size_t)c * CH + s;
                R.r8 = *(const h16x8*)(C1 + row * LDC1 + h * 64 + e8 * 8);
                R.k8 = *(const h16x8*)(C1 + row * LDC1 + 2048 + h * 64 + e8 * 8);
                { const int tn = c * CH + s + 1; const size_t rown = row0 + (size_t)(tn < SEQ ? tn : SEQ - 1);
                  R.a8 = *(const h16x8*)(AA + rown * DM + h * 64 + e8 * 8); }
                R.b8 = *(const h16x8*)(BB + row * DM + h * 64 + e8 * 8);
                R.d8 = *(const h16x8*)(DEC + row * DM + h * 64 + e8 * 8);
                R.v8 = (h16x8){};
                if (lt < 64) R.v8 = *(const h16x8*)(C1 + (row0 + (size_t)c * CH + (lt >> 1)) * LDC1 + 4096 + h * 64 + q * 16 + (lt & 1) * 8);
                return R;
            };
            auto lwrite = [&](const StReg& R, int bufi) {
                LAS float* Bf = L + bufi * BUF;
                LAS float* dst = Bf + s * 64 + e8 * 8;
                *(LAS f32x4*)(dst + 0 * 2048) = (f32x4){(float)R.r8[0], (float)R.r8[1], (float)R.r8[2], (float)R.r8[3]}; *(LAS f32x4*)(dst + 0 * 2048 + 4) = (f32x4){(float)R.r8[4], (float)R.r8[5], (float)R.r8[6], (float)R.r8[7]};
                *(LAS f32x4*)(dst + 1 * 2048) = (f32x4){__expf(-(float)R.d8[0]), __expf(-(float)R.d8[1]), __expf(-(float)R.d8[2]), __expf(-(float)R.d8[3])};
                *(LAS f32x4*)(dst + 1 * 2048 + 4) = (f32x4){__expf(-(float)R.d8[4]), __expf(-(float)R.d8[5]), __expf(-(float)R.d8[6]), __expf(-(float)R.d8[7])};
                *(LAS f32x4*)(dst + 2 * 2048) = (f32x4){(float)R.k8[0], (float)R.k8[1], (float)R.k8[2], (float)R.k8[3]}; *(LAS f32x4*)(dst + 2 * 2048 + 4) = (f32x4){(float)R.k8[4], (float)R.k8[5], (float)R.k8[6], (float)R.k8[7]};
                *(LAS f32x4*)(dst + 3 * 2048) = (f32x4){(float)R.a8[0], (float)R.a8[1], (float)R.a8[2], (float)R.a8[3]}; *(LAS f32x4*)(dst + 3 * 2048 + 4) = (f32x4){(float)R.a8[4], (float)R.a8[5], (float)R.a8[6], (float)R.a8[7]};
                *(LAS f32x4*)(dst + 4 * 2048) = (f32x4){(float)R.b8[0], (float)R.b8[1], (float)R.b8[2], (float)R.b8[3]}; *(LAS f32x4*)(dst + 4 * 2048 + 4) = (f32x4){(float)R.b8[4], (float)R.b8[5], (float)R.b8[6], (float)R.b8[7]};
                { float cp = 0.f;
#pragma unroll
                  for (int e = 0; e < 8; ++e) cp += (float)R.b8[e] * (float)R.a8[e];
                  cp += __shfl_xor(cp, 1); cp += __shfl_xor(cp, 2); cp += __shfl_xor(cp, 4);
                  if (e8 == 0) Bf[18944 + s] = cp; }
                if (lt < 64) { LAS float* vd = Bf + 10240 + (lt >> 1) * 16 + (lt & 1) * 8;
                    *(LAS f32x4*)vd = (f32x4){(float)R.v8[0], (float)R.v8[1], (float)R.v8[2], (float)R.v8[3]}; *(LAS f32x4*)(vd + 4) = (f32x4){(float)R.v8[4], (float)R.v8[5], (float)R.v8[6], (float)R.v8[7]}; }
            };
            auto yout = [&](int c, int bufi) {
#pragma unroll
                for (int o2 = 0; o2 < 2; ++o2) {
                    const int o = lt + 256 * o2, ys = o >> 4, yr = o & 15;
                    LAS float* yp = L + bufi * BUF + 10752 + o * 16;
                    f32x4 acc4 = *(LAS f32x4*)(yp + (((0 + (o >> 2)) & 3) << 2));
#pragma unroll
                    for (int i = 1; i < 4; ++i) acc4 += *(LAS f32x4*)(yp + (((i + (o >> 2)) & 3) << 2));
                    Y[(row0 + (size_t)c * CH + ys) * DM + h * 64 + q * 16 + yr] = (acc4[0] + acc4[1]) + (acc4[2] + acc4[3]);
                }
            };
            const int lw = (lt >> 6), wgl = item * 4 + lw;
            LAS h16* ctile = (LAS h16*)(lds + 2 * BUF * 4) + lw * 512;
            f32x4 cv0 = (f32x4){0.f, 0.f, 0.f, 0.f}, cv1 = cv0; h16* cdst = nullptr;
            auto cvt_issue = [&](int tix) {
                constexpr int T0 = 128 * 192, T1 = 128 * 64, T2 = 128 * 344, T3 = 344 * 64;
                cdst = nullptr;
                if (tix >= T0 + T1 + 2 * (T2 + T3)) return;
                const float* src; h16* dst; int Ks, Ns, rm = 0, t = tix;
                if (t >= T0 + T1 + T2 + T3) {
                    t -= T0 + T1 + T2 + T3;
                    if (t < T2) { src = sUP0; dst = (h16*)(Wc + W_UP); Ks = DM; Ns = 2 * FF; rm = 1; }
                    else { t -= T2; src = sDN0; dst = (h16*)(Wc + W_DN); Ks = FF; Ns = DM; }
                }
                else if (t < T0) { src = sQKV; dst = (h16*)(Wn + W_B1); Ks = DM; Ns = 6144; }
                else if (t < T0 + T1) { t -= T0; src = sWO; dst = (h16*)(Wn + W_WO); Ks = DM; Ns = DM; }
                else if (t < T0 + T1 + T2) { t -= T0 + T1; src = sUP; dst = (h16*)(Wn + W_UP); Ks = DM; Ns = 2 * FF; rm = 1; }
                else { t -= T0 + T1 + T2; src = sDN; dst = (h16*)(Wn + W_DN); Ks = FF; Ns = DM; }
                const int tk = Ks >> 4, k0 = (t % tk) * 16, n0 = (t / tk) * 32;
                const int ln = lt & 63, kr = ln >> 3, nc = (ln & 7) * 4;
                cv0 = *(const f32x4*)(src + (size_t)(k0 + kr) * Ns + n0 + nc); cv1 = *(const f32x4*)(src + (size_t)(k0 + kr + 8) * Ns + n0 + nc);
                const int n = ln & 31, hf = ln >> 5, no = n0 + n;
                const int nd = rm == 0 ? no : (no < FF ? (no >> 7) * 256 + (no & 127) : ((no - FF) >> 7) * 256 + 128 + ((no - FF) & 127));
                cdst = dst + (size_t)nd * Ks + k0 + hf * 8;
            };
            auto cvt_finish = [&]() {
                if (cdst == nullptr) return;
                const int ln = lt & 63, kr = ln >> 3, nc = (ln & 7) * 4;
#pragma unroll
                for (int e = 0; e < 4; ++e) { ctile[(nc + e) * 16 + kr] = (h16)cv0[e]; ctile[(nc + e) * 16 + kr + 8] = (h16)cv1[e]; }
                asm volatile("s_waitcnt lgkmcnt(0)" ::: "memory");
                const h16x8 o = *(LAS h16x8*)(ctile + (ln & 31) * 16 + (ln >> 5) * 8);
                *(h16x8*)cdst = o;
                asm volatile("s_waitcnt lgkmcnt(0)" ::: "memory");
            };
            { const StReg R0 = gload(0); lwrite(R0, 0); }
            StReg RA = gload(1);
            __syncthreads();
            for (int c = 0; c < NCH; ++c) {
                StReg RB = RA;
                if (c + 2 < NCH) RB = gload(c + 2);
                if (c + 1 < NCH) lwrite(RA, (c + 1) & 1);
                if (c > 0) yout(c - 1, (c - 1) & 1);
                if (Wn) { cvt_finish(); cvt_issue(wgl + 1024 * c); }
                asm volatile("s_waitcnt lgkmcnt(0)" ::: "memory");
                __builtin_amdgcn_s_barrier();
                asm volatile("" ::: "memory");
                RA = RB;
            }
            yout(NCH - 1, (NCH - 1) & 1);
            if (Wn) cvt_finish();
        } else {
            const int jg = lane & 15, rl = wid * 4 + (lane >> 4);
            f32x2 Sa = (f32x2){0.f, 0.f}, Sb = (f32x2){0.f, 0.f};
            float sa = 0.f;
            __syncthreads();
            for (int c = 0; c < NCH; ++c) {
                LAS float* Bf = L + (c & 1) * BUF;
                LAS float* vec = Bf + jg * 4;
                f32x4 r4 = *(LAS f32x4*)(vec + 0 * 2048), w4 = *(LAS f32x4*)(vec + 1 * 2048), k4 = *(LAS f32x4*)(vec + 2 * 2048), a4 = *(LAS f32x4*)(vec + 3 * 2048), b4 = *(LAS f32x4*)(vec + 4 * 2048);
                float v = Bf[10240 + rl], cn = Bf[18944];
#pragma unroll 1
                for (int s0 = 0; s0 < CH; s0 += 8) {
                    float yv[8];
#pragma unroll
                    for (int u = 0; u < 8; ++u) {
                        const int s = s0 + u, sn = (s + 1 < CH) ? s + 1 : CH - 1;
                        const f32x4 r4n = *(LAS f32x4*)(vec + 0 * 2048 + sn * 64), w4n = *(LAS f32x4*)(vec + 1 * 2048 + sn * 64), k4n = *(LAS f32x4*)(vec + 2 * 2048 + sn * 64),
                                    a4n = *(LAS f32x4*)(vec + 3 * 2048 + sn * 64), b4n = *(LAS f32x4*)(vec + 4 * 2048 + sn * 64);
                        const float vn = Bf[10240 + sn * 16 + rl], cnn = Bf[18944 + sn];
                        const f32x2 aL = {a4[0], a4[1]}, aH = {a4[2], a4[3]}, wL = {w4[0], w4[1]}, wH = {w4[2], w4[3]}, kL = {k4[0], k4[1]}, kH = {k4[2], k4[3]},
                                    bL = {b4[0], b4[1]}, bH = {b4[2], b4[3]}, rL = {r4[0], r4[1]}, rH = {r4[2], r4[3]};
                        const f32x2 uL = Sa * wL + kL * v, uH = Sb * wH + kH * v;
                        const f32x2 dz = uL * aL + uH * aH;
                        const float z = row16_sum(dz[0] + dz[1]);
                        Sa = bL * sa + uL; Sb = bH * sa + uH;
                        const f32x2 dr = Sa * rL + Sb * rH;
                        yv[u] = dr[0] + dr[1];
                        sa = z + cn * sa;
                        r4 = r4n; w4 = w4n; k4 = k4n; a4 = a4n; b4 = b4n; v = vn; cn = cnn;
                    }
#pragma unroll
                    for (int u = 0; u < 8; ++u) Bf[10752 + ((s0 + u) * 16 + rl) * 16 + jg] = yv[u];
                }
                __syncthreads();
            }
        }
    }
}

__device__ __forceinline__ void gn_phase(const float* Y, const h16* C1, const h16* Gb, h16* YG, const float* r_k, const float* lnx_g, const float* lnx_b, h16* VFw) {
    const int lane = otid() & 63, gw = obid() * 8 + (otid() >> 6), GW = gridDim.x * 8;
    for (int row = gw; row < MTOK; row += GW) {
#pragma unroll
        for (int i = 0; i < 8; ++i) {
            const int c = i * 256 + lane * 4;
            const f32x4 y = *(const f32x4*)(Y + (size_t)row * DM + c);
            const h16x4 rh = *(const h16x4*)(C1 + (size_t)row * LDC1 + c), kh = *(const h16x4*)(C1 + (size_t)row * LDC1 + 2048 + c), vh = *(const h16x4*)(C1 + (size_t)row * LDC1 + 4096 + c);
            const h16x4 gh = *(const h16x4*)(Gb + (size_t)row * DM + c);
            const f32x4 rk = *(const f32x4*)(r_k + c), lg = *(const f32x4*)(lnx_g + c), lb = *(const f32x4*)(lnx_b + c);
            float s = (y[0] + y[1]) + (y[2] + y[3]);
            const float mean = grp16_sum(s) * (1.0f / 64.0f);
            const f32x4 d = y - mean;
            float qv = (d[0] * d[0] + d[1] * d[1]) + (d[2] * d[2] + d[3] * d[3]);
            const float rstd = rsqrtf(grp16_sum(qv) * (1.0f / 64.0f) + 64e-5f);
            float bs = 0.f;
#pragma unroll
            for (int e = 0; e < 4; ++e) bs += (float)rh[e] * (float)kh[e] * rk[e];
            bs = grp16_sum(bs);
            h16x4 o;
#pragma unroll
            for (int e = 0; e < 4; ++e) o[e] = (h16)((d[e] * rstd * lg[e] + lb[e] + bs * (float)vh[e]) * (float)gh[e]);
            *(h16x4*)(YG + (size_t)row * DM + c) = o;
            if (VFw) *(h16x4*)(VFw + (size_t)row * DM + c) = vh;
        }
    }
}

__device__ __forceinline__ void convglu_phase(const h16* U, h16* ACT, const float* cw, const float* cb) {
    constexpr int NCG = FF / 8, RC = 16, NT = (MTOK / RC) * NCG;
    for (int task = obid() * 512 + otid(); task < NT; task += gridDim.x * 512) {
        const int cgi = task % NCG, rc = task / NCG, f = cgi * 8, m0 = rc * RC;
        float w0[8], w1[8], w2[8], bb[8], g1[8], g2[8];
#pragma unroll
        for (int e = 0; e < 8; ++e) { w0[e] = cw[f + e]; w1[e] = cw[FF + f + e]; w2[e] = cw[2 * FF + f + e]; bb[e] = cb[f + e]; g1[e] = 0.f; g2[e] = 0.f; }
        if ((m0 & (SEQ - 1)) != 0) {
            const h16x8 a = *(const h16x8*)(U + (size_t)(m0 - 1) * (2 * FF) + FF + f), c2 = *(const h16x8*)(U + (size_t)(m0 - 2) * (2 * FF) + FF + f);
#pragma unroll
            for (int e = 0; e < 8; ++e) { g1[e] = (float)a[e]; g2[e] = (float)c2[e]; }
        }
        for (int r = 0; r < RC; ++r) {
            const size_t m = (size_t)(m0 + r);
            const h16x8 uh = *(const h16x8*)(U + m * (2 * FF) + f), gh = *(const h16x8*)(U + m * (2 * FF) + FF + f);
            h16x8 o;
#pragma unroll
            for (int e = 0; e < 8; ++e) {
                const float g0 = (float)gh[e];
                const float gc = bb[e] + g2[e] * w0[e] + g1[e] * w1[e] + g0 * w2[e];
                const float z = 1.5957691216057308f * (gc + 0.044715f * gc * gc * gc);
                const float ge = gc / (1.0f + __expf(-z));
                o[e] = (h16)((float)uh[e] * ge);
                g2[e] = g1[e]; g1[e] = g0;
            }
            *(h16x8*)(ACT + m * FF + f) = o;
        }
    }
}

__device__ __forceinline__ void attn_phase(LAS unsigned char* lds, const h16* Qb, const h16* Kb, const h16* Vt, h16* AO, const float* rel_bias, const float* lam, const float* subg, float lambda_init) {
    constexpr int STG = 65536;
    const int wid = __builtin_amdgcn_readfirstlane(otid() >> 6), rg = wid & 3, mp = wid >> 2;
    LAS float* lut = (LAS float*)(lds + 2 * STG);
    LAS float* osh = (LAS float*)lds;
    for (int vc = obid(); vc < 256; vc += gridDim.x) {
        const int bh = vc & 15, jj = vc >> 4, b = bh >> 3, h = bh & 7;
        for (int it = 0; it < 4; ++it) {
            const int qb = it == 0 ? 63 - jj : (it == 1 ? 32 + jj : (it == 2 ? 31 - jj : jj));
            __syncthreads();
            const int tid = otid(), lane = tid & 63, l32 = lane & 31, hh = lane >> 5;
            const int kkey = wid * 2 + (lane >> 5);
            const int kseg = (lane & 31) ^ (kkey & 15);
            const int vdv = wid * 8 + (lane >> 3);
            const int vseg = (lane & 7) ^ ((vdv >> 1) & 7);
            const int xk = l32 & 15, yv = (l32 >> 1) & 7;
            if (tid <= 128) {
                const float* rbp_ = rel_bias; asm volatile("" : "+s"(rbp_)); const GAS float* rbp = (const GAS float*)rbp_;
                float val = 0.f;
                if (tid < 128) { int bk = tid; if (tid >= 16) { bk = 16 + (int)(__logf((float)tid * (1.0f / 16.0f)) / 2.0794415416798357f * 16.0f); bk = bk > 31 ? 31 : bk; }
                    val = (rbp[bk * 8 + h] - rbp[31 * 8 + h]) * LOG2E; }
                lut[tid] = val;
            }
            const int q0 = qb * 128, qrow = q0 + 32 * rg + l32;
            const size_t tokbase = (size_t)b * SEQ;
            h16x8 Qf[8];
            { const h16* qp = Qb + (tokbase + qrow) * DM + h * 256 + mp * 128 + hh * 8;
#pragma unroll
              for (int ks = 0; ks < 8; ++ks) Qf[ks] = *(const h16x8*)(qp + ks * 16); }
            f32x16 O[8];
#pragma unroll
            for (int i = 0; i < 8; ++i)
#pragma unroll
                for (int r = 0; r < 16; ++r) O[i][r] = 0.f;
            float mrun = -1e30f, lrun = 0.f;
            const int nkt = 2 * qb + 2;
            const h16* kg = Kb + (tokbase + kkey) * DM + h * 256 + kseg * 8;
            const h16* vg = Vt + ((size_t)((b * 8 + h) * 256) + vdv) * SEQ + vseg * 8;
#define ATT_ISSUE(KT, BUF) do { _Pragma("unroll") for (int _i = 0; _i < 4; ++_i) \
                __builtin_amdgcn_global_load_lds((const unsigned*)(kg + (size_t)(64 * (KT) + 16 * _i) * DM), (LAS unsigned*)((BUF) + (_i * 8 + wid) * 1024), 16, 0, 0); \
              _Pragma("unroll") for (int _i = 0; _i < 4; ++_i) \
                __builtin_amdgcn_global_load_lds((const unsigned*)(vg + (size_t)(64 * _i) * SEQ + 64 * (KT)), (LAS unsigned*)((BUF) + 32768 + (_i * 8 + wid) * 1024), 16, 0, 0); } while (0)
            ATT_ISSUE(0, lds);
            asm volatile("s_waitcnt vmcnt(0)" ::: "memory");
            __syncthreads();
            for (int kt = 0; kt < nkt; ++kt) {
                LAS unsigned char* cb = lds + (kt & 1) * STG; LAS unsigned char* nb = lds + ((kt & 1) ^ 1) * STG;
                const bool near = kt >= 2 * qb - 2;
                if (kt + 1 < nkt) ATT_ISSUE(kt + 1, nb);
#pragma unroll
                for (int kb = 0; kb < 2; ++kb) {
                    if (64 * kt + 32 * kb <= q0 + 32 * rg + 31) {
                        f32x16 S0;
#pragma unroll
                        for (int r = 0; r < 16; ++r) S0[r] = 0.f;
                        LAS unsigned char* ks = cb + (32 * kb + l32) * 512 + mp * 256;
#pragma unroll
                        for (int k = 0; k < 8; ++k) {
                            const h16x8 a0 = *(LAS h16x8*)(ks + (((2 * k + hh) ^ xk) << 4));
                            S0 = __builtin_amdgcn_mfma_f32_32x32x16_f16(a0, Qf[k], S0, 0, 0, 0);
                        }
                        if (near) {
#pragma unroll
                            for (int r = 0; r < 16; ++r) {
                                const int kp = 64 * kt + 32 * kb + (r >> 2) * 8 + hh * 4 + (r & 3); const int d0 = qrow - kp;
                                const int di = d0 < 0 ? 0 : (d0 > 128 ? 128 : d0); const float bv = lut[di];
                                S0[r] = d0 < 0 ? -1e30f : S0[r] + bv;
                            }
                        }
                        float mt = S0[0];
#pragma unroll
                        for (int r = 1; r < 16; ++r) mt = fmaxf(mt, S0[r]);
                        if (__builtin_amdgcn_ballot_w64(mt - mrun > 10.0f) != 0ull) {
                            const float mo = fmaxf(mt, __shfl_xor(mt, 32));
                            const float mn = fmaxf(mrun, mo);
                            const float al = __builtin_amdgcn_exp2f(mrun - mn);
                            mrun = mn; lrun *= al;
#pragma unroll
                            for (int i = 0; i < 8; ++i) O[i] = O[i] * al;
                        }
                        float ps = 0.f;
#pragma unroll
                        for (int r = 0; r < 16; ++r) { S0[r] = __builtin_amdgcn_exp2f(S0[r] - mrun); ps += S0[r]; }
                        lrun += ps;
                        h16x8 P0, P1;
#pragma unroll
                        for (int e = 0; e < 8; ++e) { P0[e] = (h16)S0[e]; P1[e] = (h16)S0[8 + e]; }
                        LAS unsigned char* vs = cb + 32768 + l32 * 128;
                        const int vo0 = ((4 * kb + hh) ^ yv) << 4, vo1 = ((4 * kb + 2 + hh) ^ yv) << 4;
#pragma unroll
                        for (int dvb = 0; dvb < 8; ++dvb) {
                            const h16x8 a = *(LAS h16x8*)(vs + dvb * 4096 + vo0);
                            O[dvb] = __builtin_amdgcn_mfma_f32_32x32x16_f16(a, P0, O[dvb], 0, 0, 0);
                        }
#pragma unroll
                        for (int dvb = 0; dvb < 8; ++dvb) {
                            const h16x8 a = *(LAS h16x8*)(vs + dvb * 4096 + vo1);
                            O[dvb] = __builtin_amdgcn_mfma_f32_32x32x16_f16(a, P1, O[dvb], 0, 0, 0);
                        }
                    }
                }
                asm volatile("s_waitcnt vmcnt(0)" ::: "memory");
                __syncthreads();
            }
#undef ATT_ISSUE
            lrun += __shfl_xor(lrun, 32);
            const float inv = 1.0f / lrun;
            const int lane2 = otid() & 63, l32b = lane2 & 31, hhb = lane2 >> 5;
            const int obase = (rg * 8) * 16 * 64 + lane2;
            if (mp == 1) {
                float lf;
                { const float* lmp_ = lam; asm volatile("" : "+s"(lmp_)); const GAS float* lmp = (const GAS float*)lmp_;
                  float s1 = 0.f, s2 = 0.f; for (int i = lane2; i < 128; i += 64) { s1 += lmp[i] * lmp[128 + i]; s2 += lmp[256 + i] * lmp[384 + i]; }
                  s1 = wave_sum(s1); s2 = wave_sum(s2); lf = __expf(s1) - __expf(s2) + lambda_init; }
                const float sc = inv * lf;
#pragma unroll
                for (int dvb = 0; dvb < 8; ++dvb)
#pragma unroll
                    for (int r = 0; r < 16; ++r) osh[obase + (dvb * 16 + r) * 64] = O[dvb][r] * sc;
            }
            __syncthreads();
            if (mp == 0) {
                const float* sgp_ = subg; asm volatile("" : "+s"(sgp_)); const GAS float* sgp = (const GAS float*)sgp_;
                float ss = 0.f;
#pragma unroll
                for (int dvb = 0; dvb < 8; ++dvb)
#pragma unroll
                    for (int r = 0; r < 16; ++r) { const float o = O[dvb][r] * inv - osh[obase + (dvb * 16 + r) * 64]; O[dvb][r] = o; ss += o * o; }
                ss += __shfl_xor(ss, 32);
                const float rms = rsqrtf(ss * (1.0f / 256.0f) + 1e-5f) * (1.0f - lambda_init);
                h16* op = AO + ((size_t)b * SEQ + q0 + 32 * rg + l32b) * DM + h * 256 + hhb * 4;
#pragma unroll
                for (int dvb = 0; dvb < 8; ++dvb)
#pragma unroll
                    for (int rq = 0; rq < 4; ++rq) {
                        const int dv0 = dvb * 32 + rq * 8;
                        const f32x4 sg = *(const GAS f32x4*)(sgp + dv0 + hhb * 4);
                        h16x4 o = {(h16)(O[dvb][rq * 4 + 0] * rms * sg[0]), (h16)(O[dvb][rq * 4 + 1] * rms * sg[1]), (h16)(O[dvb][rq * 4 + 2] * rms * sg[2]), (h16)(O[dvb][rq * 4 + 3] * rms * sg[3])};
                        *(h16x4*)(op + dv0) = o;
                    }
            }
        }
    }
}

#define XB_TMO      128
#define XB_XCNT(j)  (256  + 64 * (j))
#define XB_XSUB(j)  (1280 + 64 * (j))
#define XB_XGEN(j)  (2304 + 64 * (j))
#define XB_TOP      3328
#define XB_TOPGEN   3392
#define XCD_BAR_WORDS 3456
#define XB_SPIN_CAP (1u << 18)

__device__ __forceinline__ unsigned xb_ld(unsigned* p)              { return __hip_atomic_load(p, __ATOMIC_RELAXED, __HIP_MEMORY_SCOPE_AGENT); }
__device__ __forceinline__ unsigned xb_add(unsigned* p, unsigned v) { return __hip_atomic_fetch_add(p, v, __ATOMIC_RELAXED, __HIP_MEMORY_SCOPE_AGENT); }
__device__ __forceinline__ unsigned xb_xcc_id() { return (unsigned)__builtin_amdgcn_s_getreg((3 << 11) | 20) & 0xFu; }
#define XB_SPIN(cond, bar) do { unsigned _sp = 0; while (cond) { __builtin_amdgcn_s_sleep(1); \
    if ((++_sp & 255u) == 0u) { if (xb_ld(&(bar)[XB_TMO])) break; if (_sp > XB_SPIN_CAP) { atomicAdd(&(bar)[XB_TMO], 1u); break; } } } } while (0)

struct XcdBarrier {
    unsigned* bar; unsigned x;
    volatile LAS unsigned* st;
};

__device__ __forceinline__ XcdBarrier xcd_barrier_post(unsigned* bar, volatile LAS unsigned* st) {
    XcdBarrier b; b.bar = bar; b.x = xb_xcc_id(); b.st = st;
    if (threadIdx.x == 0) (void)xb_add(&bar[XB_XCNT(b.x)], 1u);
    return b;
}
__device__ __forceinline__ void xcd_barrier_complete(unsigned* bar, unsigned x, unsigned& nloc, unsigned& nx) {
    const unsigned G = gridDim.x * gridDim.y * gridDim.z;
    unsigned sum, cnt, mine, sp = 0u;
    for (;;) {
        sum = 0u; cnt = 0u; mine = 0u;
#pragma unroll
        for (unsigned j = 0; j < 16; ++j) { const unsigned c = xb_ld(&bar[XB_XCNT(j)]); sum += c; cnt += (c > 0u) ? 1u : 0u; mine = (j == x) ? c : mine; }
        if (sum == G) break;
        __builtin_amdgcn_s_sleep(1);
        if ((++sp & 255u) == 0u) { if (xb_ld(&bar[XB_TMO])) break; if (sp > XB_SPIN_CAP) { atomicAdd(&bar[XB_TMO], 1u); break; } }
    }
    nloc = mine > 0u ? mine : 1u; nx = cnt > 0u ? cnt : 1u;
}

__device__ __forceinline__ void xcd_barrier(const XcdBarrier& b) {
    asm volatile("s_waitcnt vmcnt(0)" ::: "memory");
    __syncthreads();
    if (threadIdx.x == 0) {
        unsigned* bar = b.bar;
        __builtin_amdgcn_s_waitcnt(0);
        unsigned nloc = b.st[0], nx = b.st[1];
        if (nloc == 0u) { xcd_barrier_complete(bar, b.x, nloc, nx); b.st[0] = nloc; b.st[1] = nx; }
        const unsigned old = xb_add(&bar[XB_XSUB(b.x)], 1u);
        const unsigned gen = old / nloc;
        if (old + 1u == (gen + 1u) * nloc) {
            __builtin_amdgcn_fence(__ATOMIC_RELEASE, "agent");
            asm volatile("s_waitcnt vmcnt(0)" ::: "memory");
            const unsigned og = xb_add(&bar[XB_TOP], 1u);
            const unsigned tg = og / nx;
            if (og + 1u == (tg + 1u) * nx) xb_add(&bar[XB_TOPGEN], 1u);
            else XB_SPIN(xb_ld(&bar[XB_TOPGEN]) == tg, bar);
            __builtin_amdgcn_fence(__ATOMIC_ACQUIRE, "agent");
            xb_add(&bar[XB_XGEN(b.x)], 1u);
            asm volatile("s_waitcnt vmcnt(0)" ::: "memory");
        } else {
            XB_SPIN(xb_ld(&bar[XB_XGEN(b.x)]) == gen, bar);
            __builtin_amdgcn_fence(__ATOMIC_ACQUIRE, "agent");
            asm volatile("s_waitcnt vmcnt(0)" ::: "memory");
        }
    }
    __syncthreads();
}


__device__ __forceinline__ void gbar(unsigned* ctr, unsigned target) {
    asm volatile("s_waitcnt vmcnt(0)" ::: "memory");
    __syncthreads();
    if (threadIdx.x == 0) {
        __builtin_amdgcn_fence(__ATOMIC_RELEASE, "agent");
        asm volatile("s_waitcnt vmcnt(0)" ::: "memory");
        __hip_atomic_fetch_add(ctr, 1u, __ATOMIC_RELAXED, __HIP_MEMORY_SCOPE_AGENT);
        while (__hip_atomic_load(ctr, __ATOMIC_RELAXED, __HIP_MEMORY_SCOPE_AGENT) < target) __builtin_amdgcn_s_sleep(1);
        __builtin_amdgcn_fence(__ATOMIC_ACQUIRE, "agent");
        asm volatile("s_waitcnt vmcnt(0)" ::: "memory");
    }
    __syncthreads();
}

#ifndef ONLY_GI
#define ENG(k) true
#else
#define ENG(k) ((k) == ONLY_GI)
#endif
#ifndef ONLY_KIND
#define EN(k) true
#else
#define EN(k) ((k) == ONLY_KIND)
#endif
__global__ void __launch_bounds__(512, 2) fwd_megakernel(Params p) {
    extern __shared__ __attribute__((aligned(16))) unsigned char shm[];
    LAS unsigned char* lds = (LAS unsigned char*)shm;
    cg::grid_group grid = cg::this_grid();
    unsigned char* ws = p.ws;
    h16* PRE = (h16*)(ws + WS_PRE); h16* XH = (h16*)(ws + WS_XH); h16* VF = (h16*)(ws + WS_VF);
    unsigned char* R1 = ws + WS_R1; unsigned char* R2 = ws + WS_R2; float* Y = (float*)(ws + WS_Y);
    h16* MIX = (h16*)R1; h16* SIDE = (h16*)R1; h16* AO = (h16*)R1;
    h16* DEC = (h16*)(R1 + R1_DEC); h16* Ab = (h16*)(R1 + R1_A); h16* Gb = (h16*)(R1 + R1_G); h16* AA = (h16*)(R1 + R1_AA); h16* YG = (h16*)(R1 + R1_YG);
    h16* C1 = (h16*)R2; h16* ACT = (h16*)R2; h16* Qb = (h16*)R2; h16* Kb = Qb + (size_t)MTOK * DM; h16* Vt = Kb + (size_t)MTOK * DM;

    volatile LAS unsigned* xst = (volatile LAS unsigned*)(lds + LDS_BYTES - 16);
    if (threadIdx.x == 0) { xst[0] = 0u; xst[1] = 0u; }
    __syncthreads();
    const XcdBarrier xb = xcd_barrier_post((unsigned*)(ws + WS_BAR), xst);
    for (int ph = p.ph_lo; ph < p.ph_hi; ++ph) {
        int layer, kind;
        if (ph < 11) { layer = 0; kind = (int)((0xDCBA9854210ull >> (4 * ph)) & 15ull); }
        else if (ph < 19) { layer = 1; kind = (int)((0xDCBA9876ull >> (4 * (ph - 11))) & 15ull); }
        else if (ph < 29) { layer = 2; kind = (int)((0xDCBA985421ull >> (4 * (ph - 19))) & 15ull); }
        else { layer = 3; kind = (int)((0xDCBA9876ull >> (4 * (ph - 29))) & 15ull); }
        const int j = layer >> 1;
        const char* W = (const char*)(ws + ((layer & 1) ? WS_X : WS_W16));
        const h16* wB1 = (const h16*)(W + W_B1); const h16* wB2 = (const h16*)(W + W_B2); const h16* wWO = (const h16*)(W + W_WO);
        const h16* wUP = (const h16*)(W + W_UP); const h16* wDN = (const h16*)(W + W_DN);
        const int nrep = ((PROBE_MASK >> kind) & 1) ? 2 : 1;
        for (int rep = 0; rep < nrep; ++rep)
        switch (kind) {
        case 0: if (EN(0)) {
            cvt_layer(lds, p, 0);
            ln_phase<false>(p.in[0], nullptr, nullptr, nullptr, XH, p.in[3], MIX);
        } break;
        case 1: if (EN(1)) {
            AMapMix am{(const char*)MIX}; EpiG1 e{C1};
            pg8::gemm_phase(lds, am, DM, wB1, DM, MTOK, j == 0 ? 6912 : 7168, DM, e);
        } break;
        case 2: if (EN(2)) {
            const float* w0 = p.in[5] + (size_t)j * DM; const float* a0 = p.in[8] + (size_t)j * DM; const float* v0 = p.in[11] + (size_t)(j > 0 ? j - 1 : 0) * DM;
            int k2 = 256; asm volatile("" : "+s"(k2));
            if (ENG(0)) { AMapOne am{(const char*)(C1 + 6144)}; EpiG2<0> e{DEC, Ab, Gb, C1, VF, w0, a0, v0, AA, p.in[16] + (size_t)j * DM, p.in[17] + (size_t)j * DM}; pg8::gemm_phase(lds, am, LDC1, wB2, 256, MTOK, DM, k2, e); }
            if (ENG(1)) { AMapOne am{(const char*)(C1 + 6400)}; EpiG2<1> e{DEC, Ab, Gb, C1, VF, w0, a0, v0, AA, p.in[16] + (size_t)j * DM, p.in[17] + (size_t)j * DM}; pg8::gemm_phase(lds, am, LDC1, wB2 + (size_t)2048 * 256, 256, MTOK, DM, k2, e); }
            if (ENG(2)) { AMapOne am{(const char*)(C1 + 6656)}; EpiG2<2> e{DEC, Ab, Gb, C1, VF, w0, a0, v0, AA, p.in[16] + (size_t)j * DM, p.in[17] + (size_t)j * DM}; pg8::gemm_phase(lds, am, LDC1, wB2 + (size_t)4096 * 256, 256, MTOK, DM, k2, e); }
            if (ENG(3) && j > 0) { AMapOne am{(const char*)(C1 + 6912)}; EpiG2<3> e{DEC, Ab, Gb, C1, VF, w0, a0, v0, AA, p.in[16] + (size_t)j * DM, p.in[17] + (size_t)j * DM}; pg8::gemm_phase(lds, am, LDC1, wB2 + (size_t)6144 * 256, 256, MTOK, DM, k2, e); }
        } break;
        case 3: if (EN(3)) prep_phase(C1, Ab, AA, VF, p.in[16] + (size_t)j * DM, p.in[17] + (size_t)j * DM, j == 0); break;
        case 4: if (EN(4)) scan_phase(lds, C1, DEC, AA, Ab, Y, p.in[22] + (size_t)j * DM * 6144, p.in[25] + (size_t)j * DM * DM, p.in[27] + (size_t)(layer + 1) * DM * 2 * FF, p.in[30] + (size_t)(layer + 1) * FF * DM, (char*)(ws + WS_X),
                                       p.in[27] + (size_t)layer * DM * 2 * FF, p.in[30] + (size_t)layer * FF * DM, (char*)(ws + WS_W16)); break;
        case 5: if (EN(5)) gn_phase(Y, C1, Gb, YG, p.in[18] + (size_t)j * DM, p.in[19] + (size_t)j * DM, p.in[20] + (size_t)j * DM, j == 0 ? VF : nullptr); break;
        case 6: if (EN(6)) {
            AMapOne am{(const char*)XH}; EpiQKV e{Qb, Kb, Vt};
            pg8::gemm_phase(lds, am, DM, wB1, DM, MTOK, 6144, DM, e);
        } break;
        case 7: if (EN(7)) {
            const float li = layer == 1 ? 0.35550906759096926f : 0.5560581861995943f;
            attn_phase(lds, Qb, Kb, Vt, AO, p.in[26], p.in[23] + (size_t)j * 512, p.in[24] + (size_t)j * 256, li);
        } break;
        case 8: if (EN(8)) {
            AMapOne am{(const char*)((layer & 1) ? AO : YG)}; EpiRes e{XH, PRE};
            pg8::gemm_phase(lds, am, DM, wWO, DM, MTOK, DM, DM, e);
        } break;
        case 9: case 13: if (EN(9)) {
            const int sub = kind == 9 ? 0 : 1;
            const float* g = p.in[1] + (size_t)(layer * 2 + sub) * DM; const float* bt = p.in[2] + (size_t)(layer * 2 + sub) * DM;
            float* xo = nullptr; h16* xh = XH; const float* mu = nullptr; h16* mx = nullptr;
            if (kind == 13) {
                if (layer == 3) { xo = p.out; xh = nullptr; }
                else {
                    if (layer == 1) cvt_layer(lds, p, layer + 1);
                    if (layer == 1) { mu = p.in[3] + (size_t)1 * 6 * DM; mx = MIX; }
                }
            }
            ln_phase<true>(PRE, g, bt, xo, xh, mu, mx);
        } break;
        case 10: if (EN(10)) {
            AMapOne am{(const char*)XH}; EpiUpConv e{ACT, SIDE, p.in[28] + (size_t)layer * 3 * FF, p.in[29] + (size_t)layer * FF};
            pg8::gemm_phase(lds, am, DM, wUP, DM, MTOK, 2 * FF, DM, e);
        } break;
        case 11: if (EN(11)) convfix_phase(SIDE, ACT, p.in[28] + (size_t)layer * 3 * FF, p.in[29] + (size_t)layer * FF); break;
        case 12: if (EN(12)) {
            AMapOne am{(const char*)ACT}; EpiRes e{XH, PRE};
            pg8::gemm_phase(lds, am, FF, wDN, FF, MTOK, DM, FF, e);
        } break;
        }
        if (ph + 1 < p.ph_hi) {
            if (ph == p.ph_lo) grid.sync();
            else xcd_barrier(xb);
        }
    }
}

constexpr int NPHASES = 37;

extern "C" void kernel_launch(void* const* d_in, const int* in_sizes, int n_in, void* d_out, int out_size, void* d_ws, size_t ws_size, hipStream_t stream) {
    static int grid_blocks = 0;
    if (!grid_blocks) {
        if (n_in != 31 || ws_size < WS_END) { fprintf(stderr, "kernel_launch: unexpected n_in %d / ws_size %zu (need %zu)\n", n_in, ws_size, (size_t)WS_END); grid_blocks = -1; return; }
        int dev = 0, cus = 0, per_cu = 0;
        hipGetDevice(&dev);
        hipDeviceGetAttribute(&cus, hipDeviceAttributeMultiprocessorCount, dev);
        if (hipFuncSetAttribute((const void*)fwd_megakernel, hipFuncAttributeMaxDynamicSharedMemorySize, LDS_BYTES) != hipSuccess) { fprintf(stderr, "kernel_launch: hipFuncSetAttribute failed\n"); grid_blocks = -1; return; }
        if (hipOccupancyMaxActiveBlocksPerMultiprocessor(&per_cu, (const void*)fwd_megakernel, 512, LDS_BYTES) != hipSuccess || per_cu < 1) { fprintf(stderr, "kernel_launch: occupancy query gave %d\n", per_cu); per_cu = 1; (void)hipGetLastError(); }
        grid_blocks = cus * per_cu;
        if (grid_blocks > 256) grid_blocks = 256;
    }
    if (grid_blocks < 0) return;
    Params p{};
    for (int i = 0; i < 31; ++i) p.in[i] = (const float*)d_in[i];
    p.out = (float*)d_out; p.ws = (unsigned char*)d_ws; p.ph_lo = 0; p.ph_hi = NPHASES;
    if (hipMemsetAsync((char*)d_ws + WS_BAR, 0, 16384, stream) != hipSuccess) { fprintf(stderr, "kernel_launch: memset failed\n"); return; }
    void* args[] = {&p};
    hipError_t e = hipLaunchCooperativeKernel((const void*)fwd_megakernel, dim3(grid_blocks), dim3(512), args, LDS_BYTES, stream);
    if (e != hipSuccess) fprintf(stderr, "cooperative launch failed: %s (grid %d)\n", hipGetErrorString(e), grid_blocks);
}
```

```cpp
#include <hip/hip_runtime.h>
#include <hip/hip_cooperative_groups.h>
#include <cstdio>
namespace cg = cooperative_groups;

#define LAS __attribute__((address_space(3)))
#define GAS __attribute__((address_space(1)))
typedef _Float16 h16;
typedef _Float16 h16x8 __attribute__((ext_vector_type(8)));
typedef _Float16 h16x4 __attribute__((ext_vector_type(4)));
typedef float f32x4 __attribute__((ext_vector_type(4)));
typedef float f32x2 __attribute__((ext_vector_type(2)));
typedef float f32x16 __attribute__((ext_vector_type(16)));
typedef unsigned u32x4 __attribute__((ext_vector_type(4)));

constexpr int MTOK = 16384, DM = 2048, SEQ = 8192, FF = 5504, LDC1 = 7168;
constexpr float ALPHA = 1.681792830507429f;
constexpr float LOG2E = 1.4426950408889634f;
constexpr float QSCALE = 0.08838834764831845f * LOG2E;
constexpr int LDS_BYTES = 157696;
#define PROBE_MASK 0x0000

constexpr size_t W_B1 = 0, W_B2 = 29360128, W_WO = 33554432, W_UP = 41943040, W_DN = 87031808;
constexpr size_t WS_W16 = 0, WS_X = 117440512, WS_PRE = WS_X + 134217728, WS_XH = WS_PRE + 134217728, WS_VF = WS_XH + 67108864,
                 WS_R1 = WS_VF + 67108864, WS_R2 = WS_R1 + 402653184, WS_Y = WS_R2 + 234881024, WS_BAR = WS_Y + 134217728, WS_END = WS_BAR + 16384;
constexpr size_t R1_DEC = 0, R1_A = 134217728, R1_G = R1_A + 67108864, R1_AA = R1_G + 67108864, R1_YG = R1_AA + 67108864;

struct Params {
    const float* in[31];
    float* out;
    unsigned char* ws;
    int ph_lo, ph_hi;
};

__device__ __forceinline__ int otid() { int t = (int)threadIdx.x; asm volatile("" : "+v"(t)); return t; }
__device__ __forceinline__ int obid() { int t = (int)blockIdx.x; asm volatile("" : "+s"(t)); return t; }
template <int CTRL> __device__ __forceinline__ float dpp_f(float x) { return __int_as_float(__builtin_amdgcn_update_dpp(0, __float_as_int(x), CTRL, 0xF, 0xF, true)); }
__device__ __forceinline__ float row16_sum(float x) { x += dpp_f<0xB1>(x); x += dpp_f<0x4E>(x); x += dpp_f<0x141>(x); x += dpp_f<0x140>(x); return x; }
__device__ __forceinline__ float grp16_sum(float x) { return row16_sum(x); }
__device__ __forceinline__ float wave_sum(float x) { x = row16_sum(x); x += __shfl_xor(x, 16); x += __shfl_xor(x, 32); return x; }
__device__ __forceinline__ float sigmoidf_(float x) { return 1.0f / (1.0f + __expf(-x)); }

namespace pg8 {
constexpr int BM = 256, BK = 64, HALF = 128, HTB = HALF * BK * 2, NXCD = 8, WGM = 4;
__device__ __forceinline__ int lds_byte(int r, int c) { const int st = (r >> 4) * 2 + (c >> 5), rr = r & 15, cc = c & 31, ob = rr * 64 + cc * 2; return st * 1024 + (ob ^ (((ob >> 9) & 1) << 5)); }
__device__ __forceinline__ void stage_rc(int b, int& R, int& C) { const int st = b / 1024, sb = b % 1024, swz = sb ^ (((sb >> 9) & 1) << 5); R = (st >> 1) * 16 + swz / 64; C = (st & 1) * 32 + (swz % 64) / 2; }
__device__ __forceinline__ int perm32(int rho) { const int n = rho >> 4, i = rho & 15; return 8 * (i >> 2) + 4 * n + (i & 3); }
struct Unit { int pm, pn; };
struct Order {
    int nM, nN, nwg, G, c;
    __device__ void init(int M, int N, int G_, int c_) { nM = M / BM; nN = N / BM; nwg = nM * nN; G = G_; c = c_; }
    __device__ bool next(int i, Unit& u) const {
        const long L = (long)i * G + c; if (L >= nwg) return false;
        int wgid = (int)L; { const int q = nwg / NXCD, r = nwg % NXCD, xcd = wgid % NXCD, off = wgid / NXCD; wgid = (xcd < r ? xcd * (q + 1) : r * (q + 1) + (xcd - r) * q) + off; }
        const int nig = WGM * nN, gid = wgid / nig, fm = gid * WGM, gsz = (nM - fm) < WGM ? (nM - fm) : WGM;
        u.pm = fm + ((wgid % nig) % gsz); u.pn = (wgid % nig) / gsz; return true;
    }
};

template <class Epi, class AMap>
__device__ __forceinline__ void gemm_phase(LAS unsigned char* lds, const AMap am, const int lda, const h16* Bt, const int ldb, const int M, const int N, const int K, const Epi& E) {
    const int tid = otid(), wid = __builtin_amdgcn_readfirstlane(tid >> 6), lane = tid & 63, wr = wid >> 2, wc = wid & 3, fr = lane & 15, fq = lane >> 4;
    const int nt = K / BK;
    Order S; S.init(M, N, (int)gridDim.x, obid());
    unsigned voffA[2], voffB[2];
#pragma unroll
    for (int i = 0; i < 2; ++i) { int R, C; stage_rc(tid * 16 + i * 8192, R, C); const int Rb = Epi::PERM ? ((R & ~31) + perm32(R & 31)) : R;
        voffA[i] = (unsigned)(R * lda + C) * 2u; voffB[i] = (unsigned)(Rb * ldb + C) * 2u; }
    const size_t kstep = (size_t)(BK * 2);
    const size_t hstepA = (size_t)HALF * lda * 2, hstepB = (size_t)HALF * ldb * 2;
    const size_t tstepA = 2 * hstepA, tstepB = 2 * hstepB;
    const unsigned ldsw = (unsigned)wid * 1024u;
    const int aoff = lds_byte(wr * 64 + fr, fq * 8), boff = lds_byte(wc * 32 + fr, fq * 8);
#define PG8_SA(b, h) (((b) * 2 + (h)) * HTB)
#define PG8_SB(b, h) ((4 + (b) * 2 + (h)) * HTB)
#define PG8_STAGE(bufoff, gbase, voff) do { _Pragma("unroll") for (int _i = 0; _i < 2; ++_i) \
        __builtin_amdgcn_global_load_lds((const unsigned*)((const char*)(gbase) + (voff)[_i]), (LAS unsigned*)(lds + (bufoff) + ldsw + _i * 8192), 16, 0, 0); } while (0)
#define PG8_LDA(dst, b, h) do { _Pragma("unroll") for (int m = 0; m < 4; ++m) _Pragma("unroll") for (int k = 0; k < 2; ++k) dst[m][k] = *(const LAS h16x8*)(lds + PG8_SA(b, h) + aoff + m * 2048 + k * 1024); } while (0)
#define PG8_LDB(dst, b, h) do { _Pragma("unroll") for (int n = 0; n < 2; ++n) _Pragma("unroll") for (int k = 0; k < 2; ++k) dst[n][k] = *(const LAS h16x8*)(lds + PG8_SB(b, h) + boff + n * 2048 + k * 1024); } while (0)
#define PG8_MMA(ai, bj, At, Bt_) do { __builtin_amdgcn_s_setprio(1); _Pragma("unroll") for (int m = 0; m < 4; ++m) _Pragma("unroll") for (int n = 0; n < 2; ++n) _Pragma("unroll") for (int k = 0; k < 2; ++k) \
        acc[ai][bj][m][n] = __builtin_amdgcn_mfma_f32_16x16x32_f16(Bt_[n][k], At[m][k], acc[ai][bj][m][n], 0, 0, 0); __builtin_amdgcn_s_setprio(0); } while (0)
#define PG8_WAIT_V(n) asm volatile("s_waitcnt vmcnt(" #n ")" ::: "memory")
#define PG8_WAIT_L(n) asm volatile("s_waitcnt lgkmcnt(" #n ")" ::: "memory")
#define PG8_BAR __builtin_amdgcn_s_barrier()
#define PG8_SCHED __builtin_amdgcn_sched_barrier(0)
    Unit cur, nxt; int ui = 0;
    if (!S.next(0, cur)) return;
    f32x4 acc[2][2][4][2];
#pragma unroll
    for (int a = 0; a < 2; ++a)
#pragma unroll
        for (int b = 0; b < 2; ++b)
#pragma unroll
            for (int m = 0; m < 4; ++m)
#pragma unroll
                for (int n = 0; n < 2; ++n) acc[a][b][m][n] = (f32x4){0.f, 0.f, 0.f, 0.f};
    h16x8 At[4][2], B0[2][2], B1[2][2];
    const char* cA = am(cur.pn) + (size_t)cur.pm * tstepA; const char* cB = (const char*)Bt + (size_t)cur.pn * tstepB;
    PG8_STAGE(PG8_SB(0, 0), cB, voffB); PG8_STAGE(PG8_SA(0, 0), cA, voffA); PG8_STAGE(PG8_SB(0, 1), cB + hstepB, voffB); PG8_STAGE(PG8_SA(0, 1), cA + hstepA, voffA);
    if (wr == 1) PG8_BAR;
    PG8_WAIT_V(4); PG8_BAR;
    PG8_STAGE(PG8_SB(1, 0), cB + kstep, voffB); PG8_STAGE(PG8_SA(1, 0), cA + kstep, voffA); PG8_STAGE(PG8_SB(1, 1), cB + hstepB + kstep, voffB);
    PG8_WAIT_V(6); PG8_BAR;
    for (;;) {
        const bool has_next = S.next(ui + 1, nxt);
        const char* nA = has_next ? am(nxt.pn) + (size_t)nxt.pm * tstepA : cA; const char* nB = has_next ? (const char*)Bt + (size_t)nxt.pn * tstepB : cB;
#pragma unroll 1
        for (int t = 0; t < nt; t += 2) {
            const bool last = (t == nt - 2);
            const char* a1 = cA + (size_t)(t + 1) * kstep;
            const char* a2 = last ? nA : cA + (size_t)(t + 2) * kstep; const char* b2 = last ? nB : cB + (size_t)(t + 2) * kstep;
            const char* a3 = a2 + kstep; const char* b3 = b2 + kstep;
            PG8_LDB(B0, 0, 0); PG8_SCHED; PG8_LDA(At, 0, 0); PG8_STAGE(PG8_SA(1, 1), a1 + hstepA, voffA);
            PG8_WAIT_L(8); PG8_BAR; PG8_WAIT_L(0); PG8_MMA(0, 0, At, B0); PG8_BAR; PG8_SCHED;
            PG8_LDB(B1, 0, 1); PG8_STAGE(PG8_SB(0, 0), b2, voffB);
            PG8_BAR; PG8_WAIT_L(0); PG8_MMA(0, 1, At, B1); PG8_BAR;
            PG8_LDA(At, 0, 1); PG8_STAGE(PG8_SA(0, 0), a2, voffA);
            PG8_BAR; PG8_WAIT_L(0); PG8_MMA(1, 0, At, B0); PG8_BAR; PG8_SCHED;
            PG8_STAGE(PG8_SB(0, 1), b2 + hstepB, voffB);
            PG8_WAIT_V(6); PG8_BAR; PG8_MMA(1, 1, At, B1); PG8_BAR;
            PG8_LDB(B0, 1, 0); PG8_SCHED; PG8_LDA(At, 1, 0); PG8_STAGE(PG8_SA(0, 1), a2 + hstepA, voffA);
            PG8_WAIT_L(8); PG8_BAR; PG8_WAIT_L(0); PG8_MMA(0, 0, At, B0); PG8_BAR; PG8_SCHED;
            PG8_LDB(B1, 1, 1); PG8_STAGE(PG8_SB(1, 0), b3, voffB);
            PG8_BAR; PG8_WAIT_L(0); PG8_MMA(0, 1, At, B1); PG8_BAR;
            PG8_LDA(At, 1, 1); PG8_STAGE(PG8_SA(1, 0), a3, voffA);
            PG8_BAR; PG8_WAIT_L(0); PG8_MMA(1, 0, At, B0); PG8_BAR; PG8_SCHED;
            PG8_STAGE(PG8_SB(1, 1), b3 + hstepB, voffB);
            PG8_WAIT_V(6); PG8_BAR; PG8_MMA(1, 1, At, B1); PG8_BAR;
        }
        E(acc, cur, wr, wc, fr, fq);
        if (!has_next) break;
#pragma unroll
        for (int a = 0; a < 2; ++a)
#pragma unroll
            for (int b = 0; b < 2; ++b)
#pragma unroll
                for (int m = 0; m < 4; ++m)
#pragma unroll
                    for (int n = 0; n < 2; ++n) acc[a][b][m][n] = (f32x4){0.f, 0.f, 0.f, 0.f};
        cur = nxt; cA = nA; cB = nB; ++ui;
    }
    PG8_WAIT_V(0);
    if (wr == 0) PG8_BAR;
    PG8_BAR;
#undef PG8_SA
#undef PG8_SB
#undef PG8_STAGE
#undef PG8_LDA
#undef PG8_LDB
#undef PG8_MMA
#undef PG8_WAIT_V
#undef PG8_WAIT_L
#undef PG8_BAR
#undef PG8_SCHED
}
}
using pg8::Unit;

__device__ __forceinline__ u32x4 pack8(f32x4 a, f32x4 b) {
    h16x8 v = {(h16)a[0], (h16)a[1], (h16)a[2], (h16)a[3], (h16)b[0], (h16)b[1], (h16)b[2], (h16)b[3]};
    return __builtin_bit_cast(u32x4, v);
}

struct AMapOne { const char* A; __device__ __forceinline__ const char* operator()(int) const { return A; } };
struct AMapMix {
    const char* A;
    __device__ __forceinline__ const char* operator()(int pn) const {
        int idx; if (pn < 8) idx = 0; else if (pn < 16) idx = 2; else if (pn < 24) idx = 3; else if (pn == 24) idx = 1; else if (pn == 25) idx = 4; else if (pn == 26) idx = 5; else idx = 3;
        return A + (size_t)idx * ((size_t)MTOK * DM * 2);
    }
};
struct AMapLora {
    const char* C1;
    __device__ __forceinline__ const char* operator()(int pn) const { return C1 + (size_t)(6144 + 256 * (pn >> 3)) * 2; }
};

#define EPI_ROWS_PERM  const int row0 = u.pm * 256 + wr * 64 + fr; const int colt = u.pn * 256 + wc * 32 + 8 * fq;
struct EpiH16 {
    static constexpr bool PERM = true;
    h16* O; int ldc;
    __device__ __forceinline__ void operator()(const f32x4 (&acc)[2][2][4][2], const Unit& u, int wr, int wc, int fr, int fq) const {
        EPI_ROWS_PERM
#pragma unroll
        for (int ai = 0; ai < 2; ++ai)
#pragma unroll
            for (int m = 0; m < 4; ++m) { h16* rowp = O + (size_t)(row0 + ai * 128 + m * 16) * ldc + colt;
#pragma unroll
                for (int bj = 0; bj < 2; ++bj) *(u32x4*)(rowp + bj * 128) = pack8(acc[ai][bj][m][0], acc[ai][bj][m][1]); }
    }
};
struct EpiG1 {
    static constexpr bool PERM = true;
    h16* O; h16* VFw;
    __device__ __forceinline__ void operator()(const f32x4 (&acc)[2][2][4][2], const Unit& u, int wr, int wc, int fr, int fq) const {
        EPI_ROWS_PERM
        const int mode = u.pn == 24 ? 1 : (u.pn == 26 ? 2 : 0);
        const bool vtile = VFw != nullptr && u.pn >= 16 && u.pn < 24;
#pragma unroll
        for (int ai = 0; ai < 2; ++ai)
#pragma unroll
            for (int m = 0; m < 4; ++m) { h16* rowp = O + (size_t)(row0 + ai * 128 + m * 16) * LDC1 + colt;
#pragma unroll
                for (int bj = 0; bj < 2; ++bj) { f32x4 v0 = acc[ai][bj][m][0], v1 = acc[ai][bj][m][1];
                    if (mode == 1) {
#pragma unroll
                        for (int j = 0; j < 4; ++j) { v0[j] = 1.0f - 2.0f / (1.0f + __expf(2.0f * v0[j])); v1[j] = 1.0f - 2.0f / (1.0f + __expf(2.0f * v1[j])); } }
                    else if (mode == 2) {
#pragma unroll
                        for (int j = 0; j < 4; ++j) { v0[j] = sigmoidf_(v0[j]); v1[j] = sigmoidf_(v1[j]); } }
                    const u32x4 pk = pack8(v0, v1);
                    *(u32x4*)(rowp + bj * 128) = pk;
                    if (vtile) *(u32x4*)(VFw + (size_t)(row0 + ai * 128 + m * 16) * DM + (colt - 4096) + bj * 128) = pk; } }
    }
};
template <int GI_> struct EpiG2 {
    static constexpr bool PERM = true;
    h16* DEC; h16* Ab; h16* Gb; h16* C1; const h16* VF; const float* w0; const float* a0; const float* v0; h16* AA; const float* k_k; const float* k_a;
    template <int GI>
    __device__ __forceinline__ void body(const f32x4 (&acc)[2][2][4][2], int row0, int colt) const {
#pragma unroll
        for (int bj = 0; bj < 2; ++bj) {
            const int c = colt + bj * 128;
            f32x4 b0 = (f32x4){0.f, 0.f, 0.f, 0.f}, b1 = b0;
            if (GI == 0) { b0 = *(const f32x4*)(w0 + c); b1 = *(const f32x4*)(w0 + c + 4); }
            else if (GI == 1) { b0 = *(const f32x4*)(a0 + c); b1 = *(const f32x4*)(a0 + c + 4); }
            else if (GI == 3) { b0 = *(const f32x4*)(v0 + c); b1 = *(const f32x4*)(v0 + c + 4); }
#pragma unroll
            for (int ai = 0; ai < 2; ++ai)
#pragma unroll
                for (int m = 0; m < 4; ++m) {
                    const size_t row = (size_t)(row0 + ai * 128 + m * 16);
                    f32x4 x0 = acc[ai][bj][m][0] + b0, x1 = acc[ai][bj][m][1] + b1;
                    if (GI == 0) {
#pragma unroll
                        for (int j = 0; j < 4; ++j) {
                            x0[j] = 0.6065306597126334f * sigmoidf_(x0[j]); x1[j] = 0.6065306597126334f * sigmoidf_(x1[j]); }
                        *(u32x4*)(DEC + row * DM + c) = pack8(x0, x1);
                    } else if (GI == 1) {
#pragma unroll
                        for (int j = 0; j < 4; ++j) { x0[j] = sigmoidf_(x0[j]); x1[j] = sigmoidf_(x1[j]); }
                        *(u32x4*)(Ab + row * DM + c) = pack8(x0, x1);
                    } else if (GI == 2) {
                        *(u32x4*)(Gb + row * DM + c) = pack8(x0, x1);
                    } else {
                        h16* vp = C1 + row * LDC1 + 4096 + c;
                        const h16x8 vv = *(const h16x8*)vp; const h16x8 vf = *(const h16x8*)(VF + row * DM + c);
                        f32x4 o0, o1;
#pragma unroll
                        for (int j = 0; j < 4; ++j) { float v = (float)vv[j], f = (float)vf[j]; o0[j] = v + (f - v) * sigmoidf_(x0[j]); v = (float)vv[4 + j]; f = (float)vf[4 + j]; o1[j] = v + (f - v) * sigmoidf_(x1[j]); }
                        *(u32x4*)vp = pack8(o0, o1);
                    }
                    __builtin_amdgcn_sched_barrier(0);
                }
        }
    }
    __device__ __forceinline__ void body_a(const f32x4 (&acc)[2][2][4][2], int row0, int cb0) const {
#pragma unroll
        for (int ai = 0; ai < 2; ++ai)
#pragma unroll
            for (int m = 0; m < 4; ++m) {
                const size_t row = (size_t)(row0 + ai * 128 + m * 16);
                asm volatile("" ::: "memory");
                float a[2][8], kv[2][8], kk[2][8]; float ss = 0.f;
#pragma unroll
                for (int bj = 0; bj < 2; ++bj) {
                    const int c = cb0 + 32 * bj;
                    const f32x4 b0 = *(const f32x4*)(a0 + c), b1 = *(const f32x4*)(a0 + c + 4), q0 = *(const f32x4*)(k_k + c), q1 = *(const f32x4*)(k_k + c + 4);
                    const h16x8 kh = *(const h16x8*)(C1 + row * LDC1 + 2048 + c);
#pragma unroll
                    for (int e = 0; e < 4; ++e) {
                        a[bj][e] = sigmoidf_(acc[ai][bj][m][0][e] + b0[e]); a[bj][4 + e] = sigmoidf_(acc[ai][bj][m][1][e] + b1[e]);
                        kv[bj][e] = (float)kh[e]; kv[bj][4 + e] = (float)kh[4 + e];
                        kk[bj][e] = kv[bj][e] * q0[e]; kk[bj][4 + e] = kv[bj][4 + e] * q1[e];
                        ss += kk[bj][e] * kk[bj][e] + kk[bj][4 + e] * kk[bj][4 + e];
                    }
                }
                ss += __shfl_xor(ss, 16); ss += __shfl_xor(ss, 32);
                const float inv = 1.0f / fmaxf(sqrtf(ss), 1e-12f);
#pragma unroll
                for (int bj = 0; bj < 2; ++bj) {
                    const int c = cb0 + 32 * bj;
                    const f32x4 p0 = *(const f32x4*)(k_a + c), p1 = *(const f32x4*)(k_a + c + 4);
                    f32x4 ko0, ko1, ao0, ao1, bo0, bo1;
#pragma unroll
                    for (int e = 0; e < 4; ++e) {
                        ko0[e] = kv[bj][e] * (1.0f + (a[bj][e] - 1.0f) * p0[e]); ko1[e] = kv[bj][4 + e] * (1.0f + (a[bj][4 + e] - 1.0f) * p1[e]);
                        const float n0_ = kk[bj][e] * inv, n1_ = kk[bj][4 + e] * inv;
                        ao0[e] = -n0_; ao1[e] = -n1_; bo0[e] = n0_ * a[bj][e]; bo1[e] = n1_ * a[bj][4 + e];
                    }
                    *(u32x4*)(C1 + row * LDC1 + 2048 + c) = pack8(ko0, ko1);
                    *(u32x4*)(AA + row * DM + c) = pack8(ao0, ao1);
                    *(u32x4*)(Ab + row * DM + c) = pack8(bo0, bo1);
                }
                __builtin_amdgcn_sched_barrier(0);
            }
    }
    __device__ __forceinline__ void operator()(const f32x4 (&acc)[2][2][4][2], const Unit& u, int wr, int wc, int fr, int fq) const {
        const int row0 = u.pm * 256 + wr * 64 + fr; const int colt = u.pn * 256 + wc * 32 + 8 * fq;
        if (GI_ == 1) body_a(acc, row0, u.pn * 256 + wc * 64 + 8 * fq);
        else body<GI_>(acc, row0, colt);
    }
};
struct EpiRes {
    static constexpr bool PERM = true;
    const h16* X; h16* PRE;
    __device__ __forceinline__ void operator()(const f32x4 (&acc)[2][2][4][2], const Unit& u, int wr, int wc, int fr, int fq) const {
        EPI_ROWS_PERM
#pragma unroll
        for (int ai = 0; ai < 2; ++ai)
#pragma unroll
            for (int m = 0; m < 4; ++m) { const size_t off = (size_t)(row0 + ai * 128 + m * 16) * DM + colt;
#pragma unroll
                for (int bj = 0; bj < 2; ++bj) {
                    const h16x8 x = *(const h16x8*)(X + off + bj * 128);
                    f32x4 o0, o1;
#pragma unroll
                    for (int e = 0; e < 4; ++e) { o0[e] = (float)x[e] * ALPHA + acc[ai][bj][m][0][e]; o1[e] = (float)x[4 + e] * ALPHA + acc[ai][bj][m][1][e]; }
                    *(u32x4*)(PRE + off + bj * 128) = pack8(o0, o1); } }
    }
};
__device__ __forceinline__ float gelu_mul(float u, float gc) {
    const float t = gc * gc;
    const float z = gc * (t * (0.044715f * 1.5957691216057308f * LOG2E) + 1.5957691216057308f * LOG2E);
    return u * gc * __builtin_amdgcn_rcpf(1.0f + __builtin_amdgcn_exp2f(-z));
}
struct EpiUpConv {
    static constexpr bool PERM = true;
    h16* ACT; h16* SIDE; const float* cw; const float* cb;
    __device__ __forceinline__ void operator()(const f32x4 (&acc)[2][2][4][2], const Unit& u, int wr, int wc, int fr, int fq) const {
        const int row0 = u.pm * 256 + wr * 64 + fr, f0 = u.pn * 128 + wc * 32 + 8 * fq;
        f32x4 w0[2], w1[2], w2[2], bb[2];
#pragma unroll
        for (int n = 0; n < 2; ++n) { w0[n] = *(const f32x4*)(cw + f0 + 4 * n); w1[n] = *(const f32x4*)(cw + FF + f0 + 4 * n); w2[n] = *(const f32x4*)(cw + 2 * FF + f0 + 4 * n); bb[n] = *(const f32x4*)(cb + f0 + 4 * n); }
#pragma unroll
        for (int ai = 0; ai < 2; ++ai) {
            f32x4 p1[2], p2[2];
#pragma unroll
            for (int n = 0; n < 2; ++n) { p1[n] = (f32x4){0.f, 0.f, 0.f, 0.f}; p2[n] = p1[n]; }
#pragma unroll
            for (int m = 0; m < 4; ++m) {
                const int row = row0 + ai * 128 + m * 16;
                f32x4 r1[2], r2[2], o[2];
#pragma unroll
                for (int n = 0; n < 2; ++n)
#pragma unroll
                    for (int e = 0; e < 4; ++e) {
                        const float g = acc[ai][1][m][n][e];
                        r1[n][e] = dpp_f<0x121>(g); r2[n][e] = dpp_f<0x122>(g);
                        const float g1 = fr >= 1 ? r1[n][e] : p1[n][e], g2 = fr >= 2 ? r2[n][e] : p2[n][e];
                        const float gc = bb[n][e] + g2 * w0[n][e] + g1 * w1[n][e] + g * w2[n][e];
                        o[n][e] = gelu_mul(acc[ai][0][m][n][e], gc);
                    }
                if (m > 0 || fr >= 2) *(u32x4*)(ACT + (size_t)row * FF + f0) = pack8(o[0], o[1]);
                if (m == 0 && fr < 2) { h16* sp = SIDE + ((size_t)(row >> 6) * 4 + 2 + fr) * (2 * FF) + f0;
                    *(u32x4*)sp = pack8(acc[ai][0][m][0], acc[ai][0][m][1]); *(u32x4*)(sp + FF) = pack8(acc[ai][1][m][0], acc[ai][1][m][1]); }
                if (m == 3 && fr >= 14) { h16* sp = SIDE + ((size_t)(row >> 6) * 4 + (fr - 14)) * (2 * FF) + FF + f0;
                    *(u32x4*)sp = pack8(acc[ai][1][m][0], acc[ai][1][m][1]); }
#pragma unroll
                for (int n = 0; n < 2; ++n) { p1[n] = r1[n]; p2[n] = r2[n]; }
            }
        }
    }
};
__device__ __forceinline__ void convfix_phase(const h16* SIDE, h16* ACT, const float* cw, const float* cb) {
    constexpr int NCG = FF / 8, NT = 256 * 2 * NCG;
    for (int task = obid() * 512 + otid(); task < NT; task += gridDim.x * 512) {
        const int cgi = task % NCG, j = (task / NCG) & 1, gidx = task / (2 * NCG), f = cgi * 8;
        const bool first = (gidx & 127) == 0;
        const h16* cur = SIDE + ((size_t)gidx * 4 + 2 + j) * (2 * FF) + f;
        const h16x8 uh = *(const h16x8*)cur, g0h = *(const h16x8*)(cur + FF);
        h16x8 g1h = {}, g2h = {};
        if (j == 0) { if (!first) { g1h = *(const h16x8*)(SIDE + ((size_t)(gidx - 1) * 4 + 1) * (2 * FF) + FF + f); g2h = *(const h16x8*)(SIDE + ((size_t)(gidx - 1) * 4 + 0) * (2 * FF) + FF + f); } }
        else { g1h = *(const h16x8*)(SIDE + ((size_t)gidx * 4 + 2) * (2 * FF) + FF + f); if (!first) g2h = *(const h16x8*)(SIDE + ((size_t)(gidx - 1) * 4 + 1) * (2 * FF) + FF + f); }
        h16x8 o;
#pragma unroll
        for (int e = 0; e < 8; ++e) {
            const float gc = cb[f + e] + (float)g2h[e] * cw[f + e] + (float)g1h[e] * cw[FF + f + e] + (float)g0h[e] * cw[2 * FF + f + e];
            o[e] = (h16)gelu_mul((float)uh[e], gc);
        }
        *(h16x8*)(ACT + ((size_t)gidx * 64 + j) * FF + f) = o;
    }
}
struct EpiQKV {
    static constexpr bool PERM = true;
    h16* Qb; h16* Kb; h16* Vt;
    __device__ __forceinline__ void operator()(const f32x4 (&acc)[2][2][4][2], const Unit& u, int wr, int wc, int fr, int fq) const {
        const int row0 = u.pm * 256 + wr * 64 + fr; const int part = u.pn >> 3; const int colt = (u.pn & 7) * 256 + wc * 32 + 8 * fq;
#pragma unroll
        for (int ai = 0; ai < 2; ++ai)
#pragma unroll
            for (int m = 0; m < 4; ++m) { const int row = row0 + ai * 128 + m * 16;
#pragma unroll
                for (int bj = 0; bj < 2; ++bj) { const int c = colt + bj * 128;
                    if (part == 0) *(u32x4*)(Qb + (size_t)row * DM + c) = pack8(acc[ai][bj][m][0] * QSCALE, acc[ai][bj][m][1] * QSCALE);
                    else if (part == 1) *(u32x4*)(Kb + (size_t)row * DM + c) = pack8(acc[ai][bj][m][0], acc[ai][bj][m][1]);
                    else {
                        const int b = row >> 13, t = row & 8191, hd = c >> 8, dv = c & 255;
                        const int pos = (t & ~12) | ((t & 4) << 1) | ((t & 8) >> 1);
                        h16* vp = Vt + ((size_t)((b * 8 + hd) * 256 + dv)) * SEQ + pos;
#pragma unroll
                        for (int j = 0; j < 4; ++j) { vp[(size_t)j * SEQ] = (h16)acc[ai][bj][m][0][j]; vp[(size_t)(4 + j) * SEQ] = (h16)acc[ai][bj][m][1][j]; }
                    } } }
    }
};

__device__ __forceinline__ void cvt_job(LAS unsigned char* lds, const float* src, int Ks, int Ns, h16* dst, int Kd, int Nd, int remap = 0) {
    LAS h16* tile = (LAS h16*)lds;
    const int tid = otid(), tk = Kd >> 6, tn = Nd >> 6;
    for (int t = obid(); t < tk * tn; t += gridDim.x) {
        const int k0 = (t % tk) * 64, n0 = (t / tk) * 64;
#pragma unroll
        for (int i = 0; i < 2; ++i) {
            const int idx = tid + 512 * i, kr = idx >> 4, nc = (idx & 15) * 4, k = k0 + kr, n = n0 + nc;
            f32x4 v = (f32x4){0.f, 0.f, 0.f, 0.f};
            if (k < Ks && n < Ns) v = *(const f32x4*)(src + (size_t)k * Ns + n);
            tile[kr * 66 + nc + 0] = (h16)v[0]; tile[kr * 66 + nc + 1] = (h16)v[1]; tile[kr * 66 + nc + 2] = (h16)v[2]; tile[kr * 66 + nc + 3] = (h16)v[3];
        }
        __syncthreads();
        { const int n = tid >> 3, kg = tid & 7; h16x8 o;
#pragma unroll
          for (int e = 0; e < 8; ++e) o[e] = tile[(kg * 8 + e) * 66 + n];
          const int no = n0 + n;
          const int nd = remap == 0 ? no : (remap == 1 ? (no < FF ? (no >> 7) * 256 + (no & 127) : ((no - FF) >> 7) * 256 + 128 + ((no - FF) & 127))
                                                      : ((no & ~255) | ((no & 32) << 2) | ((no & 192) >> 1) | (no & 31)));
          *(h16x8*)(dst + (size_t)nd * Kd + k0 + kg * 8) = o; }
        __syncthreads();
    }
}
__device__ __forceinline__ void cvt_layer(LAS unsigned char* lds, const Params& p, int layer) {
    const bool ffn_here = (layer & 1) != 0;
    h16* W = (h16*)(p.ws + ((layer & 1) ? WS_X : WS_W16));
    const int j = layer >> 1;
    if ((layer & 1) == 0) {
        h16* B1 = (h16*)((char*)W + W_B1); h16* B2 = (h16*)((char*)W + W_B2);
        for (int i = 0; i < 3; ++i) cvt_job(lds, p.in[4] + ((size_t)j * 3 + i) * DM * DM, DM, DM, B1 + (size_t)i * DM * DM, DM, DM);
        cvt_job(lds, p.in[6] + (size_t)j * DM * 96, DM, 96, B1 + (size_t)6144 * DM, DM, 256);
        cvt_job(lds, p.in[9] + (size_t)j * DM * 96, DM, 96, B1 + (size_t)6400 * DM, DM, 256);
        cvt_job(lds, p.in[14] + (size_t)j * DM * 128, DM, 128, B1 + (size_t)6656 * DM, DM, 256);
        cvt_job(lds, p.in[7] + (size_t)j * 96 * DM, 96, DM, B2, 256, DM);
        cvt_job(lds, p.in[10] + (size_t)j * 96 * DM, 96, DM, B2 + (size_t)2048 * 256, 256, DM, 2);
        cvt_job(lds, p.in[15] + (size_t)j * 128 * DM, 128, DM, B2 + (size_t)4096 * 256, 256, DM);
        if (j > 0) {
            cvt_job(lds, p.in[12] + (size_t)(j - 1) * DM * 64, DM, 64, B1 + (size_t)6912 * DM, DM, 256);
            cvt_job(lds, p.in[13] + (size_t)(j - 1) * 64 * DM, 64, DM, B2 + (size_t)6144 * 256, 256, DM);
        }
        cvt_job(lds, p.in[21] + (size_t)j * DM * DM, DM, DM, (h16*)((char*)W + W_WO), DM, DM);
    } else {
        cvt_job(lds, p.in[22] + (size_t)j * DM * 6144, DM, 6144, (h16*)((char*)W + W_B1), DM, 6144);
        cvt_job(lds, p.in[25] + (size_t)j * DM * DM, DM, DM, (h16*)((char*)W + W_WO), DM, DM);
    }
    if (ffn_here) {
        cvt_job(lds, p.in[27] + (size_t)layer * DM * 2 * FF, DM, 2 * FF, (h16*)((char*)W + W_UP), DM, 2 * FF, 1);
        cvt_job(lds, p.in[30] + (size_t)layer * FF * DM, FF, DM, (h16*)((char*)W + W_DN), FF, DM);
    }
}

template <bool LN>
__device__ __forceinline__ void ln_row(const void* src, size_t row, int lane, const float* g, const float* bt, f32x4 (&v)[8]) {
    if (LN) {
        const h16x4* sp = (const h16x4*)((const h16*)src + row * DM);
#pragma unroll
        for (int i = 0; i < 8; ++i) { const h16x4 t = sp[i * 64 + lane]; v[i] = (f32x4){(float)t[0], (float)t[1], (float)t[2], (float)t[3]}; }
        float s = 0.f;
#pragma unroll
        for (int i = 0; i < 8; ++i) s += (v[i][0] + v[i][1]) + (v[i][2] + v[i][3]);
        const float mean = wave_sum(s) * (1.0f / DM);
        float q = 0.f;
#pragma unroll
        for (int i = 0; i < 8; ++i) { v[i] = v[i] - mean; q += (v[i][0] * v[i][0] + v[i][1] * v[i][1]) + (v[i][2] * v[i][2] + v[i][3] * v[i][3]); }
        const float rstd = rsqrtf(wave_sum(q) * (1.0f / DM) + 1e-5f);
#pragma unroll
        for (int i = 0; i < 8; ++i) { const f32x4 gg = ((const f32x4*)g)[i * 64 + lane], bb = ((const f32x4*)bt)[i * 64 + lane]; v[i] = v[i] * rstd * gg + bb; }
    } else {
        const f32x4* sp = (const f32x4*)((const float*)src + row * DM);
#pragma unroll
        for (int i = 0; i < 8; ++i) v[i] = sp[i * 64 + lane];
    }
}
__device__ __forceinline__ void ln_load16(const void* src, size_t row, int lane, h16x4 (&t)[8]) {
    const h16x4* sp = (const h16x4*)((const h16*)src + row * DM);
#pragma unroll
    for (int i = 0; i < 8; ++i) t[i] = sp[i * 64 + lane];
}
__device__ __forceinline__ void ln_apply16(const h16x4 (&t)[8], int lane, const float* g, const float* bt, f32x4 (&v)[8]) {
#pragma unroll
    for (int i = 0; i < 8; ++i) v[i] = (f32x4){(float)t[i][0], (float)t[i][1], (float)t[i][2], (float)t[i][3]};
    float s = 0.f;
#pragma unroll
    for (int i = 0; i < 8; ++i) s += (v[i][0] + v[i][1]) + (v[i][2] + v[i][3]);
    const float mean = wave_sum(s) * (1.0f / DM);
    float q = 0.f;
#pragma unroll
    for (int i = 0; i < 8; ++i) { v[i] = v[i] - mean; q += (v[i][0] * v[i][0] + v[i][1] * v[i][1]) + (v[i][2] * v[i][2] + v[i][3] * v[i][3]); }
    const float rstd = rsqrtf(wave_sum(q) * (1.0f / DM) + 1e-5f);
#pragma unroll
    for (int i = 0; i < 8; ++i) { const f32x4 gg = ((const f32x4*)g)[i * 64 + lane], bb = ((const f32x4*)bt)[i * 64 + lane]; v[i] = v[i] * rstd * gg + bb; }
}
template <bool LN>
__device__ __forceinline__ void ln_phase(const void* src, const float* g, const float* bt, float* xout, h16* xh, const float* mu, h16* mix) {
    const int lane = otid() & 63, gw = obid() * 8 + (otid() >> 6), GW = gridDim.x * 8;
    for (int ch = gw; ch < MTOK / 8; ch += GW) {
        const size_t t0 = (size_t)ch * 8;
        f32x4 prev[8], cur[8];
        if (mix) {
            if ((t0 & (SEQ - 1)) == 0) {
#pragma unroll
                for (int i = 0; i < 8; ++i) prev[i] = (f32x4){0.f, 0.f, 0.f, 0.f};
            } else ln_row<LN>(src, t0 - 1, lane, g, bt, prev);
        }
        h16x4 raw[8], rawn[8];
        if (LN) ln_load16(src, t0, lane, raw);
#pragma unroll 1
        for (int r = 0; r < 8; ++r) {
            const size_t row = t0 + r;
            asm volatile("" ::: "memory");
            if (LN) {
                ln_load16(src, t0 + (r < 7 ? r + 1 : 7), lane, rawn);
                ln_apply16(raw, lane, g, bt, cur);
#pragma unroll
                for (int i = 0; i < 8; ++i) raw[i] = rawn[i];
            } else ln_row<LN>(src, row, lane, g, bt, cur);
            if (xout) {
#pragma unroll
                for (int i = 0; i < 8; ++i) ((f32x4*)(xout + row * DM))[i * 64 + lane] = cur[i];
            }
            if (xh) {
#pragma unroll
                for (int i = 0; i < 8; ++i) { h16x4 o = {(h16)cur[i][0], (h16)cur[i][1], (h16)cur[i][2], (h16)cur[i][3]}; ((h16x4*)(xh + row * DM))[i * 64 + lane] = o; }
            }
            if (mix) {
#pragma unroll
                for (int i = 0; i < 8; ++i) {
                    asm volatile("" ::: "memory");
                    const f32x4 xx = prev[i] - cur[i];
#pragma unroll
                    for (int k = 0; k < 6; ++k) {
                        const f32x4 m4 = ((const f32x4*)(mu + (size_t)k * DM))[i * 64 + lane];
                        const f32x4 o4 = cur[i] + xx * m4;
                        h16x4 o = {(h16)o4[0], (h16)o4[1], (h16)o4[2], (h16)o4[3]};
                        ((h16x4*)(mix + ((size_t)k * MTOK + row) * DM))[i * 64 + lane] = o;
                    }
                    prev[i] = cur[i];
                }
            }
        }
    }
}

__device__ __forceinline__ void prep_phase(h16* C1, h16* Ab, h16* AA, h16* VF, const float* k_k, const float* k_a, bool first) {
    const int lane = otid() & 63, gw = obid() * 8 + (otid() >> 6), GW = gridDim.x * 8;
    for (int row = gw; row < MTOK; row += GW) {
#pragma unroll
        for (int i = 0; i < 8; ++i) {
            const int c = i * 256 + lane * 4;
            h16x4* kp = (h16x4*)(C1 + (size_t)row * LDC1 + 2048 + c);
            h16x4* ap = (h16x4*)(Ab + (size_t)row * DM + c);
            const h16x4 kh = *kp, ah = *ap;
            const f32x4 kkw = *(const f32x4*)(k_k + c), kaw = *(const f32x4*)(k_a + c);
            f32x4 k, a, kk;
#pragma unroll
            for (int e = 0; e < 4; ++e) { k[e] = (float)kh[e]; a[e] = (float)ah[e]; kk[e] = k[e] * kkw[e]; }
            float ss = (kk[0] * kk[0] + kk[1] * kk[1]) + (kk[2] * kk[2] + kk[3] * kk[3]);
            ss = grp16_sum(ss);
            const float inv = 1.0f / fmaxf(sqrtf(ss), 1e-12f);
            h16x4 ko, aao, bbo;
#pragma unroll
            for (int e = 0; e < 4; ++e) { const float kn = kk[e] * inv; ko[e] = (h16)(k[e] * (1.0f + (a[e] - 1.0f) * kaw[e])); aao[e] = (h16)(-kn); bbo[e] = (h16)(kn * a[e]); }
            *kp = ko; *ap = bbo; *(h16x4*)(AA + (size_t)row * DM + c) = aao;
            if (first) *(h16x4*)(VF + (size_t)row * DM + c) = *(const h16x4*)(C1 + (size_t)row * LDC1 + 4096 + c);
        }
    }
}

__device__ __forceinline__ void scan_phase(LAS unsigned char* lds, const h16* C1, const h16* DEC, const h16* AA, const h16* BB, float* Y,
                                           const float* sQKV, const float* sWO, const float* sUP, const float* sDN, char* Wn, const float* sUP0, const float* sDN0, char* Wc) {
    constexpr int CH = 32, NCH = SEQ / CH, BUF = 18976;
    LAS float* L = (LAS float*)lds;
    const int tid = otid(), wid = tid >> 6, lane = tid & 63;
    for (int item = obid(); item < 256; item += gridDim.x) {
        const int b = item >> 7, h = (item >> 2) & 31, q = item & 3;
        const size_t row0 = (size_t)b * SEQ;
        __syncthreads();
        if (wid >= 4) {
            const int lt = tid - 256, s = lt >> 3, e8 = lt & 7;
            struct StReg { h16x8 r8, k8, a8, b8, v8, d8; };
            auto gload = [&](int c) -> StReg {
                StReg R;
                const size_t row = row0 + (size_t)c * CH + s;
                R.r8 = *(const h16x8*)(C1 + row * LDC1 + h * 64 + e8 * 8);
                R.k8 = *(const h16x8*)(C1 + row * LDC1 + 2048 + h * 64 + e8 * 8);
                { const int tn = c * CH + s + 1; const size_t rown = row0 + (size_t)(tn < SEQ ? tn : SEQ - 1);
                  R.a8 = *(const h16x8*)(AA + rown * DM + h * 64 + e8 * 8); }
                R.b8 = *(const h16x8*)(BB + row * DM + h * 64 + e8 * 8);
                R.d8 = *(const h16x8*)(DEC + row * DM + h * 64 + e8 * 8);
                R.v8 = (h16x8){};
                if (lt < 64) R.v8 = *(const h16x8*)(C1 + (row0 + (size_t)c * CH + (lt >> 1)) * LDC1 + 4096 + h * 64 + q * 16 + (lt & 1) * 8);
                return R;
            };
            auto lwrite = [&](const StReg& R, int bufi) {
                LAS float* Bf = L + bufi * BUF;
                LAS float* dst = Bf + s * 64 + e8 * 8;
                *(LAS f32x4*)(dst + 0 * 2048) = (f32x4){(float)R.r8[0], (float)R.r8[1], (float)R.r8[2], (float)R.r8[3]}; *(LAS f32x4*)(dst + 0 * 2048 + 4) = (f32x4){(float)R.r8[4], (float)R.r8[5], (float)R.r8[6], (float)R.r8[7]};
                *(LAS f32x4*)(dst + 1 * 2048) = (f32x4){__expf(-(float)R.d8[0]), __expf(-(float)R.d8[1]), __expf(-(float)R.d8[2]), __expf(-(float)R.d8[3])};
                *(LAS f32x4*)(dst + 1 * 2048 + 4) = (f32x4){__expf(-(float)R.d8[4]), __expf(-(float)R.d8[5]), __expf(-(float)R.d8[6]), __expf(-(float)R.d8[7])};
                *(LAS f32x4*)(dst + 2 * 2048) = (f32x4){(float)R.k8[0], (float)R.k8[1], (float)R.k8[2], (float)R.k8[3]}; *(LAS f32x4*)(dst + 2 * 2048 + 4) = (f32x4){(float)R.k8[4], (float)R.k8[5], (float)R.k8[6], (float)R.k8[7]};
                *(LAS f32x4*)(dst + 3 * 2048) = (f32x4){(float)R.a8[0], (float)R.a8[1], (float)R.a8[2], (float)R.a8[3]}; *(LAS f32x4*)(dst + 3 * 2048 + 4) = (f32x4){(float)R.a8[4], (float)R.a8[5], (float)R.a8[6], (float)R.a8[7]};
                *(LAS f32x4*)(dst + 4 * 2048) = (f32x4){(float)R.b8[0], (float)R.b8[1], (float)R.b8[2], (float)R.b8[3]}; *(LAS f32x4*)(dst + 4 * 2048 + 4) = (f32x4){(float)R.b8[4], (float)R.b8[5], (float)R.b8[6], (float)R.b8[7]};
                { float cp = 0.f;
#pragma unroll
                  for (int e = 0; e < 8; ++e) cp += (float)R.b8[e] * (float)R.a8[e];
                  cp += __shfl_xor(cp, 1); cp += __shfl_xor(cp, 2); cp += __shfl_xor(cp, 4);
                  if (e8 == 0) Bf[18944 + s] = cp; }
                if (lt < 64) { LAS float* vd = Bf + 10240 + (lt >> 1) * 16 + (lt & 1) * 8;
                    *(LAS f32x4*)vd = (f32x4){(float)R.v8[0], (float)R.v8[1], (float)R.v8[2], (float)R.v8[3]}; *(LAS f32x4*)(vd + 4) = (f32x4){(float)R.v8[4], (float)R.v8[5], (float)R.v8[6], (float)R.v8[7]}; }
            };
            auto yout = [&](int c, int bufi) {
#pragma unroll
                for (int o2 = 0; o2 < 2; ++o2) {
                    const int o = lt + 256 * o2, ys = o >> 4, yr = o & 15;
                    LAS float* yp = L + bufi * BUF + 10752 + o * 16;
                    f32x4 acc4 = *(LAS f32x4*)(yp + (((0 + (o >> 2)) & 3) << 2));
#pragma unroll
                    for (int i = 1; i < 4; ++i) acc4 += *(LAS f32x4*)(yp + (((i + (o >> 2)) & 3) << 2));
                    Y[(row0 + (size_t)c * CH + ys) * DM + h * 64 + q * 16 + yr] = (acc4[0] + acc4[1]) + (acc4[2] + acc4[3]);
                }
            };
            const int lw = (lt >> 6), wgl = item * 4 + lw;
            LAS h16* ctile = (LAS h16*)(lds + 2 * BUF * 4) + lw * 512;
            f32x4 cv0 = (f32x4){0.f, 0.f, 0.f, 0.f}, cv1 = cv0; h16* cdst = nullptr;
            auto cvt_issue = [&](int tix) {
                constexpr int T0 = 128 * 192, T1 = 128 * 64, T2 = 128 * 344, T3 = 344 * 64;
                cdst = nullptr;
                if (tix >= T0 + T1 + 2 * (T2 + T3)) return;
                const float* src; h16* dst; int Ks, Ns, rm = 0, t = tix;
                if (t >= T0 + T1 + T2 + T3) {
                    t -= T0 + T1 + T2 + T3;
                    if (t < T2) { src = sUP0; dst = (h16*)(Wc + W_UP); Ks = DM; Ns = 2 * FF; rm = 1; }
                    else { t -= T2; src = sDN0; dst = (h16*)(Wc + W_DN); Ks = FF; Ns = DM; }
                }
                else if (t < T0) { src = sQKV; dst = (h16*)(Wn + W_B1); Ks = DM; Ns = 6144; }
                else if (t < T0 + T1) { t -= T0; src = sWO; dst = (h16*)(Wn + W_WO); Ks = DM; Ns = DM; }
                else if (t < T0 + T1 + T2) { t -= T0 + T1; src = sUP; dst = (h16*)(Wn + W_UP); Ks = DM; Ns = 2 * FF; rm = 1; }
                else { t -= T0 + T1 + T2; src = sDN; dst = (h16*)(Wn + W_DN); Ks = FF; Ns = DM; }
                const int tk = Ks >> 4, k0 = (t % tk) * 16, n0 = (t / tk) * 32;
                const int ln = lt & 63, kr = ln >> 3, nc = (ln & 7) * 4;
                cv0 = *(const f32x4*)(src + (size_t)(k0 + kr) * Ns + n0 + nc); cv1 = *(const f32x4*)(src + (size_t)(k0 + kr + 8) * Ns + n0 + nc);
                const int n = ln & 31, hf = ln >> 5, no = n0 + n;
                const int nd = rm == 0 ? no : (no < FF ? (no >> 7) * 256 + (no & 127) : ((no - FF) >> 7) * 256 + 128 + ((no - FF) & 127));
                cdst = dst + (size_t)nd * Ks + k0 + hf * 8;
            };
            auto cvt_finish = [&]() {
                if (cdst == nullptr) return;
                const int ln = lt & 63, kr = ln >> 3, nc = (ln & 7) * 4;
#pragma unroll
                for (int e = 0; e < 4; ++e) { ctile[(nc + e) * 16 + kr] = (h16)cv0[e]; ctile[(nc + e) * 16 + kr + 8] = (h16)cv1[e]; }
                asm volatile("s_waitcnt lgkmcnt(0)" ::: "memory");
                const h16x8 o = *(LAS h16x8*)(ctile + (ln & 31) * 16 + (ln >> 5) * 8);
                *(h16x8*)cdst = o;
                asm volatile("s_waitcnt lgkmcnt(0)" ::: "memory");
            };
            { const StReg R0 = gload(0); lwrite(R0, 0); }
            StReg RA = gload(1);
            __syncthreads();
            for (int c = 0; c < NCH; ++c) {
                StReg RB = RA;
                if (c + 2 < NCH) RB = gload(c + 2);
                if (c + 1 < NCH) lwrite(RA, (c + 1) & 1);
                if (c > 0) yout(c - 1, (c - 1) & 1);
                if (Wn) { cvt_finish(); cvt_issue(wgl + 1024 * c); }
                asm volatile("s_waitcnt lgkmcnt(0)" ::: "memory");
                __builtin_amdgcn_s_barrier();
                asm volatile("" ::: "memory");
                RA = RB;
            }
            yout(NCH - 1, (NCH - 1) & 1);
            if (Wn) cvt_finish();
        } else {
            const int jg = lane & 15, rl = wid * 4 + (lane >> 4);
            f32x2 Sa = (f32x2){0.f, 0.f}, Sb = (f32x2){0.f, 0.f};
            float sa = 0.f;
            __syncthreads();
            for (int c = 0; c < NCH; ++c) {
                LAS float* Bf = L + (c & 1) * BUF;
                LAS float* vec = Bf + jg * 4;
                f32x4 r4 = *(LAS f32x4*)(vec + 0 * 2048), w4 = *(LAS f32x4*)(vec + 1 * 2048), k4 = *(LAS f32x4*)(vec + 2 * 2048), a4 = *(LAS f32x4*)(vec + 3 * 2048), b4 = *(LAS f32x4*)(vec + 4 * 2048);
                float v = Bf[10240 + rl], cn = Bf[18944];
#pragma unroll 1
                for (int s0 = 0; s0 < CH; s0 += 8) {
                    float yv[8];
#pragma unroll
                    for (int u = 0; u < 8; ++u) {
                        const int s = s0 + u, sn = (s + 1 < CH) ? s + 1 : CH - 1;
                        const f32x4 r4n = *(LAS f32x4*)(vec + 0 * 2048 + sn * 64), w4n = *(LAS f32x4*)(vec + 1 * 2048 + sn * 64), k4n = *(LAS f32x4*)(vec + 2 * 2048 + sn * 64),
                                    a4n = *(LAS f32x4*)(vec + 3 * 2048 + sn * 64), b4n = *(LAS f32x4*)(vec + 4 * 2048 + sn * 64);
                        const float vn = Bf[10240 + sn * 16 + rl], cnn = Bf[18944 + sn];
                        const f32x2 aL = {a4[0], a4[1]}, aH = {a4[2], a4[3]}, wL = {w4[0], w4[1]}, wH = {w4[2], w4[3]}, kL = {k4[0], k4[1]}, kH = {k4[2], k4[3]},
                                    bL = {b4[0], b4[1]}, bH = {b4[2], b4[3]}, rL = {r4[0], r4[1]}, rH = {r4[2], r4[3]};
                        const f32x2 uL = Sa * wL + kL * v, uH = Sb * wH + kH * v;
                        const f32x2 dz = uL * aL + uH * aH;
                        const float z = row16_sum(dz[0] + dz[1]);
                        Sa = bL * sa + uL; Sb = bH * sa + uH;
                        const f32x2 dr = Sa * rL + Sb * rH;
                        yv[u] = dr[0] + dr[1];
                        sa = z + cn * sa;
                        r4 = r4n; w4 = w4n; k4 = k4n; a4 = a4n; b4 = b4n; v = vn; cn = cnn;
                    }
#pragma unroll
                    for (int u = 0; u < 8; ++u) Bf[10752 + ((s0 + u) * 16 + rl) * 16 + jg] = yv[u];
                }
                __syncthreads();
            }
        }
    }
}

__device__ __forceinline__ void gn_phase(const float* Y, const h16* C1, const h16* Gb, h16* YG, const float* r_k, const float* lnx_g, const float* lnx_b, h16* VFw) {
    const int lane = otid() & 63, gw = obid() * 8 + (otid() >> 6), GW = gridDim.x * 8;
    for (int row = gw; row < MTOK; row += GW) {
#pragma unroll
        for (int i = 0; i < 8; ++i) {
            const int c = i * 256 + lane * 4;
            const f32x4 y = *(const f32x4*)(Y + (size_t)row * DM + c);
            const h16x4 rh = *(const h16x4*)(C1 + (size_t)row * LDC1 + c), kh = *(const h16x4*)(C1 + (size_t)row * LDC1 + 2048 + c), vh = *(const h16x4*)(C1 + (size_t)row * LDC1 + 4096 + c);
            const h16x4 gh = *(const h16x4*)(Gb + (size_t)row * DM + c);
            const f32x4 rk = *(const f32x4*)(r_k + c), lg = *(const f32x4*)(lnx_g + c), lb = *(const f32x4*)(lnx_b + c);
            float s = (y[0] + y[1]) + (y[2] + y[3]);
            const float mean = grp16_sum(s) * (1.0f / 64.0f);
            const f32x4 d = y - mean;
            float qv = (d[0] * d[0] + d[1] * d[1]) + (d[2] * d[2] + d[3] * d[3]);
            const float rstd = rsqrtf(grp16_sum(qv) * (1.0f / 64.0f) + 64e-5f);
            float bs = 0.f;
#pragma unroll
            for (int e = 0; e < 4; ++e) bs += (float)rh[e] * (float)kh[e] * rk[e];
            bs = grp16_sum(bs);
            h16x4 o;
#pragma unroll
            for (int e = 0; e < 4; ++e) o[e] = (h16)((d[e] * rstd * lg[e] + lb[e] + bs * (float)vh[e]) * (float)gh[e]);
            *(h16x4*)(YG + (size_t)row * DM + c) = o;
            if (VFw) *(h16x4*)(VFw + (size_t)row * DM + c) = vh;
        }
    }
}

__device__ __forceinline__ void convglu_phase(const h16* U, h16* ACT, const float* cw, const float* cb) {
    constexpr int NCG = FF / 8, RC = 16, NT = (MTOK / RC) * NCG;
    for (int task = obid() * 512 + otid(); task < NT; task += gridDim.x * 512) {
        const int cgi = task % NCG, rc = task / NCG, f = cgi * 8, m0 = rc * RC;
        float w0[8], w1[8], w2[8], bb[8], g1[8], g2[8];
#pragma unroll
        for (int e = 0; e < 8; ++e) { w0[e] = cw[f + e]; w1[e] = cw[FF + f + e]; w2[e] = cw[2 * FF + f + e]; bb[e] = cb[f + e]; g1[e] = 0.f; g2[e] = 0.f; }
        if ((m0 & (SEQ - 1)) != 0) {
            const h16x8 a = *(const h16x8*)(U + (size_t)(m0 - 1) * (2 * FF) + FF + f), c2 = *(const h16x8*)(U + (size_t)(m0 - 2) * (2 * FF) + FF + f);
#pragma unroll
            for (int e = 0; e < 8; ++e) { g1[e] = (float)a[e]; g2[e] = (float)c2[e]; }
        }
        for (int r = 0; r < RC; ++r) {
            const size_t m = (size_t)(m0 + r);
            const h16x8 uh = *(const h16x8*)(U + m * (2 * FF) + f), gh = *(const h16x8*)(U + m * (2 * FF) + FF + f);
            h16x8 o;
#pragma unroll
            for (int e = 0; e < 8; ++e) {
                const float g0 = (float)gh[e];
                const float gc = bb[e] + g2[e] * w0[e] + g1[e] * w1[e] + g0 * w2[e];
                const float z = 1.5957691216057308f * (gc + 0.044715f * gc * gc * gc);
                const float ge = gc / (1.0f + __expf(-z));
                o[e] = (h16)((float)uh[e] * ge);
                g2[e] = g1[e]; g1[e] = g0;
            }
            *(h16x8*)(ACT + m * FF + f) = o;
        }
    }
}

__device__ __forceinline__ void attn_phase(LAS unsigned char* lds, const h16* Qb, const h16* Kb, const h16* Vt, h16* AO, const float* rel_bias, const float* lam, const float* subg, float lambda_init) {
    constexpr int STG = 65536;
    const int wid = __builtin_amdgcn_readfirstlane(otid() >> 6), rg = wid & 3, mp = wid >> 2;
    LAS float* lut = (LAS float*)(lds + 2 * STG);
    LAS float* osh = (LAS float*)lds;
    for (int vc = obid(); vc < 256; vc += gridDim.x) {
        const int bh = vc & 15, jj = vc >> 4, b = bh >> 3, h = bh & 7;
        for (int it = 0; it < 4; ++it) {
            const int qb = it == 0 ? 63 - jj : (it == 1 ? 32 + jj : (it == 2 ? 31 - jj : jj));
            __syncthreads();
            const int tid = otid(), lane = tid & 63, l32 = lane & 31, hh = lane >> 5;
            const int kkey = wid * 2 + (lane >> 5);
            const int kseg = (lane & 31) ^ (kkey & 15);
            const int vdv = wid * 8 + (lane >> 3);
            const int vseg = (lane & 7) ^ ((vdv >> 1) & 7);
            const int xk = l32 & 15, yv = (l32 >> 1) & 7;
            if (tid <= 128) {
                const float* rbp_ = rel_bias; asm volatile("" : "+s"(rbp_)); const GAS float* rbp = (const GAS float*)rbp_;
                float val = 0.f;
                if (tid < 128) { int bk = tid; if (tid >= 16) { bk = 16 + (int)(__logf((float)tid * (1.0f / 16.0f)) / 2.0794415416798357f * 16.0f); bk = bk > 31 ? 31 : bk; }
                    val = (rbp[bk * 8 + h] - rbp[31 * 8 + h]) * LOG2E; }
                lut[tid] = val;
            }
            const int q0 = qb * 128, qrow = q0 + 32 * rg + l32;
            const size_t tokbase = (size_t)b * SEQ;
            h16x8 Qf[8];
            { const h16* qp = Qb + (tokbase + qrow) * DM + h * 256 + mp * 128 + hh * 8;
#pragma unroll
              for (int ks = 0; ks < 8; ++ks) Qf[ks] = *(const h16x8*)(qp + ks * 16); }
            f32x16 O[8];
#pragma unroll
            for (int i = 0; i < 8; ++i)
#pragma unroll
                for (int r = 0; r < 16; ++r) O[i][r] = 0.f;
            float mrun = -1e30f, lrun = 0.f;
            const int nkt = 2 * qb + 2;
            const h16* kg = Kb + (tokbase + kkey) * DM + h * 256 + kseg * 8;
            const h16* vg = Vt + ((size_t)((b * 8 + h) * 256) + vdv) * SEQ + vseg * 8;
#define ATT_ISSUE(KT, BUF) do { _Pragma("unroll") for (int _i = 0; _i < 4; ++_i) \
                __builtin_amdgcn_global_load_lds((const unsigned*)(kg + (size_t)(64 * (KT) + 16 * _i) * DM), (LAS unsigned*)((BUF) + (_i * 8 + wid) * 1024), 16, 0, 0); \
              _Pragma("unroll") for (int _i = 0; _i < 4; ++_i) \
                __builtin_amdgcn_global_load_lds((const unsigned*)(vg + (size_t)(64 * _i) * SEQ + 64 * (KT)), (LAS unsigned*)((BUF) + 32768 + (_i * 8 + wid) * 1024), 16, 0, 0); } while (0)
            ATT_ISSUE(0, lds);
            asm volatile("s_waitcnt vmcnt(0)" ::: "memory");
            __syncthreads();
            for (int kt = 0; kt < nkt; ++kt) {
                LAS unsigned char* cb = lds + (kt & 1) * STG; LAS unsigned char* nb = lds + ((kt & 1) ^ 1) * STG;
                const bool near = kt >= 2 * qb - 2;
                if (kt + 1 < nkt) ATT_ISSUE(kt + 1, nb);
#pragma unroll
                for (int kb = 0; kb < 2; ++kb) {
                    if (64 * kt + 32 * kb <= q0 + 32 * rg + 31) {
                        f32x16 S0;
#pragma unroll
                        for (int r = 0; r < 16; ++r) S0[r] = 0.f;
                        LAS unsigned char* ks = cb + (32 * kb + l32) * 512 + mp * 256;
#pragma unroll
                        for (int k = 0; k < 8; ++k) {
                            const h16x8 a0 = *(LAS h16x8*)(ks + (((2 * k + hh) ^ xk) << 4));
                            S0 = __builtin_amdgcn_mfma_f32_32x32x16_f16(a0, Qf[k], S0, 0, 0, 0);
                        }
                        if (near) {
#pragma unroll
                            for (int r = 0; r < 16; ++r) {
                                const int kp = 64 * kt + 32 * kb + (r >> 2) * 8 + hh * 4 + (r & 3); const int d0 = qrow - kp;
                                const int di = d0 < 0 ? 0 : (d0 > 128 ? 128 : d0); const float bv = lut[di];
                                S0[r] = d0 < 0 ? -1e30f : S0[r] + bv;
                            }
                        }
                        float mt = S0[0];
#pragma unroll
                        for (int r = 1; r < 16; ++r) mt = fmaxf(mt, S0[r]);
                        if (__builtin_amdgcn_ballot_w64(mt - mrun > 10.0f) != 0ull) {
                            const float mo = fmaxf(mt, __shfl_xor(mt, 32));
                            const float mn = fmaxf(mrun, mo);
                            const float al = __builtin_amdgcn_exp2f(mrun - mn);
                            mrun = mn; lrun *= al;
#pragma unroll
                            for (int i = 0; i < 8; ++i) O[i] = O[i] * al;
                        }
                        float ps = 0.f;
#pragma unroll
                        for (int r = 0; r < 16; ++r) { S0[r] = __builtin_amdgcn_exp2f(S0[r] - mrun); ps += S0[r]; }
                        lrun += ps;
                        h16x8 P0, P1;
#pragma unroll
                        for (int e = 0; e < 8; ++e) { P0[e] = (h16)S0[e]; P1[e] = (h16)S0[8 + e]; }
                        LAS unsigned char* vs = cb + 32768 + l32 * 128;
                        const int vo0 = ((4 * kb + hh) ^ yv) << 4, vo1 = ((4 * kb + 2 + hh) ^ yv) << 4;
#pragma unroll
                        for (int dvb = 0; dvb < 8; ++dvb) {
                            const h16x8 a = *(LAS h16x8*)(vs + dvb * 4096 + vo0);
                            O[dvb] = __builtin_amdgcn_mfma_f32_32x32x16_f16(a, P0, O[dvb], 0, 0, 0);
                        }
#pragma unroll
                        for (int dvb = 0; dvb < 8; ++dvb) {
                            const h16x8 a = *(LAS h16x8*)(vs + dvb * 4096 + vo1);
                            O[dvb] = __builtin_amdgcn_mfma_f32_32x32x16_f16(a, P1, O[dvb], 0, 0, 0);
                        }
                    }
                }
                asm volatile("s_waitcnt vmcnt(0)" ::: "memory");
                __syncthreads();
            }
#undef ATT_ISSUE
            lrun += __shfl_xor(lrun, 32);
            const float inv = 1.0f / lrun;
            const int lane2 = otid() & 63, l32b = lane2 & 31, hhb = lane2 >> 5;
            const int obase = (rg * 8) * 16 * 64 + lane2;
            if (mp == 1) {
                float lf;
                { const float* lmp_ = lam; asm volatile("" : "+s"(lmp_)); const GAS float* lmp = (const GAS float*)lmp_;
                  float s1 = 0.f, s2 = 0.f; for (int i = lane2; i < 128; i += 64) { s1 += lmp[i] * lmp[128 + i]; s2 += lmp[256 + i] * lmp[384 + i]; }
                  s1 = wave_sum(s1); s2 = wave_sum(s2); lf = __expf(s1) - __expf(s2) + lambda_init; }
                const float sc = inv * lf;
#pragma unroll
                for (int dvb = 0; dvb < 8; ++dvb)
#pragma unroll
                    for (int r = 0; r < 16; ++r) osh[obase + (dvb * 16 + r) * 64] = O[dvb][r] * sc;
            }
            __syncthreads();
            if (mp == 0) {
                const float* sgp_ = subg; asm volatile("" : "+s"(sgp_)); const GAS float* sgp = (const GAS float*)sgp_;
                float ss = 0.f;
#pragma unroll
                for (int dvb = 0; dvb < 8; ++dvb)
#pragma unroll
                    for (int r = 0; r < 16; ++r) { const float o = O[dvb][r] * inv - osh[obase + (dvb * 16 + r) * 64]; O[dvb][r] = o; ss += o * o; }
                ss += __shfl_xor(ss, 32);
                const float rms = rsqrtf(ss * (1.0f / 256.0f) + 1e-5f) * (1.0f - lambda_init);
                h16* op = AO + ((size_t)b * SEQ + q0 + 32 * rg + l32b) * DM + h * 256 + hhb * 4;
#pragma unroll
                for (int dvb = 0; dvb < 8; ++dvb)
#pragma unroll
                    for (int rq = 0; rq < 4; ++rq) {
                        const int dv0 = dvb * 32 + rq * 8;
                        const f32x4 sg = *(const GAS f32x4*)(sgp + dv0 + hhb * 4);
                        h16x4 o = {(h16)(O[dvb][rq * 4 + 0] * rms * sg[0]), (h16)(O[dvb][rq * 4 + 1] * rms * sg[1]), (h16)(O[dvb][rq * 4 + 2] * rms * sg[2]), (h16)(O[dvb][rq * 4 + 3] * rms * sg[3])};
                        *(h16x4*)(op + dv0) = o;
                    }
            }
        }
    }
}

#define XB_TMO      128
#define XB_XCNT(j)  (256  + 64 * (j))
#define XB_XSUB(j)  (1280 + 64 * (j))
#define XB_XGEN(j)  (2304 + 64 * (j))
#define XB_TOP      3328
#define XB_TOPGEN   3392
#define XCD_BAR_WORDS 3456
#define XB_SPIN_CAP (1u << 18)

__device__ __forceinline__ unsigned xb_ld(unsigned* p)              { return __hip_atomic_load(p, __ATOMIC_RELAXED, __HIP_MEMORY_SCOPE_AGENT); }
__device__ __forceinline__ unsigned xb_add(unsigned* p, unsigned v) { return __hip_atomic_fetch_add(p, v, __ATOMIC_RELAXED, __HIP_MEMORY_SCOPE_AGENT); }
__device__ __forceinline__ unsigned xb_xcc_id() { return (unsigned)__builtin_amdgcn_s_getreg((3 << 11) | 20) & 0xFu; }
#define XB_SPIN(cond, bar) do { unsigned _sp = 0; while (cond) { __builtin_amdgcn_s_sleep(1); \
    if ((++_sp & 255u) == 0u) { if (xb_ld(&(bar)[XB_TMO])) break; if (_sp > XB_SPIN_CAP) { atomicAdd(&(bar)[XB_TMO], 1u); break; } } } } while (0)

struct XcdBarrier {
    unsigned* bar; unsigned x;
    volatile LAS unsigned* st;
};

__device__ __forceinline__ XcdBarrier xcd_barrier_post(unsigned* bar, volatile LAS unsigned* st) {
    XcdBarrier b; b.bar = bar; b.x = xb_xcc_id(); b.st = st;
    if (threadIdx.x == 0) (void)xb_add(&bar[XB_XCNT(b.x)], 1u);
    return b;
}
__device__ __forceinline__ void xcd_barrier_complete(unsigned* bar, unsigned x, unsigned& nloc, unsigned& nx) {
    const unsigned G = gridDim.x * gridDim.y * gridDim.z;
    unsigned sum, cnt, mine, sp = 0u;
    for (;;) {
        sum = 0u; cnt = 0u; mine = 0u;
#pragma unroll
        for (unsigned j = 0; j < 16; ++j) { const unsigned c = xb_ld(&bar[XB_XCNT(j)]); sum += c; cnt += (c > 0u) ? 1u : 0u; mine = (j == x) ? c : mine; }
        if (sum == G) break;
        __builtin_amdgcn_s_sleep(1);
        if ((++sp & 255u) == 0u) { if (xb_ld(&bar[XB_TMO])) break; if (sp > XB_SPIN_CAP) { atomicAdd(&bar[XB_TMO], 1u); break; } }
    }
    nloc = mine > 0u ? mine : 1u; nx = cnt > 0u ? cnt : 1u;
}

__device__ __forceinline__ void xcd_barrier(const XcdBarrier& b) {
    asm volatile("s_waitcnt vmcnt(0)" ::: "memory");
    __syncthreads();
    if (threadIdx.x == 0) {
        unsigned* bar = b.bar;
        __builtin_amdgcn_s_waitcnt(0);
        unsigned nloc = b.st[0], nx = b.st[1];
        if (nloc == 0u) { xcd_barrier_complete(bar, b.x, nloc, nx); b.st[0] = nloc; b.st[1] = nx; }
        const unsigned old = xb_add(&bar[XB_XSUB(b.x)], 1u);
        const unsigned gen = old / nloc;
        if (old + 1u == (gen + 1u) * nloc) {
            __builtin_amdgcn_fence(__ATOMIC_RELEASE, "agent");
            asm volatile("s_waitcnt vmcnt(0)" ::: "memory");
            const unsigned og = xb_add(&bar[XB_TOP], 1u);
            const unsigned tg = og / nx;
            if (og + 1u == (tg + 1u) * nx) xb_add(&bar[XB_TOPGEN], 1u);
            else XB_SPIN(xb_ld(&bar[XB_TOPGEN]) == tg, bar);
            __builtin_amdgcn_fence(__ATOMIC_ACQUIRE, "agent");
            xb_add(&bar[XB_XGEN(b.x)], 1u);
            asm volatile("s_waitcnt vmcnt(0)" ::: "memory");
        } else {
            XB_SPIN(xb_ld(&bar[XB_XGEN(b.x)]) == gen, bar);
            __builtin_amdgcn_fence(__ATOMIC_ACQUIRE, "agent");
            asm volatile("s_waitcnt vmcnt(0)" ::: "memory");
        }
    }
    __syncthreads();
}


__device__ __forceinline__ void gbar(unsigned* ctr, unsigned target) {
    asm volatile("s_waitcnt vmcnt(0)" ::: "memory");
    __syncthreads();
    if (threadIdx.x == 0) {
        __builtin_amdgcn_fence(__ATOMIC_RELEASE, "agent");
        asm volatile("s_waitcnt vmcnt(0)" ::: "memory");
        __hip_atomic_fetch_add(ctr, 1u, __ATOMIC_RELAXED, __HIP_MEMORY_SCOPE_AGENT);
        while (__hip_atomic_load(ctr, __ATOMIC_RELAXED, __HIP_MEMORY_SCOPE_AGENT) < target) __builtin_amdgcn_s_sleep(1);
        __builtin_amdgcn_fence(__ATOMIC_ACQUIRE, "agent");
        asm volatile("s_waitcnt vmcnt(0)" ::: "memory");
    }
    __syncthreads();
}

#ifndef ONLY_GI
#define ENG(k) true
#else
#define ENG(k) ((k) == ONLY_GI)
#endif
#ifndef ONLY_KIND
#define EN(k) true
#else
#define EN(k) ((k) == ONLY_KIND)
#endif
__global__ void __launch_bounds__(512, 2) fwd_megakernel(Params p) {
    extern __shared__ __attribute__((aligned(16))) unsigned char shm[];
    LAS unsigned char* lds = (LAS unsigned char*)shm;
    cg::grid_group grid = cg::this_grid();
    unsigned char* ws = p.ws;
    h16* PRE = (h16*)(ws + WS_PRE); h16* XH = (h16*)(ws + WS_XH); h16* VF = (h16*)(ws + WS_VF);
    unsigned char* R1 = ws + WS_R1; unsigned char* R2 = ws + WS_R2; float* Y = (float*)(ws + WS_Y);
    h16* MIX = (h16*)R1; h16* SIDE = (h16*)R1; h16* AO = (h16*)R1;
    h16* DEC = (h16*)(R1 + R1_DEC); h16* Ab = (h16*)(R1 + R1_A); h16* Gb = (h16*)(R1 + R1_G); h16* AA = (h16*)(R1 + R1_AA); h16* YG = (h16*)(R1 + R1_YG);
    h16* C1 = (h16*)R2; h16* ACT = (h16*)R2; h16* Qb = (h16*)R2; h16* Kb = Qb + (size_t)MTOK * DM; h16* Vt = Kb + (size_t)MTOK * DM;

    volatile LAS unsigned* xst = (volatile LAS unsigned*)(lds + LDS_BYTES - 16);
    if (threadIdx.x == 0) { xst[0] = 0u; xst[1] = 0u; }
    __syncthreads();
    const XcdBarrier xb = xcd_barrier_post((unsigned*)(ws + WS_BAR), xst);
    for (int ph = p.ph_lo; ph < p.ph_hi; ++ph) {
        int layer, kind;
        if (ph < 11) { layer = 0; kind = (int)((0xDCBA9854210ull >> (4 * ph)) & 15ull); }
        else if (ph < 19) { layer = 1; kind = (int)((0xDCBA9876ull >> (4 * (ph - 11))) & 15ull); }
        else if (ph < 29) { layer = 2; kind = (int)((0xDCBA985421ull >> (4 * (ph - 19))) & 15ull); }
        else { layer = 3; kind = (int)((0xDCBA9876ull >> (4 * (ph - 29))) & 15ull); }
        const int j = layer >> 1;
        const char* W = (const char*)(ws + ((layer & 1) ? WS_X : WS_W16));
        const h16* wB1 = (const h16*)(W + W_B1); const h16* wB2 = (const h16*)(W + W_B2); const h16* wWO = (const h16*)(W + W_WO);
        const h16* wUP = (const h16*)(W + W_UP); const h16* wDN = (const h16*)(W + W_DN);
        const int nrep = ((PROBE_MASK >> kind) & 1) ? 2 : 1;
        for (int rep = 0; rep < nrep; ++rep)
        switch (kind) {
        case 0: if (EN(0)) {
            cvt_layer(lds, p, 0);
            ln_phase<false>(p.in[0], nullptr, nullptr, nullptr, XH, p.in[3], MIX);
        } break;
        case 1: if (EN(1)) {
            AMapMix am{(const char*)MIX}; EpiG1 e{C1, j == 0 ? VF : nullptr};
            pg8::gemm_phase(lds, am, DM, wB1, DM, MTOK, j == 0 ? 6912 : 7168, DM, e);
        } break;
        case 2: if (EN(2)) {
            const float* w0 = p.in[5] + (size_t)j * DM; const float* a0 = p.in[8] + (size_t)j * DM; const float* v0 = p.in[11] + (size_t)(j > 0 ? j - 1 : 0) * DM;
            int k2 = 256; asm volatile("" : "+s"(k2));
            if (ENG(0)) { AMapOne am{(const char*)(C1 + 6144)}; EpiG2<0> e{DEC, Ab, Gb, C1, VF, w0, a0, v0, AA, p.in[16] + (size_t)j * DM, p.in[17] + (size_t)j * DM}; pg8::gemm_phase(lds, am, LDC1, wB2, 256, MTOK, DM, k2, e); }
            if (ENG(1)) { AMapOne am{(const char*)(C1 + 6400)}; EpiG2<1> e{DEC, Ab, Gb, C1, VF, w0, a0, v0, AA, p.in[16] + (size_t)j * DM, p.in[17] + (size_t)j * DM}; pg8::gemm_phase(lds, am, LDC1, wB2 + (size_t)2048 * 256, 256, MTOK, DM, k2, e); }
            if (ENG(2)) { AMapOne am{(const char*)(C1 + 6656)}; EpiG2<2> e{DEC, Ab, Gb, C1, VF, w0, a0, v0, AA, p.in[16] + (size_t)j * DM, p.in[17] + (size_t)j * DM}; pg8::gemm_phase(lds, am, LDC1, wB2 + (size_t)4096 * 256, 256, MTOK, DM, k2, e); }
            if (ENG(3) && j > 0) { AMapOne am{(const char*)(C1 + 6912)}; EpiG2<3> e{DEC, Ab, Gb, C1, VF, w0, a0, v0, AA, p.in[16] + (size_t)j * DM, p.in[17] + (size_t)j * DM}; pg8::gemm_phase(lds, am, LDC1, wB2 + (size_t)6144 * 256, 256, MTOK, DM, k2, e); }
        } break;
        case 3: if (EN(3)) prep_phase(C1, Ab, AA, VF, p.in[16] + (size_t)j * DM, p.in[17] + (size_t)j * DM, j == 0); break;
        case 4: if (EN(4)) scan_phase(lds, C1, DEC, AA, Ab, Y, p.in[22] + (size_t)j * DM * 6144, p.in[25] + (size_t)j * DM * DM, p.in[27] + (size_t)(layer + 1) * DM * 2 * FF, p.in[30] + (size_t)(layer + 1) * FF * DM, (char*)(ws + WS_X),
                                       p.in[27] + (size_t)layer * DM * 2 * FF, p.in[30] + (size_t)layer * FF * DM, (char*)(ws + WS_W16)); break;
        case 5: if (EN(5)) gn_phase(Y, C1, Gb, YG, p.in[18] + (size_t)j * DM, p.in[19] + (size_t)j * DM, p.in[20] + (size_t)j * DM, nullptr); break;
        case 6: if (EN(6)) {
            AMapOne am{(const char*)XH}; EpiQKV e{Qb, Kb, Vt};
            pg8::gemm_phase(lds, am, DM, wB1, DM, MTOK, 6144, DM, e);
        } break;
        case 7: if (EN(7)) {
            const float li = layer == 1 ? 0.35550906759096926f : 0.5560581861995943f;
            attn_phase(lds, Qb, Kb, Vt, AO, p.in[26], p.in[23] + (size_t)j * 512, p.in[24] + (size_t)j * 256, li);
        } break;
        case 8: if (EN(8)) {
            AMapOne am{(const char*)((layer & 1) ? AO : YG)}; EpiRes e{XH, PRE};
            pg8::gemm_phase(lds, am, DM, wWO, DM, MTOK, DM, DM, e);
        } break;
        case 9: case 13: if (EN(9)) {
            const int sub = kind == 9 ? 0 : 1;
            const float* g = p.in[1] + (size_t)(layer * 2 + sub) * DM; const float* bt = p.in[2] + (size_t)(layer * 2 + sub) * DM;
            float* xo = nullptr; h16* xh = XH; const float* mu = nullptr; h16* mx = nullptr;
            if (kind == 13) {
                if (layer == 3) { xo = p.out; xh = nullptr; }
                else {
                    if (layer == 1) cvt_layer(lds, p, layer + 1);
                    if (layer == 1) { mu = p.in[3] + (size_t)1 * 6 * DM; mx = MIX; }
                }
            }
            ln_phase<true>(PRE, g, bt, xo, xh, mu, mx);
        } break;
        case 10: if (EN(10)) {
            AMapOne am{(const char*)XH}; EpiUpConv e{ACT, SIDE, p.in[28] + (size_t)layer * 3 * FF, p.in[29] + (size_t)layer * FF};
            pg8::gemm_phase(lds, am, DM, wUP, DM, MTOK, 2 * FF, DM, e);
        } break;
        case 11: if (EN(11)) convfix_phase(SIDE, ACT, p.in[28] + (size_t)layer * 3 * FF, p.in[29] + (size_t)layer * FF); break;
        case 12: if (EN(12)) {
            AMapOne am{(const char*)ACT}; EpiRes e{XH, PRE};
            pg8::gemm_phase(lds, am, FF, wDN, FF, MTOK, DM, FF, e);
        } break;
        }
        if (ph + 1 < p.ph_hi) {
            if (p.ph_lo < 0) grid.sync();
            else xcd_barrier(xb);
        }
    }
}

constexpr int NPHASES = 37;

extern "C" void kernel_launch(void* const* d_in, const int* in_sizes, int n_in, void* d_out, int out_size, void* d_ws, size_t ws_size, hipStream_t stream) {
    static int grid_blocks = 0;
    if (!grid_blocks) {
        if (n_in != 31 || ws_size < WS_END) { fprintf(stderr, "kernel_launch: unexpected n_in %d / ws_size %zu (need %zu)\n", n_in, ws_size, (size_t)WS_END); grid_blocks = -1; return; }
        int dev = 0, cus = 0, per_cu = 0;
        hipGetDevice(&dev);
        hipDeviceGetAttribute(&cus, hipDeviceAttributeMultiprocessorCount, dev);
        if (hipFuncSetAttribute((const void*)fwd_megakernel, hipFuncAttributeMaxDynamicSharedMemorySize, LDS_BYTES) != hipSuccess) { fprintf(stderr, "kernel_launch: hipFuncSetAttribute failed\n"); grid_blocks = -1; return; }
        if (hipOccupancyMaxActiveBlocksPerMultiprocessor(&per_cu, (const void*)fwd_megakernel, 512, LDS_BYTES) != hipSuccess || per_cu < 1) { fprintf(stderr, "kernel_launch: occupancy query gave %d\n", per_cu); per_cu = 1; (void)hipGetLastError(); }
        grid_blocks = cus * per_cu;
        if (grid_blocks > 256) grid_blocks = 256;
    }
    if (grid_blocks < 0) return;
    Params p{};
    for (int i = 0; i < 31; ++i) p.in[i] = (const float*)d_in[i];
    p.out = (float*)d_out; p.ws = (unsigned char*)d_ws; p.ph_lo = 0; p.ph_hi = NPHASES;
    if (hipMemsetAsync((char*)d_ws + WS_BAR, 0, 16384, stream) != hipSuccess) { fprintf(stderr, "kernel_launch: memset failed\n"); return; }
    void* args[] = {&p};
    hipError_t e = hipLaunchCooperativeKernel((const void*)fwd_megakernel, dim3(grid_blocks), dim3(512), args, LDS_BYTES, stream);
    if (e != hipSuccess) fprintf(stderr, "cooperative launch failed: %s (grid %d)\n", hipGetErrorString(e), grid_blocks);
}
```

```cpp
#include <hip/hip_runtime.h>
#include <hip/hip_cooperative_groups.h>
#include <cstdio>
namespace cg = cooperative_groups;

#define LAS __attribute__((address_space(3)))
#define GAS __attribute__((address_space(1)))
typedef _Float16 h16;
typedef _Float16 h16x8 __attribute__((ext_vector_type(8)));
typedef _Float16 h16x4 __attribute__((ext_vector_type(4)));
typedef float f32x4 __attribute__((ext_vector_type(4)));
typedef float f32x2 __attribute__((ext_vector_type(2)));
typedef float f32x16 __attribute__((ext_vector_type(16)));
typedef unsigned u32x4 __attribute__((ext_vector_type(4)));

constexpr int MTOK = 16384, DM = 2048, SEQ = 8192, FF = 5504, LDC1 = 7168;
constexpr float ALPHA = 1.681792830507429f;
constexpr float LOG2E = 1.4426950408889634f;
constexpr float QSCALE = 0.08838834764831845f * LOG2E;
constexpr int LDS_BYTES = 157696;
#define PROBE_MASK 0x0000

constexpr size_t W_B1 = 0, W_B2 = 29360128, W_WO = 33554432, W_UP = 41943040, W_DN = 87031808;
constexpr size_t WS_W16 = 0, WS_X = 117440512, WS_PRE = WS_X + 134217728, WS_XH = WS_PRE + 134217728, WS_VF = WS_XH + 67108864,
                 WS_R1 = WS_VF + 67108864, WS_R2 = WS_R1 + 402653184, WS_Y = WS_R2 + 234881024, WS_BAR = WS_Y + 134217728, WS_END = WS_BAR + 16384;
constexpr size_t R1_DEC = 0, R1_A = 134217728, R1_G = R1_A + 67108864, R1_AA = R1_G + 67108864, R1_YG = R1_AA + 67108864;

struct Params {
    const float* in[31];
    float* out;
    unsigned char* ws;
    int ph_lo, ph_hi;
};

__device__ __forceinline__ int otid() { int t = (int)threadIdx.x; asm volatile("" : "+v"(t)); return t; }
__device__ __forceinline__ int obid() { int t = (int)blockIdx.x; asm volatile("" : "+s"(t)); return t; }
template <int CTRL> __device__ __forceinline__ float dpp_f(float x) { return __int_as_float(__builtin_amdgcn_update_dpp(0, __float_as_int(x), CTRL, 0xF, 0xF, true)); }
__device__ __forceinline__ float row16_sum(float x) { x += dpp_f<0xB1>(x); x += dpp_f<0x4E>(x); x += dpp_f<0x141>(x); x += dpp_f<0x140>(x); return x; }
__device__ __forceinline__ float grp16_sum(float x) { return row16_sum(x); }
__device__ __forceinline__ float wave_sum(float x) { x = row16_sum(x); x += __shfl_xor(x, 16); x += __shfl_xor(x, 32); return x; }
__device__ __forceinline__ float sigmoidf_(float x) { return 1.0f / (1.0f + __expf(-x)); }

namespace pg8 {
constexpr int BM = 256, BK = 64, HALF = 128, HTB = HALF * BK * 2, NXCD = 8, WGM = 4;
__device__ __forceinline__ int lds_byte(int r, int c) { const int st = (r >> 4) * 2 + (c >> 5), rr = r & 15, cc = c & 31, ob = rr * 64 + cc * 2; return st * 1024 + (ob ^ (((ob >> 9) & 1) << 5)); }
__device__ __forceinline__ void stage_rc(int b, int& R, int& C) { const int st = b / 1024, sb = b % 1024, swz = sb ^ (((sb >> 9) & 1) << 5); R = (st >> 1) * 16 + swz / 64; C = (st & 1) * 32 + (swz % 64) / 2; }
__device__ __forceinline__ int perm32(int rho) { const int n = rho >> 4, i = rho & 15; return 8 * (i >> 2) + 4 * n + (i & 3); }
struct Unit { int pm, pn; };
struct Order {
    int nM, nN, nwg, G, c;
    __device__ void init(int M, int N, int G_, int c_) { nM = M / BM; nN = N / BM; nwg = nM * nN; G = G_; c = c_; }
    __device__ bool next(int i, Unit& u) const {
        const long L = (long)i * G + c; if (L >= nwg) return false;
        int wgid = (int)L; { const int q = nwg / NXCD, r = nwg % NXCD, xcd = wgid % NXCD, off = wgid / NXCD; wgid = (xcd < r ? xcd * (q + 1) : r * (q + 1) + (xcd - r) * q) + off; }
        const int nig = WGM * nN, gid = wgid / nig, fm = gid * WGM, gsz = (nM - fm) < WGM ? (nM - fm) : WGM;
        u.pm = fm + ((wgid % nig) % gsz); u.pn = (wgid % nig) / gsz; return true;
    }
};

template <class Epi, class AMap>
__device__ __forceinline__ void gemm_phase(LAS unsigned char* lds, const AMap am, const int lda, const h16* Bt, const int ldb, const int M, const int N, const int K, const Epi& E) {
    const int tid = otid(), wid = __builtin_amdgcn_readfirstlane(tid >> 6), lane = tid & 63, wr = wid >> 2, wc = wid & 3, fr = lane & 15, fq = lane >> 4;
    const int nt = K / BK;
    Order S; S.init(M, N, (int)gridDim.x, obid());
    unsigned voffA[2], voffB[2];
#pragma unroll
    for (int i = 0; i < 2; ++i) { int R, C; stage_rc(tid * 16 + i * 8192, R, C); const int Rb = Epi::PERM ? ((R & ~31) + perm32(R & 31)) : R;
        voffA[i] = (unsigned)(R * lda + C) * 2u; voffB[i] = (unsigned)(Rb * ldb + C) * 2u; }
    const size_t kstep = (size_t)(BK * 2);
    const size_t hstepA = (size_t)HALF * lda * 2, hstepB = (size_t)HALF * ldb * 2;
    const size_t tstepA = 2 * hstepA, tstepB = 2 * hstepB;
    const unsigned ldsw = (unsigned)wid * 1024u;
    const int aoff = lds_byte(wr * 64 + fr, fq * 8), boff = lds_byte(wc * 32 + fr, fq * 8);
#define PG8_SA(b, h) (((b) * 2 + (h)) * HTB)
#define PG8_SB(b, h) ((4 + (b) * 2 + (h)) * HTB)
#define PG8_STAGE(bufoff, gbase, voff) do { _Pragma("unroll") for (int _i = 0; _i < 2; ++_i) \
        __builtin_amdgcn_global_load_lds((const unsigned*)((const char*)(gbase) + (voff)[_i]), (LAS unsigned*)(lds + (bufoff) + ldsw + _i * 8192), 16, 0, 0); } while (0)
#define PG8_LDA(dst, b, h) do { _Pragma("unroll") for (int m = 0; m < 4; ++m) _Pragma("unroll") for (int k = 0; k < 2; ++k) dst[m][k] = *(const LAS h16x8*)(lds + PG8_SA(b, h) + aoff + m * 2048 + k * 1024); } while (0)
#define PG8_LDB(dst, b, h) do { _Pragma("unroll") for (int n = 0; n < 2; ++n) _Pragma("unroll") for (int k = 0; k < 2; ++k) dst[n][k] = *(const LAS h16x8*)(lds + PG8_SB(b, h) + boff + n * 2048 + k * 1024); } while (0)
#define PG8_MMA(ai, bj, At, Bt_) do { __builtin_amdgcn_s_setprio(1); _Pragma("unroll") for (int m = 0; m < 4; ++m) _Pragma("unroll") for (int n = 0; n < 2; ++n) _Pragma("unroll") for (int k = 0; k < 2; ++k) \
        acc[ai][bj][m][n] = __builtin_amdgcn_mfma_f32_16x16x32_f16(Bt_[n][k], At[m][k], acc[ai][bj][m][n], 0, 0, 0); __builtin_amdgcn_s_setprio(0); } while (0)
#define PG8_WAIT_V(n) asm volatile("s_waitcnt vmcnt(" #n ")" ::: "memory")
#define PG8_WAIT_L(n) asm volatile("s_waitcnt lgkmcnt(" #n ")" ::: "memory")
#define PG8_BAR __builtin_amdgcn_s_barrier()
#define PG8_SCHED __builtin_amdgcn_sched_barrier(0)
    Unit cur, nxt; int ui = 0;
    if (!S.next(0, cur)) return;
    f32x4 acc[2][2][4][2];
#pragma unroll
    for (int a = 0; a < 2; ++a)
#pragma unroll
        for (int b = 0; b < 2; ++b)
#pragma unroll
            for (int m = 0; m < 4; ++m)
#pragma unroll
                for (int n = 0; n < 2; ++n) acc[a][b][m][n] = (f32x4){0.f, 0.f, 0.f, 0.f};
    h16x8 At[4][2], B0[2][2], B1[2][2];
    const char* cA = am(cur.pn) + (size_t)cur.pm * tstepA; const char* cB = (const char*)Bt + (size_t)cur.pn * tstepB;
    PG8_STAGE(PG8_SB(0, 0), cB, voffB); PG8_STAGE(PG8_SA(0, 0), cA, voffA); PG8_STAGE(PG8_SB(0, 1), cB + hstepB, voffB); PG8_STAGE(PG8_SA(0, 1), cA + hstepA, voffA);
    if (wr == 1) PG8_BAR;
    PG8_WAIT_V(4); PG8_BAR;
    PG8_STAGE(PG8_SB(1, 0), cB + kstep, voffB); PG8_STAGE(PG8_SA(1, 0), cA + kstep, voffA); PG8_STAGE(PG8_SB(1, 1), cB + hstepB + kstep, voffB);
    PG8_WAIT_V(6); PG8_BAR;
    for (;;) {
        const bool has_next = S.next(ui + 1, nxt);
        const char* nA = has_next ? am(nxt.pn) + (size_t)nxt.pm * tstepA : cA; const char* nB = has_next ? (const char*)Bt + (size_t)nxt.pn * tstepB : cB;
#pragma unroll 1
        for (int t = 0; t < nt; t += 2) {
            const bool last = (t == nt - 2);
            const char* a1 = cA + (size_t)(t + 1) * kstep;
            const char* a2 = last ? nA : cA + (size_t)(t + 2) * kstep; const char* b2 = last ? nB : cB + (size_t)(t + 2) * kstep;
            const char* a3 = a2 + kstep; const char* b3 = b2 + kstep;
            PG8_LDB(B0, 0, 0); PG8_SCHED; PG8_LDA(At, 0, 0); PG8_STAGE(PG8_SA(1, 1), a1 + hstepA, voffA);
            PG8_WAIT_L(8); PG8_BAR; PG8_WAIT_L(0); PG8_MMA(0, 0, At, B0); PG8_BAR; PG8_SCHED;
            PG8_LDB(B1, 0, 1); PG8_STAGE(PG8_SB(0, 0), b2, voffB);
            PG8_BAR; PG8_WAIT_L(0); PG8_MMA(0, 1, At, B1); PG8_BAR;
            PG8_LDA(At, 0, 1); PG8_STAGE(PG8_SA(0, 0), a2, voffA);
            PG8_BAR; PG8_WAIT_L(0); PG8_MMA(1, 0, At, B0); PG8_BAR; PG8_SCHED;
            PG8_STAGE(PG8_SB(0, 1), b2 + hstepB, voffB);
            PG8_WAIT_V(6); PG8_BAR; PG8_MMA(1, 1, At, B1); PG8_BAR;
            PG8_LDB(B0, 1, 0); PG8_SCHED; PG8_LDA(At, 1, 0); PG8_STAGE(PG8_SA(0, 1), a2 + hstepA, voffA);
            PG8_WAIT_L(8); PG8_BAR; PG8_WAIT_L(0); PG8_MMA(0, 0, At, B0); PG8_BAR; PG8_SCHED;
            PG8_LDB(B1, 1, 1); PG8_STAGE(PG8_SB(1, 0), b3, voffB);
            PG8_BAR; PG8_WAIT_L(0); PG8_MMA(0, 1, At, B1); PG8_BAR;
            PG8_LDA(At, 1, 1); PG8_STAGE(PG8_SA(1, 0), a3, voffA);
            PG8_BAR; PG8_WAIT_L(0); PG8_MMA(1, 0, At, B0); PG8_BAR; PG8_SCHED;
            PG8_STAGE(PG8_SB(1, 1), b3 + hstepB, voffB);
            PG8_WAIT_V(6); PG8_BAR; PG8_MMA(1, 1, At, B1); PG8_BAR;
        }
        E(acc, cur, wr, wc, fr, fq);
        if (!has_next) break;
#pragma unroll
        for (int a = 0; a < 2; ++a)
#pragma unroll
            for (int b = 0; b < 2; ++b)
#pragma unroll
                for (int m = 0; m < 4; ++m)
#pragma unroll
                    for (int n = 0; n < 2; ++n) acc[a][b][m][n] = (f32x4){0.f, 0.f, 0.f, 0.f};
        cur = nxt; cA = nA; cB = nB; ++ui;
    }
    PG8_WAIT_V(0);
    if (wr == 0) PG8_BAR;
    PG8_BAR;
#undef PG8_SA
#undef PG8_SB
#undef PG8_STAGE
#undef PG8_LDA
#undef PG8_LDB
#undef PG8_MMA
#undef PG8_WAIT_V
#undef PG8_WAIT_L
#undef PG8_BAR
#undef PG8_SCHED
}
}
using pg8::Unit;

__device__ __forceinline__ u32x4 pack8(f32x4 a, f32x4 b) {
    h16x8 v = {(h16)a[0], (h16)a[1], (h16)a[2], (h16)a[3], (h16)b[0], (h16)b[1], (h16)b[2], (h16)b[3]};
    return __builtin_bit_cast(u32x4, v);
}

struct AMapOne { const char* A; __device__ __forceinline__ const char* operator()(int) const { return A; } };
struct AMapMix {
    const char* A;
    __device__ __forceinline__ const char* operator()(int pn) const {
        int idx; if (pn < 8) idx = 0; else if (pn < 16) idx = 2; else if (pn < 24) idx = 3; else if (pn == 24) idx = 1; else if (pn == 25) idx = 4; else if (pn == 26) idx = 5; else idx = 3;
        return A + (size_t)idx * ((size_t)MTOK * DM * 2);
    }
};
struct AMapLora {
    const char* C1;
    __device__ __forceinline__ const char* operator()(int pn) const { return C1 + (size_t)(6144 + 256 * (pn >> 3)) * 2; }
};

#define EPI_ROWS_PERM  const int row0 = u.pm * 256 + wr * 64 + fr; const int colt = u.pn * 256 + wc * 32 + 8 * fq;
struct EpiH16 {
    static constexpr bool PERM = true;
    h16* O; int ldc;
    __device__ __forceinline__ void operator()(const f32x4 (&acc)[2][2][4][2], const Unit& u, int wr, int wc, int fr, int fq) const {
        EPI_ROWS_PERM
#pragma unroll
        for (int ai = 0; ai < 2; ++ai)
#pragma unroll
            for (int m = 0; m < 4; ++m) { h16* rowp = O + (size_t)(row0 + ai * 128 + m * 16) * ldc + colt;
#pragma unroll
                for (int bj = 0; bj < 2; ++bj) *(u32x4*)(rowp + bj * 128) = pack8(acc[ai][bj][m][0], acc[ai][bj][m][1]); }
    }
};
struct EpiG1 {
    static constexpr bool PERM = true;
    h16* O; h16* VFw;
    __device__ __forceinline__ void operator()(const f32x4 (&acc)[2][2][4][2], const Unit& u, int wr, int wc, int fr, int fq) const {
        EPI_ROWS_PERM
        const int mode = u.pn == 24 ? 1 : (u.pn == 26 ? 2 : 0);
        const bool vtile = VFw != nullptr && u.pn >= 16 && u.pn < 24;
#pragma unroll
        for (int ai = 0; ai < 2; ++ai)
#pragma unroll
            for (int m = 0; m < 4; ++m) { h16* rowp = O + (size_t)(row0 + ai * 128 + m * 16) * LDC1 + colt;
#pragma unroll
                for (int bj = 0; bj < 2; ++bj) { f32x4 v0 = acc[ai][bj][m][0], v1 = acc[ai][bj][m][1];
                    if (mode == 1) {
#pragma unroll
                        for (int j = 0; j < 4; ++j) { v0[j] = 1.0f - 2.0f / (1.0f + __expf(2.0f * v0[j])); v1[j] = 1.0f - 2.0f / (1.0f + __expf(2.0f * v1[j])); } }
                    else if (mode == 2) {
#pragma unroll
                        for (int j = 0; j < 4; ++j) { v0[j] = sigmoidf_(v0[j]); v1[j] = sigmoidf_(v1[j]); } }
                    const u32x4 pk = pack8(v0, v1);
                    *(u32x4*)(rowp + bj * 128) = pk;
                    if (vtile) *(u32x4*)(VFw + (size_t)(row0 + ai * 128 + m * 16) * DM + (colt - 4096) + bj * 128) = pk; } }
    }
};
template <int GI_> struct EpiG2 {
    static constexpr bool PERM = true;
    h16* DEC; h16* Ab; h16* Gb; h16* C1; const h16* VF; const float* w0; const float* a0; const float* v0; h16* AA; const float* k_k; const float* k_a;
    template <int GI>
    __device__ __forceinline__ void body(const f32x4 (&acc)[2][2][4][2], int row0, int colt) const {
#pragma unroll
        for (int bj = 0; bj < 2; ++bj) {
            const int c = colt + bj * 128;
            f32x4 b0 = (f32x4){0.f, 0.f, 0.f, 0.f}, b1 = b0;
            if (GI == 0) { b0 = *(const f32x4*)(w0 + c); b1 = *(const f32x4*)(w0 + c + 4); }
            else if (GI == 1) { b0 = *(const f32x4*)(a0 + c); b1 = *(const f32x4*)(a0 + c + 4); }
            else if (GI == 3) { b0 = *(const f32x4*)(v0 + c); b1 = *(const f32x4*)(v0 + c + 4); }
#pragma unroll
            for (int ai = 0; ai < 2; ++ai)
#pragma unroll
                for (int m = 0; m < 4; ++m) {
                    const size_t row = (size_t)(row0 + ai * 128 + m * 16);
                    f32x4 x0 = acc[ai][bj][m][0] + b0, x1 = acc[ai][bj][m][1] + b1;
                    if (GI == 0) {
#pragma unroll
                        for (int j = 0; j < 4; ++j) {
                            x0[j] = 0.6065306597126334f * sigmoidf_(x0[j]); x1[j] = 0.6065306597126334f * sigmoidf_(x1[j]); }
                        *(u32x4*)(DEC + row * DM + c) = pack8(x0, x1);
                    } else if (GI == 1) {
#pragma unroll
                        for (int j = 0; j < 4; ++j) { x0[j] = sigmoidf_(x0[j]); x1[j] = sigmoidf_(x1[j]); }
                        *(u32x4*)(Ab + row * DM + c) = pack8(x0, x1);
                    } else if (GI == 2) {
                        *(u32x4*)(Gb + row * DM + c) = pack8(x0, x1);
                    } else {
                        h16* vp = C1 + row * LDC1 + 4096 + c;
                        const h16x8 vv = *(const h16x8*)vp; const h16x8 vf = *(const h16x8*)(VF + row * DM + c);
                        f32x4 o0, o1;
#pragma unroll
                        for (int j = 0; j < 4; ++j) { float v = (float)vv[j], f = (float)vf[j]; o0[j] = v + (f - v) * sigmoidf_(x0[j]); v = (float)vv[4 + j]; f = (float)vf[4 + j]; o1[j] = v + (f - v) * sigmoidf_(x1[j]); }
                        *(u32x4*)vp = pack8(o0, o1);
                    }
                    __builtin_amdgcn_sched_barrier(0);
                }
        }
    }
    __device__ __forceinline__ void body_a(const f32x4 (&acc)[2][2][4][2], int row0, int cb0) const {
#pragma unroll
        for (int ai = 0; ai < 2; ++ai)
#pragma unroll
            for (int m = 0; m < 4; ++m) {
                const size_t row = (size_t)(row0 + ai * 128 + m * 16);
                asm volatile("" ::: "memory");
                float a[2][8], kv[2][8], kk[2][8]; float ss = 0.f;
#pragma unroll
                for (int bj = 0; bj < 2; ++bj) {
                    const int c = cb0 + 32 * bj;
                    const f32x4 b0 = *(const f32x4*)(a0 + c), b1 = *(const f32x4*)(a0 + c + 4), q0 = *(const f32x4*)(k_k + c), q1 = *(const f32x4*)(k_k + c + 4);
                    const h16x8 kh = *(const h16x8*)(C1 + row * LDC1 + 2048 + c);
#pragma unroll
                    for (int e = 0; e < 4; ++e) {
                        a[bj][e] = sigmoidf_(acc[ai][bj][m][0][e] + b0[e]); a[bj][4 + e] = sigmoidf_(acc[ai][bj][m][1][e] + b1[e]);
                        kv[bj][e] = (float)kh[e]; kv[bj][4 + e] = (float)kh[4 + e];
                        kk[bj][e] = kv[bj][e] * q0[e]; kk[bj][4 + e] = kv[bj][4 + e] * q1[e];
                        ss += kk[bj][e] * kk[bj][e] + kk[bj][4 + e] * kk[bj][4 + e];
                    }
                }
                ss += __shfl_xor(ss, 16); ss += __shfl_xor(ss, 32);
                const float inv = 1.0f / fmaxf(sqrtf(ss), 1e-12f);
#pragma unroll
                for (int bj = 0; bj < 2; ++bj) {
                    const int c = cb0 + 32 * bj;
                    const f32x4 p0 = *(const f32x4*)(k_a + c), p1 = *(const f32x4*)(k_a + c + 4);
                    f32x4 ko0, ko1, ao0, ao1, bo0, bo1;
#pragma unroll
                    for (int e = 0; e < 4; ++e) {
                        ko0[e] = kv[bj][e] * (1.0f + (a[bj][e] - 1.0f) * p0[e]); ko1[e] = kv[bj][4 + e] * (1.0f + (a[bj][4 + e] - 1.0f) * p1[e]);
                        const float n0_ = kk[bj][e] * inv, n1_ = kk[bj][4 + e] * inv;
                        ao0[e] = -n0_; ao1[e] = -n1_; bo0[e] = n0_ * a[bj][e]; bo1[e] = n1_ * a[bj][4 + e];
                    }
                    *(u32x4*)(C1 + row * LDC1 + 2048 + c) = pack8(ko0, ko1);
                    *(u32x4*)(AA + row * DM + c) = pack8(ao0, ao1);
                    *(u32x4*)(Ab + row * DM + c) = pack8(bo0, bo1);
                }
                __builtin_amdgcn_sched_barrier(0);
            }
    }
    __device__ __forceinline__ void operator()(const f32x4 (&acc)[2][2][4][2], const Unit& u, int wr, int wc, int fr, int fq) const {
        const int row0 = u.pm * 256 + wr * 64 + fr; const int colt = u.pn * 256 + wc * 32 + 8 * fq;
        if (GI_ == 1) body_a(acc, row0, u.pn * 256 + wc * 64 + 8 * fq);
        else body<GI_>(acc, row0, colt);
    }
};
struct EpiRes {
    static constexpr bool PERM = true;
    const h16* X; h16* PRE;
    __device__ __forceinline__ void operator()(const f32x4 (&acc)[2][2][4][2], const Unit& u, int wr, int wc, int fr, int fq) const {
        EPI_ROWS_PERM
#pragma unroll
        for (int ai = 0; ai < 2; ++ai)
#pragma unroll
            for (int m = 0; m < 4; ++m) { const size_t off = (size_t)(row0 + ai * 128 + m * 16) * DM + colt;
#pragma unroll
                for (int bj = 0; bj < 2; ++bj) {
                    const h16x8 x = *(const h16x8*)(X + off + bj * 128);
                    f32x4 o0, o1;
#pragma unroll
                    for (int e = 0; e < 4; ++e) { o0[e] = (float)x[e] * ALPHA + acc[ai][bj][m][0][e]; o1[e] = (float)x[4 + e] * ALPHA + acc[ai][bj][m][1][e]; }
                    *(u32x4*)(PRE + off + bj * 128) = pack8(o0, o1); } }
    }
};
__device__ __forceinline__ float gelu_mul(float u, float gc) {
    const float t = gc * gc;
    const float z = gc * (t * (0.044715f * 1.5957691216057308f * LOG2E) + 1.5957691216057308f * LOG2E);
    return u * gc * __builtin_amdgcn_rcpf(1.0f + __builtin_amdgcn_exp2f(-z));
}
struct EpiUpConv {
    static constexpr bool PERM = true;
    h16* ACT; h16* SIDE; const float* cw; const float* cb;
    __device__ __forceinline__ void operator()(const f32x4 (&acc)[2][2][4][2], const Unit& u, int wr, int wc, int fr, int fq) const {
        const int row0 = u.pm * 256 + wr * 64 + fr, f0 = u.pn * 128 + wc * 32 + 8 * fq;
        f32x4 w0[2], w1[2], w2[2], bb[2];
#pragma unroll
        for (int n = 0; n < 2; ++n) { w0[n] = *(const f32x4*)(cw + f0 + 4 * n); w1[n] = *(const f32x4*)(cw + FF + f0 + 4 * n); w2[n] = *(const f32x4*)(cw + 2 * FF + f0 + 4 * n); bb[n] = *(const f32x4*)(cb + f0 + 4 * n); }
#pragma unroll
        for (int ai = 0; ai < 2; ++ai) {
            f32x4 p1[2], p2[2];
#pragma unroll
            for (int n = 0; n < 2; ++n) { p1[n] = (f32x4){0.f, 0.f, 0.f, 0.f}; p2[n] = p1[n]; }
#pragma unroll
            for (int m = 0; m < 4; ++m) {
                const int row = row0 + ai * 128 + m * 16;
                f32x4 r1[2], r2[2], o[2];
#pragma unroll
                for (int n = 0; n < 2; ++n)
#pragma unroll
                    for (int e = 0; e < 4; ++e) {
                        const float g = acc[ai][1][m][n][e];
                        r1[n][e] = dpp_f<0x121>(g); r2[n][e] = dpp_f<0x122>(g);
                        const float g1 = fr >= 1 ? r1[n][e] : p1[n][e], g2 = fr >= 2 ? r2[n][e] : p2[n][e];
                        const float gc = bb[n][e] + g2 * w0[n][e] + g1 * w1[n][e] + g * w2[n][e];
                        o[n][e] = gelu_mul(acc[ai][0][m][n][e], gc);
                    }
                if (m > 0 || fr >= 2) *(u32x4*)(ACT + (size_t)row * FF + f0) = pack8(o[0], o[1]);
                if (m == 0 && fr < 2) { h16* sp = SIDE + ((size_t)(row >> 6) * 4 + 2 + fr) * (2 * FF) + f0;
                    *(u32x4*)sp = pack8(acc[ai][0][m][0], acc[ai][0][m][1]); *(u32x4*)(sp + FF) = pack8(acc[ai][1][m][0], acc[ai][1][m][1]); }
                if (m == 3 && fr >= 14) { h16* sp = SIDE + ((size_t)(row >> 6) * 4 + (fr - 14)) * (2 * FF) + FF + f0;
                    *(u32x4*)sp = pack8(acc[ai][1][m][0], acc[ai][1][m][1]); }
#pragma unroll
                for (int n = 0; n < 2; ++n) { p1[n] = r1[n]; p2[n] = r2[n]; }
            }
        }
    }
};
__device__ __forceinline__ void convfix_phase(const h16* SIDE, h16* ACT, const float* cw, const float* cb) {
    constexpr int NCG = FF / 8, NT = 256 * 2 * NCG;
    for (int task = obid() * 512 + otid(); task < NT; task += gridDim.x * 512) {
        const int cgi = task % NCG, j = (task / NCG) & 1, gidx = task / (2 * NCG), f = cgi * 8;
        const bool first = (gidx & 127) == 0;
        const h16* cur = SIDE + ((size_t)gidx * 4 + 2 + j) * (2 * FF) + f;
        const h16x8 uh = *(const h16x8*)cur, g0h = *(const h16x8*)(cur + FF);
        h16x8 g1h = {}, g2h = {};
        if (j == 0) { if (!first) { g1h = *(const h16x8*)(SIDE + ((size_t)(gidx - 1) * 4 + 1) * (2 * FF) + FF + f); g2h = *(const h16x8*)(SIDE + ((size_t)(gidx - 1) * 4 + 0) * (2 * FF) + FF + f); } }
        else { g1h = *(const h16x8*)(SIDE + ((size_t)gidx * 4 + 2) * (2 * FF) + FF + f); if (!first) g2h = *(const h16x8*)(SIDE + ((size_t)(gidx - 1) * 4 + 1) * (2 * FF) + FF + f); }
        h16x8 o;
#pragma unroll
        for (int e = 0; e < 8; ++e) {
            const float gc = cb[f + e] + (float)g2h[e] * cw[f + e] + (float)g1h[e] * cw[FF + f + e] + (float)g0h[e] * cw[2 * FF + f + e];
            o[e] = (h16)gelu_mul((float)uh[e], gc);
        }
        *(h16x8*)(ACT + ((size_t)gidx * 64 + j) * FF + f) = o;
    }
}
struct EpiQKV {
    static constexpr bool PERM = true;
    h16* Qb; h16* Kb; h16* Vt;
    __device__ __forceinline__ void operator()(const f32x4 (&acc)[2][2][4][2], const Unit& u, int wr, int wc, int fr, int fq) const {
        const int row0 = u.pm * 256 + wr * 64 + fr; const int part = u.pn >> 3; const int colt = (u.pn & 7) * 256 + wc * 32 + 8 * fq;
#pragma unroll
        for (int ai = 0; ai < 2; ++ai)
#pragma unroll
            for (int m = 0; m < 4; ++m) { const int row = row0 + ai * 128 + m * 16;
#pragma unroll
                for (int bj = 0; bj < 2; ++bj) { const int c = colt + bj * 128;
                    if (part == 0) *(u32x4*)(Qb + (size_t)row * DM + c) = pack8(acc[ai][bj][m][0] * QSCALE, acc[ai][bj][m][1] * QSCALE);
                    else if (part == 1) *(u32x4*)(Kb + (size_t)row * DM + c) = pack8(acc[ai][bj][m][0], acc[ai][bj][m][1]);
                    else {
                        const int b = row >> 13, t = row & 8191, hd = c >> 8, dv = c & 255;
                        const int pos = (t & ~12) | ((t & 4) << 1) | ((t & 8) >> 1);
                        h16* vp = Vt + ((size_t)((b * 8 + hd) * 256 + dv)) * SEQ + pos;
#pragma unroll
                        for (int j = 0; j < 4; ++j) { vp[(size_t)j * SEQ] = (h16)acc[ai][bj][m][0][j]; vp[(size_t)(4 + j) * SEQ] = (h16)acc[ai][bj][m][1][j]; }
                    } } }
    }
};

__device__ __forceinline__ void cvt_job(LAS unsigned char* lds, const float* src, int Ks, int Ns, h16* dst, int Kd, int Nd, int remap = 0) {
    LAS h16* tile = (LAS h16*)lds;
    const int tid = otid(), tk = Kd >> 6, tn = Nd >> 6;
    for (int t = obid(); t < tk * tn; t += gridDim.x) {
        const int k0 = (t % tk) * 64, n0 = (t / tk) * 64;
#pragma unroll
        for (int i = 0; i < 2; ++i) {
            const int idx = tid + 512 * i, kr = idx >> 4, nc = (idx & 15) * 4, k = k0 + kr, n = n0 + nc;
            f32x4 v = (f32x4){0.f, 0.f, 0.f, 0.f};
            if (k < Ks && n < Ns) v = *(const f32x4*)(src + (size_t)k * Ns + n);
            tile[kr * 66 + nc + 0] = (h16)v[0]; tile[kr * 66 + nc + 1] = (h16)v[1]; tile[kr * 66 + nc + 2] = (h16)v[2]; tile[kr * 66 + nc + 3] = (h16)v[3];
        }
        __syncthreads();
        { const int n = tid >> 3, kg = tid & 7; h16x8 o;
#pragma unroll
          for (int e = 0; e < 8; ++e) o[e] = tile[(kg * 8 + e) * 66 + n];
          const int no = n0 + n;
          const int nd = remap == 0 ? no : (remap == 1 ? (no < FF ? (no >> 7) * 256 + (no & 127) : ((no - FF) >> 7) * 256 + 128 + ((no - FF) & 127))
                                                      : ((no & ~255) | ((no & 32) << 2) | ((no & 192) >> 1) | (no & 31)));
          *(h16x8*)(dst + (size_t)nd * Kd + k0 + kg * 8) = o; }
        __syncthreads();
    }
}
__device__ __forceinline__ void cvt_layer(LAS unsigned char* lds, const Params& p, int layer) {
    const bool ffn_here = (layer & 1) != 0;
    h16* W = (h16*)(p.ws + ((layer & 1) ? WS_X : WS_W16));
    const int j = layer >> 1;
    if ((layer & 1) == 0) {
        h16* B1 = (h16*)((char*)W + W_B1); h16* B2 = (h16*)((char*)W + W_B2);
        for (int i = 0; i < 3; ++i) cvt_job(lds, p.in[4] + ((size_t)j * 3 + i) * DM * DM, DM, DM, B1 + (size_t)i * DM * DM, DM, DM);
        cvt_job(lds, p.in[6] + (size_t)j * DM * 96, DM, 96, B1 + (size_t)6144 * DM, DM, 256);
        cvt_job(lds, p.in[9] + (size_t)j * DM * 96, DM, 96, B1 + (size_t)6400 * DM, DM, 256);
        cvt_job(lds, p.in[14] + (size_t)j * DM * 128, DM, 128, B1 + (size_t)6656 * DM, DM, 256);
        cvt_job(lds, p.in[7] + (size_t)j * 96 * DM, 96, DM, B2, 256, DM);
        cvt_job(lds, p.in[10] + (size_t)j * 96 * DM, 96, DM, B2 + (size_t)2048 * 256, 256, DM, 2);
        cvt_job(lds, p.in[15] + (size_t)j * 128 * DM, 128, DM, B2 + (size_t)4096 * 256, 256, DM);
        if (j > 0) {
            cvt_job(lds, p.in[12] + (size_t)(j - 1) * DM * 64, DM, 64, B1 + (size_t)6912 * DM, DM, 256);
            cvt_job(lds, p.in[13] + (size_t)(j - 1) * 64 * DM, 64, DM, B2 + (size_t)6144 * 256, 256, DM);
        }
        cvt_job(lds, p.in[21] + (size_t)j * DM * DM, DM, DM, (h16*)((char*)W + W_WO), DM, DM);
    } else {
        cvt_job(lds, p.in[22] + (size_t)j * DM * 6144, DM, 6144, (h16*)((char*)W + W_B1), DM, 6144);
        cvt_job(lds, p.in[25] + (size_t)j * DM * DM, DM, DM, (h16*)((char*)W + W_WO), DM, DM);
    }
    if (ffn_here) {
        cvt_job(lds, p.in[27] + (size_t)layer * DM * 2 * FF, DM, 2 * FF, (h16*)((char*)W + W_UP), DM, 2 * FF, 1);
        cvt_job(lds, p.in[30] + (size_t)layer * FF * DM, FF, DM, (h16*)((char*)W + W_DN), FF, DM);
    }
}

template <bool LN>
__device__ __forceinline__ void ln_row(const void* src, size_t row, int lane, const float* g, const float* bt, f32x4 (&v)[8]) {
    if (LN) {
        const h16x4* sp = (const h16x4*)((const h16*)src + row * DM);
#pragma unroll
        for (int i = 0; i < 8; ++i) { const h16x4 t = sp[i * 64 + lane]; v[i] = (f32x4){(float)t[0], (float)t[1], (float)t[2], (float)t[3]}; }
        float s = 0.f;
#pragma unroll
        for (int i = 0; i < 8; ++i) s += (v[i][0] + v[i][1]) + (v[i][2] + v[i][3]);
        const float mean = wave_sum(s) * (1.0f / DM);
        float q = 0.f;
#pragma unroll
        for (int i = 0; i < 8; ++i) { v[i] = v[i] - mean; q += (v[i][0] * v[i][0] + v[i][1] * v[i][1]) + (v[i][2] * v[i][2] + v[i][3] * v[i][3]); }
        const float rstd = rsqrtf(wave_sum(q) * (1.0f / DM) + 1e-5f);
#pragma unroll
        for (int i = 0; i < 8; ++i) { const f32x4 gg = ((const f32x4*)g)[i * 64 + lane], bb = ((const f32x4*)bt)[i * 64 + lane]; v[i] = v[i] * rstd * gg + bb; }
    } else {
        const f32x4* sp = (const f32x4*)((const float*)src + row * DM);
#pragma unroll
        for (int i = 0; i < 8; ++i) v[i] = sp[i * 64 + lane];
    }
}
__device__ __forceinline__ void ln_load16(const void* src, size_t row, int lane, h16x4 (&t)[8]) {
    const h16x4* sp = (const h16x4*)((const h16*)src + row * DM);
#pragma unroll
    for (int i = 0; i < 8; ++i) t[i] = sp[i * 64 + lane];
}
__device__ __forceinline__ void ln_apply16(const h16x4 (&t)[8], int lane, const float* g, const float* bt, f32x4 (&v)[8]) {
#pragma unroll
    for (int i = 0; i < 8; ++i) v[i] = (f32x4){(float)t[i][0], (float)t[i][1], (float)t[i][2], (float)t[i][3]};
    float s = 0.f;
#pragma unroll
    for (int i = 0; i < 8; ++i) s += (v[i][0] + v[i][1]) + (v[i][2] + v[i][3]);
    const float mean = wave_sum(s) * (1.0f / DM);
    float q = 0.f;
#pragma unroll
    for (int i = 0; i < 8; ++i) { v[i] = v[i] - mean; q += (v[i][0] * v[i][0] + v[i][1] * v[i][1]) + (v[i][2] * v[i][2] + v[i][3] * v[i][3]); }
    const float rstd = rsqrtf(wave_sum(q) * (1.0f / DM) + 1e-5f);
#pragma unroll
    for (int i = 0; i < 8; ++i) { const f32x4 gg = ((const f32x4*)g)[i * 64 + lane], bb = ((const f32x4*)bt)[i * 64 + lane]; v[i] = v[i] * rstd * gg + bb; }
}
template <bool LN>
__device__ __forceinline__ void ln_phase(const void* src, const float* g, const float* bt, float* xout, h16* xh, const float* mu, h16* mix) {
    const int lane = otid() & 63, gw = obid() * 8 + (otid() >> 6), GW = gridDim.x * 8;
    for (int ch = gw; ch < MTOK / 8; ch += GW) {
        const size_t t0 = (size_t)ch * 8;
        f32x4 prev[8], cur[8];
        if (mix) {
            if ((t0 & (SEQ - 1)) == 0) {
#pragma unroll
                for (int i = 0; i < 8; ++i) prev[i] = (f32x4){0.f, 0.f, 0.f, 0.f};
            } else ln_row<LN>(src, t0 - 1, lane, g, bt, prev);
        }
        h16x4 raw[8], rawn[8];
        if (LN) ln_load16(src, t0, lane, raw);
#pragma unroll 1
        for (int r = 0; r < 8; ++r) {
            const size_t row = t0 + r;
            asm volatile("" ::: "memory");
            if (LN) {
                ln_load16(src, t0 + (r < 7 ? r + 1 : 7), lane, rawn);
                ln_apply16(raw, lane, g, bt, cur);
#pragma unroll
                for (int i = 0; i < 8; ++i) raw[i] = rawn[i];
            } else ln_row<LN>(src, row, lane, g, bt, cur);
            if (xout) {
#pragma unroll
                for (int i = 0; i < 8; ++i) ((f32x4*)(xout + row * DM))[i * 64 + lane] = cur[i];
            }
            if (xh) {
#pragma unroll
                for (int i = 0; i < 8; ++i) { h16x4 o = {(h16)cur[i][0], (h16)cur[i][1], (h16)cur[i][2], (h16)cur[i][3]}; ((h16x4*)(xh + row * DM))[i * 64 + lane] = o; }
            }
            if (mix) {
#pragma unroll
                for (int i = 0; i < 8; ++i) {
                    asm volatile("" ::: "memory");
                    const f32x4 xx = prev[i] - cur[i];
#pragma unroll
                    for (int k = 0; k < 6; ++k) {
                        const f32x4 m4 = ((const f32x4*)(mu + (size_t)k * DM))[i * 64 + lane];
                        const f32x4 o4 = cur[i] + xx * m4;
                        h16x4 o = {(h16)o4[0], (h16)o4[1], (h16)o4[2], (h16)o4[3]};
                        ((h16x4*)(mix + ((size_t)k * MTOK + row) * DM))[i * 64 + lane] = o;
                    }
                    prev[i] = cur[i];
                }
            }
        }
    }
}

__device__ __forceinline__ void prep_phase(h16* C1, h16* Ab, h16* AA, h16* VF, const float* k_k, const float* k_a, bool first) {
    const int lane = otid() & 63, gw = obid() * 8 + (otid() >> 6), GW = gridDim.x * 8;
    for (int row = gw; row < MTOK; row += GW) {
#pragma unroll
        for (int i = 0; i < 8; ++i) {
            const int c = i * 256 + lane * 4;
            h16x4* kp = (h16x4*)(C1 + (size_t)row * LDC1 + 2048 + c);
            h16x4* ap = (h16x4*)(Ab + (size_t)row * DM + c);
            const h16x4 kh = *kp, ah = *ap;
            const f32x4 kkw = *(const f32x4*)(k_k + c), kaw = *(const f32x4*)(k_a + c);
            f32x4 k, a, kk;
#pragma unroll
            for (int e = 0; e < 4; ++e) { k[e] = (float)kh[e]; a[e] = (float)ah[e]; kk[e] = k[e] * kkw[e]; }
            float ss = (kk[0] * kk[0] + kk[1] * kk[1]) + (kk[2] * kk[2] + kk[3] * kk[3]);
            ss = grp16_sum(ss);
            const float inv = 1.0f / fmaxf(sqrtf(ss), 1e-12f);
            h16x4 ko, aao, bbo;
#pragma unroll
            for (int e = 0; e < 4; ++e) { const float kn = kk[e] * inv; ko[e] = (h16)(k[e] * (1.0f + (a[e] - 1.0f) * kaw[e])); aao[e] = (h16)(-kn); bbo[e] = (h16)(kn * a[e]); }
            *kp = ko; *ap = bbo; *(h16x4*)(AA + (size_t)row * DM + c) = aao;
            if (first) *(h16x4*)(VF + (size_t)row * DM + c) = *(const h16x4*)(C1 + (size_t)row * LDC1 + 4096 + c);
        }
    }
}

__device__ __forceinline__ void scan_phase(LAS unsigned char* lds, const h16* C1, const h16* DEC, const h16* AA, const h16* BB, float* Y,
                                           const float* sQKV, const float* sWO, const float* sUP, const float* sDN, char* Wn, const float* sUP0, const float* sDN0, char* Wc) {
    constexpr int CH = 32, NCH = SEQ / CH, BUF = 18976;
    LAS float* L = (LAS float*)lds;
    const int tid = otid(), wid = tid >> 6, lane = tid & 63;
    for (int item = obid(); item < 256; item += gridDim.x) {
        const int b = item >> 7, h = (item >> 2) & 31, q = item & 3;
        const size_t row0 = (size_t)b * SEQ;
        __syncthreads();
        if (wid >= 4) {
            const int lt = tid - 256, s = lt >> 3, e8 = lt & 7;
            struct StReg { h16x8 r8, k8, a8, b8, v8, d8; };
            auto gload = [&](int c) -> StReg {
                StReg R;
                const size_t row = row0 + (size_t)c * CH + s;
                R.r8 = *(const h16x8*)(C1 + row * LDC1 + h * 64 + e8 * 8);
                R.k8 = *(const h16x8*)(C1 + row * LDC1 + 2048 + h * 64 + e8 * 8);
                { const int tn = c * CH + s + 1; const size_t rown = row0 + (size_t)(tn < SEQ ? tn : SEQ - 1);
                  R.a8 = *(const h16x8*)(AA + rown * DM + h * 64 + e8 * 8); }
                R.b8 = *(const h16x8*)(BB + row * DM + h * 64 + e8 * 8);
                R.d8 = *(const h16x8*)(DEC + row * DM + h * 64 + e8 * 8);
                R.v8 = (h16x8){};
                if (lt < 64) R.v8 = *(const h16x8*)(C1 + (row0 + (size_t)c * CH + (lt >> 1)) * LDC1 + 4096 + h * 64 + q * 16 + (lt & 1) * 8);
                return R;
            };
            auto lwrite = [&](const StReg& R, int bufi) {
                LAS float* Bf = L + bufi * BUF;
                LAS float* dst = Bf + s * 64 + e8 * 8;
                *(LAS f32x4*)(dst + 0 * 2048) = (f32x4){(float)R.r8[0], (float)R.r8[1], (float)R.r8[2], (float)R.r8[3]}; *(LAS f32x4*)(dst + 0 * 2048 + 4) = (f32x4){(float)R.r8[4], (float)R.r8[5], (float)R.r8[6], (float)R.r8[7]};
                *(LAS f32x4*)(dst + 1 * 2048) = (f32x4){__expf(-(float)R.d8[0]), __expf(-(float)R.d8[1]), __expf(-(float)R.d8[2]), __expf(-(float)R.d8[3])};
                *(LAS f32x4*)(dst + 1 * 2048 + 4) = (f32x4){__expf(-(float)R.d8[4]), __expf(-(float)R.d8[5]), __expf(-(float)R.d8[6]), __expf(-(float)R.d8[7])};
                *(LAS f32x4*)(dst + 2 * 2048) = (f32x4){(float)R.k8[0], (float)R.k8[1], (float)R.k8[2], (float)R.k8[3]}; *(LAS f32x4*)(dst + 2 * 2048 + 4) = (f32x4){(float)R.k8[4], (float)R.k8[5], (float)R.k8[6], (float)R.k8[7]};
                *(LAS f32x4*)(dst + 3 * 2048) = (f32x4){(float)R.a8[0], (float)R.a8[1], (float)R.a8[2], (float)R.a8[3]}; *(LAS f32x4*)(dst + 3 * 2048 + 4) = (f32x4){(float)R.a8[4], (float)R.a8[5], (float)R.a8[6], (float)R.a8[7]};
                *(LAS f32x4*)(dst + 4 * 2048) = (f32x4){(float)R.b8[0], (float)R.b8[1], (float)R.b8[2], (float)R.b8[3]}; *(LAS f32x4*)(dst + 4 * 2048 + 4) = (f32x4){(float)R.b8[4], (float)R.b8[5], (float)R.b8[6], (float)R.b8[7]};
                { float cp = 0.f;
#pragma unroll
                  for (int e = 0; e < 8; ++e) cp += (float)R.b8[e] * (float)R.a8[e];
                  cp += __shfl_xor(cp, 1); cp += __shfl_xor(cp, 2); cp += __shfl_xor(cp, 4);
                  if (e8 == 0) Bf[18944 + s] = cp; }
                if (lt < 64) { LAS float* vd = Bf + 10240 + (lt >> 1) * 16 + (lt & 1) * 8;
                    *(LAS f32x4*)vd = (f32x4){(float)R.v8[0], (float)R.v8[1], (float)R.v8[2], (float)R.v8[3]}; *(LAS f32x4*)(vd + 4) = (f32x4){(float)R.v8[4], (float)R.v8[5], (float)R.v8[6], (float)R.v8[7]}; }
            };
            auto yout = [&](int c, int bufi) {
#pragma unroll
                for (int o2 = 0; o2 < 2; ++o2) {
                    const int o = lt + 256 * o2, ys = o >> 4, yr = o & 15;
                    LAS float* yp = L + bufi * BUF + 10752 + o * 16;
                    f32x4 acc4 = *(LAS f32x4*)(yp + (((0 + (o >> 2)) & 3) << 2));
#pragma unroll
                    for (int i = 1; i < 4; ++i) acc4 += *(LAS f32x4*)(yp + (((i + (o >> 2)) & 3) << 2));
                    Y[(row0 + (size_t)c * CH + ys) * DM + h * 64 + q * 16 + yr] = (acc4[0] + acc4[1]) + (acc4[2] + acc4[3]);
                }
            };
            const int lw = (lt >> 6), wgl = item * 4 + lw;
            LAS h16* ctile = (LAS h16*)(lds + 2 * BUF * 4) + lw * 512;
            f32x4 cv0 = (f32x4){0.f, 0.f, 0.f, 0.f}, cv1 = cv0; h16* cdst = nullptr;
            auto cvt_issue = [&](int tix) {
                constexpr int T0 = 128 * 192, T1 = 128 * 64, T2 = 128 * 344, T3 = 344 * 64;
                cdst = nullptr;
                if (tix >= T0 + T1 + 2 * (T2 + T3)) return;
                const float* src; h16* dst; int Ks, Ns, rm = 0, t = tix;
                if (t >= T0 + T1 + T2 + T3) {
                    t -= T0 + T1 + T2 + T3;
                    if (t < T2) { src = sUP0; dst = (h16*)(Wc + W_UP); Ks = DM; Ns = 2 * FF; rm = 1; }
                    else { t -= T2; src = sDN0; dst = (h16*)(Wc + W_DN); Ks = FF; Ns = DM; }
                }
                else if (t < T0) { src = sQKV; dst = (h16*)(Wn + W_B1); Ks = DM; Ns = 6144; }
                else if (t < T0 + T1) { t -= T0; src = sWO; dst = (h16*)(Wn + W_WO); Ks = DM; Ns = DM; }
                else if (t < T0 + T1 + T2) { t -= T0 + T1; src = sUP; dst = (h16*)(Wn + W_UP); Ks = DM; Ns = 2 * FF; rm = 1; }
                else { t -= T0 + T1 + T2; src = sDN; dst = (h16*)(Wn + W_DN); Ks = FF; Ns = DM; }
                const int tk = Ks >> 4, k0 = (t % tk) * 16, n0 = (t / tk) * 32;
                const int ln = lt & 63, kr = ln >> 3, nc = (ln & 7) * 4;
                cv0 = *(const f32x4*)(src + (size_t)(k0 + kr) * Ns + n0 + nc); cv1 = *(const f32x4*)(src + (size_t)(k0 + kr + 8) * Ns + n0 + nc);
                const int n = ln & 31, hf = ln >> 5, no = n0 + n;
                const int nd = rm == 0 ? no : (no < FF ? (no >> 7) * 256 + (no & 127) : ((no - FF) >> 7) * 256 + 128 + ((no - FF) & 127));
                cdst = dst + (size_t)nd * Ks + k0 + hf * 8;
            };
            auto cvt_finish = [&]() {
                if (cdst == nullptr) return;
                const int ln = lt & 63, kr = ln >> 3, nc = (ln & 7) * 4;
#pragma unroll
                for (int e = 0; e < 4; ++e) { ctile[(nc + e) * 16 + kr] = (h16)cv0[e]; ctile[(nc + e) * 16 + kr + 8] = (h16)cv1[e]; }
                asm volatile("s_waitcnt lgkmcnt(0)" ::: "memory");
                const h16x8 o = *(LAS h16x8*)(ctile + (ln & 31) * 16 + (ln >> 5) * 8);
                *(h16x8*)cdst = o;
                asm volatile("s_waitcnt lgkmcnt(0)" ::: "memory");
            };
            { const StReg R0 = gload(0); lwrite(R0, 0); }
            StReg RA = gload(1);
            __syncthreads();
            for (int c = 0; c < NCH; ++c) {
                StReg RB = RA;
                if (c + 2 < NCH) RB = gload(c + 2);
                if (c + 1 < NCH) lwrite(RA, (c + 1) & 1);
                if (c > 0) yout(c - 1, (c - 1) & 1);
                if (Wn) { cvt_finish(); cvt_issue(wgl + 1024 * c); }
                asm volatile("s_waitcnt lgkmcnt(0)" ::: "memory");
                __builtin_amdgcn_s_barrier();
                asm volatile("" ::: "memory");
                RA = RB;
            }
            yout(NCH - 1, (NCH - 1) & 1);
            if (Wn) cvt_finish();
        } else {
            const int jg = lane & 15, rl = wid * 4 + (lane >> 4);
            f32x2 Sa = (f32x2){0.f, 0.f}, Sb = (f32x2){0.f, 0.f};
            float sa = 0.f;
            __syncthreads();
            for (int c = 0; c < NCH; ++c) {
                LAS float* Bf = L + (c & 1) * BUF;
                LAS float* vec = Bf + jg * 4;
                f32x4 r4 = *(LAS f32x4*)(vec + 0 * 2048), w4 = *(LAS f32x4*)(vec + 1 * 2048), k4 = *(LAS f32x4*)(vec + 2 * 2048), a4 = *(LAS f32x4*)(vec + 3 * 2048), b4 = *(LAS f32x4*)(vec + 4 * 2048);
                float v = Bf[10240 + rl], cn = Bf[18944];
#pragma unroll 1
                for (int s0 = 0; s0 < CH; s0 += 8) {
                    float yv[8];
#pragma unroll
                    for (int u = 0; u < 8; ++u) {
                        const int s = s0 + u, sn = (s + 1 < CH) ? s + 1 : CH - 1;
                        const f32x4 r4n = *(LAS f32x4*)(vec + 0 * 2048 + sn * 64), w4n = *(LAS f32x4*)(vec + 1 * 2048 + sn * 64), k4n = *(LAS f32x4*)(vec + 2 * 2048 + sn * 64),
                                    a4n = *(LAS f32x4*)(vec + 3 * 2048 + sn * 64), b4n = *(LAS f32x4*)(vec + 4 * 2048 + sn * 64);
                        const float vn = Bf[10240 + sn * 16 + rl], cnn = Bf[18944 + sn];
                        const f32x2 aL = {a4[0], a4[1]}, aH = {a4[2], a4[3]}, wL = {w4[0], w4[1]}, wH = {w4[2], w4[3]}, kL = {k4[0], k4[1]}, kH = {k4[2], k4[3]},
                                    bL = {b4[0], b4[1]}, bH = {b4[2], b4[3]}, rL = {r4[0], r4[1]}, rH = {r4[2], r4[3]};
                        const f32x2 uL = Sa * wL + kL * v, uH = Sb * wH + kH * v;
                        const f32x2 dz = uL * aL + uH * aH;
                        const float z = row16_sum(dz[0] + dz[1]);
                        Sa = bL * sa + uL; Sb = bH * sa + uH;
                        const f32x2 dr = Sa * rL + Sb * rH;
                        yv[u] = dr[0] + dr[1];
                        sa = z + cn * sa;
                        r4 = r4n; w4 = w4n; k4 = k4n; a4 = a4n; b4 = b4n; v = vn; cn = cnn;
                    }
#pragma unroll
                    for (int u = 0; u < 8; ++u) Bf[10752 + ((s0 + u) * 16 + rl) * 16 + jg] = yv[u];
                }
                __syncthreads();
            }
        }
    }
}

__device__ __forceinline__ void gn_phase(const float* Y, const h16* C1, const h16* Gb, h16* YG, const float* r_k, const float* lnx_g, const float* lnx_b, h16* VFw) {
    const int lane = otid() & 63, gw = obid() * 8 + (otid() >> 6), GW = gridDim.x * 8;
    for (int row = gw; row < MTOK; row += GW) {
#pragma unroll
        for (int i = 0; i < 8; ++i) {
            const int c = i * 256 + lane * 4;
            const f32x4 y = *(const f32x4*)(Y + (size_t)row * DM + c);
            const h16x4 rh = *(const h16x4*)(C1 + (size_t)row * LDC1 + c), kh = *(const h16x4*)(C1 + (size_t)row * LDC1 + 2048 + c), vh = *(const h16x4*)(C1 + (size_t)row * LDC1 + 4096 + c);
            const h16x4 gh = *(const h16x4*)(Gb + (size_t)row * DM + c);
            const f32x4 rk = *(const f32x4*)(r_k + c), lg = *(const f32x4*)(lnx_g + c), lb = *(const f32x4*)(lnx_b + c);
            float s = (y[0] + y[1]) + (y[2] + y[3]);
            const float mean = grp16_sum(s) * (1.0f / 64.0f);
            const f32x4 d = y - mean;
            float qv = (d[0] * d[0] + d[1] * d[1]) + (d[2] * d[2] + d[3] * d[3]);
            const float rstd = rsqrtf(grp16_sum(qv) * (1.0f / 64.0f) + 64e-5f);
            float bs = 0.f;
#pragma unroll
            for (int e = 0; e < 4; ++e) bs += (float)rh[e] * (float)kh[e] * rk[e];
            bs = grp16_sum(bs);
            h16x4 o;
#pragma unroll
            for (int e = 0; e < 4; ++e) o[e] = (h16)((d[e] * rstd * lg[e] + lb[e] + bs * (float)vh[e]) * (float)gh[e]);
            *(h16x4*)(YG + (size_t)row * DM + c) = o;
            if (VFw) *(h16x4*)(VFw + (size_t)row * DM + c) = vh;
        }
    }
}

__device__ __forceinline__ void convglu_phase(const h16* U, h16* ACT, const float* cw, const float* cb) {
    constexpr int NCG = FF / 8, RC = 16, NT = (MTOK / RC) * NCG;
    for (int task = obid() * 512 + otid(); task < NT; task += gridDim.x * 512) {
        const int cgi = task % NCG, rc = task / NCG, f = cgi * 8, m0 = rc * RC;
        float w0[8], w1[8], w2[8], bb[8], g1[8], g2[8];
#pragma unroll
        for (int e = 0; e < 8; ++e) { w0[e] = cw[f + e]; w1[e] = cw[FF + f + e]; w2[e] = cw[2 * FF + f + e]; bb[e] = cb[f + e]; g1[e] = 0.f; g2[e] = 0.f; }
        if ((m0 & (SEQ - 1)) != 0) {
            const h16x8 a = *(const h16x8*)(U + (size_t)(m0 - 1) * (2 * FF) + FF + f), c2 = *(const h16x8*)(U + (size_t)(m0 - 2) * (2 * FF) + FF + f);
#pragma unroll
            for (int e = 0; e < 8; ++e) { g1[e] = (float)a[e]; g2[e] = (float)c2[e]; }
        }
        for (int r = 0; r < RC; ++r) {
            const size_t m = (size_t)(m0 + r);
            const h16x8 uh = *(const h16x8*)(U + m * (2 * FF) + f), gh = *(const h16x8*)(U + m * (2 * FF) + FF + f);
            h16x8 o;
#pragma unroll
            for (int e = 0; e < 8; ++e) {
                const float g0 = (float)gh[e];
                const float gc = bb[e] + g2[e] * w0[e] + g1[e] * w1[e] + g0 * w2[e];
                const float z = 1.5957691216057308f * (gc + 0.044715f * gc * gc * gc);
                const float ge = gc / (1.0f + __expf(-z));
                o[e] = (h16)((float)uh[e] * ge);
                g2[e] = g1[e]; g1[e] = g0;
            }
            *(h16x8*)(ACT + m * FF + f) = o;
        }
    }
}

__device__ __forceinline__ void attn_phase(LAS unsigned char* lds, const h16* Qb, const h16* Kb, const h16* Vt, h16* AO, const float* rel_bias, const float* lam, const float* subg, float lambda_init) {
    constexpr int STG = 65536;
    const int wid = __builtin_amdgcn_readfirstlane(otid() >> 6), rg = wid & 3, mp = wid >> 2;
    LAS float* lut = (LAS float*)(lds + 2 * STG);
    LAS float* osh = (LAS float*)lds;
    for (int vc = obid(); vc < 256; vc += gridDim.x) {
        const int bh = vc & 15, jj = vc >> 4, b = bh >> 3, h = bh & 7;
        for (int it = 0; it < 4; ++it) {
            const int qb = it == 0 ? 63 - jj : (it == 1 ? 32 + jj : (it == 2 ? 31 - jj : jj));
            __syncthreads();
            const int tid = otid(), lane = tid & 63, l32 = lane & 31, hh = lane >> 5;
            const int kkey = wid * 2 + (lane >> 5);
            const int kseg = (lane & 31) ^ (kkey & 15);
            const int vdv = wid * 8 + (lane >> 3);
            const int vseg = (lane & 7) ^ ((vdv >> 1) & 7);
            const int xk = l32 & 15, yv = (l32 >> 1) & 7;
            if (tid <= 128) {
                const float* rbp_ = rel_bias; asm volatile("" : "+s"(rbp_)); const GAS float* rbp = (const GAS float*)rbp_;
                float val = 0.f;
                if (tid < 128) { int bk = tid; if (tid >= 16) { bk = 16 + (int)(__logf((float)tid * (1.0f / 16.0f)) / 2.0794415416798357f * 16.0f); bk = bk > 31 ? 31 : bk; }
                    val = (rbp[bk * 8 + h] - rbp[31 * 8 + h]) * LOG2E; }
                lut[tid] = val;
            }
            const int q0 = qb * 128, qrow = q0 + 32 * rg + l32;
            const size_t tokbase = (size_t)b * SEQ;
            h16x8 Qf[8];
            { const h16* qp = Qb + (tokbase + qrow) * DM + h * 256 + mp * 128 + hh * 8;
#pragma unroll
              for (int ks = 0; ks < 8; ++ks) Qf[ks] = *(const h16x8*)(qp + ks * 16); }
            f32x16 O[8];
#pragma unroll
            for (int i = 0; i < 8; ++i)
#pragma unroll
                for (int r = 0; r < 16; ++r) O[i][r] = 0.f;
            float mrun = -1e30f, lrun = 0.f;
            const int nkt = 2 * qb + 2;
            const h16* kg = Kb + (tokbase + kkey) * DM + h * 256 + kseg * 8;
            const h16* vg = Vt + ((size_t)((b * 8 + h) * 256) + vdv) * SEQ + vseg * 8;
#define ATT_ISSUE(KT, BUF) do { _Pragma("unroll") for (int _i = 0; _i < 4; ++_i) \
                __builtin_amdgcn_global_load_lds((const unsigned*)(kg + (size_t)(64 * (KT) + 16 * _i) * DM), (LAS unsigned*)((BUF) + (_i * 8 + wid) * 1024), 16, 0, 0); \
              _Pragma("unroll") for (int _i = 0; _i < 4; ++_i) \
                __builtin_amdgcn_global_load_lds((const unsigned*)(vg + (size_t)(64 * _i) * SEQ + 64 * (KT)), (LAS unsigned*)((BUF) + 32768 + (_i * 8 + wid) * 1024), 16, 0, 0); } while (0)
            ATT_ISSUE(0, lds);
            asm volatile("s_waitcnt vmcnt(0)" ::: "memory");
            __syncthreads();
            for (int kt = 0; kt < nkt; ++kt) {
                LAS unsigned char* cb = lds + (kt & 1) * STG; LAS unsigned char* nb = lds + ((kt & 1) ^ 1) * STG;
                const bool near = kt >= 2 * qb - 2;
                if (kt + 1 < nkt) ATT_ISSUE(kt + 1, nb);
#pragma unroll
                for (int kb = 0; kb < 2; ++kb) {
                    if (64 * kt + 32 * kb <= q0 + 32 * rg + 31) {
                        f32x16 S0;
#pragma unroll
                        for (int r = 0; r < 16; ++r) S0[r] = 0.f;
                        LAS unsigned char* ks = cb + (32 * kb + l32) * 512 + mp * 256;
#pragma unroll
                        for (int k = 0; k < 8; ++k) {
                            const h16x8 a0 = *(LAS h16x8*)(ks + (((2 * k + hh) ^ xk) << 4));
                            S0 = __builtin_amdgcn_mfma_f32_32x32x16_f16(a0, Qf[k], S0, 0, 0, 0);
                        }
                        if (near) {
#pragma unroll
                            for (int r = 0; r < 16; ++r) {
                                const int kp = 64 * kt + 32 * kb + (r >> 2) * 8 + hh * 4 + (r & 3); const int d0 = qrow - kp;
                                const int di = d0 < 0 ? 0 : (d0 > 128 ? 128 : d0); const float bv = lut[di];
                                S0[r] = d0 < 0 ? -1e30f : S0[r] + bv;
                            }
                        }
                        float mt = S0[0];
#pragma unroll
                        for (int r = 1; r < 16; ++r) mt = fmaxf(mt, S0[r]);
                        if (__builtin_amdgcn_ballot_w64(mt - mrun > 10.0f) != 0ull) {
                            const float mo = fmaxf(mt, __shfl_xor(mt, 32));
                            const float mn = fmaxf(mrun, mo);
                            const float al = __builtin_amdgcn_exp2f(mrun - mn);
                            mrun = mn; lrun *= al;
#pragma unroll
                            for (int i = 0; i < 8; ++i) O[i] = O[i] * al;
                        }
                        float ps = 0.f;
#pragma unroll
                        for (int r = 0; r < 16; ++r) { S0[r] = __builtin_amdgcn_exp2f(S0[r] - mrun); ps += S0[r]; }
                        lrun += ps;
                        h16x8 P0, P1;
#pragma unroll
                        for (int e = 0; e < 8; ++e) { P0[e] = (h16)S0[e]; P1[e] = (h16)S0[8 + e]; }
                        LAS unsigned char* vs = cb + 32768 + l32 * 128;
                        const int vo0 = ((4 * kb + hh) ^ yv) << 4, vo1 = ((4 * kb + 2 + hh) ^ yv) << 4;
#pragma unroll
                        for (int dvb = 0; dvb < 8; ++dvb) {
                            const h16x8 a = *(LAS h16x8*)(vs + dvb * 4096 + vo0);
                            O[dvb] = __builtin_amdgcn_mfma_f32_32x32x16_f16(a, P0, O[dvb], 0, 0, 0);
                        }
#pragma unroll
                        for (int dvb = 0; dvb < 8; ++dvb) {
                            const h16x8 a = *(LAS h16x8*)(vs + dvb * 4096 + vo1);
                            O[dvb] = __builtin_amdgcn_mfma_f32_32x32x16_f16(a, P1, O[dvb], 0, 0, 0);
                        }
                    }
                }
                asm volatile("s_waitcnt vmcnt(0)" ::: "memory");
                __syncthreads();
            }
#undef ATT_ISSUE
            lrun += __shfl_xor(lrun, 32);
            const float inv = 1.0f / lrun;
            const int lane2 = otid() & 63, l32b = lane2 & 31, hhb = lane2 >> 5;
            const int obase = (rg * 8) * 16 * 64 + lane2;
            if (mp == 1) {
                float lf;
                { const float* lmp_ = lam; asm volatile("" : "+s"(lmp_)); const GAS float* lmp = (const GAS float*)lmp_;
                  float s1 = 0.f, s2 = 0.f; for (int i = lane2; i < 128; i += 64) { s1 += lmp[i] * lmp[128 + i]; s2 += lmp[256 + i] * lmp[384 + i]; }
                  s1 = wave_sum(s1); s2 = wave_sum(s2); lf = __expf(s1) - __expf(s2) + lambda_init; }
                const float sc = inv * lf;
#pragma unroll
                for (int dvb = 0; dvb < 8; ++dvb)
#pragma unroll
                    for (int r = 0; r < 16; ++r) osh[obase + (dvb * 16 + r) * 64] = O[dvb][r] * sc;
            }
            __syncthreads();
            if (mp == 0) {
                const float* sgp_ = subg; asm volatile("" : "+s"(sgp_)); const GAS float* sgp = (const GAS float*)sgp_;
                float ss = 0.f;
#pragma unroll
                for (int dvb = 0; dvb < 8; ++dvb)
#pragma unroll
                    for (int r = 0; r < 16; ++r) { const float o = O[dvb][r] * inv - osh[obase + (dvb * 16 + r) * 64]; O[dvb][r] = o; ss += o * o; }
                ss += __shfl_xor(ss, 32);
                const float rms = rsqrtf(ss * (1.0f / 256.0f) + 1e-5f) * (1.0f - lambda_init);
                h16* op = AO + ((size_t)b * SEQ + q0 + 32 * rg + l32b) * DM + h * 256 + hhb * 4;
#pragma unroll
                for (int dvb = 0; dvb < 8; ++dvb)
#pragma unroll
                    for (int rq = 0; rq < 4; ++rq) {
                        const int dv0 = dvb * 32 + rq * 8;
                        const f32x4 sg = *(const GAS f32x4*)(sgp + dv0 + hhb * 4);
                        h16x4 o = {(h16)(O[dvb][rq * 4 + 0] * rms * sg[0]), (h16)(O[dvb][rq * 4 + 1] * rms * sg[1]), (h16)(O[dvb][rq * 4 + 2] * rms * sg[2]), (h16)(O[dvb][rq * 4 + 3] * rms * sg[3])};
                        *(h16x4*)(op + dv0) = o;
                    }
            }
        }
    }
}

#define XB_TMO      128
#define XB_XCNT(j)  (256  + 64 * (j))
#define XB_XSUB(j)  (1280 + 64 * (j))
#define XB_XGEN(j)  (2304 + 64 * (j))
#define XB_TOP      3328
#define XB_TOPGEN   3392
#define XCD_BAR_WORDS 3456
#define XB_SPIN_CAP (1u << 18)

__device__ __forceinline__ unsigned xb_ld(unsigned* p)              { return __hip_atomic_load(p, __ATOMIC_RELAXED, __HIP_MEMORY_SCOPE_AGENT); }
__device__ __forceinline__ unsigned xb_add(unsigned* p, unsigned v) { return __hip_atomic_fetch_add(p, v, __ATOMIC_RELAXED, __HIP_MEMORY_SCOPE_AGENT); }
__device__ __forceinline__ unsigned xb_xcc_id() { return (unsigned)__builtin_amdgcn_s_getreg((3 << 11) | 20) & 0xFu; }
#define XB_SPIN(cond, bar) do { unsigned _sp = 0; while (cond) { __builtin_amdgcn_s_sleep(1); \
    if ((++_sp & 255u) == 0u) { if (xb_ld(&(bar)[XB_TMO])) break; if (_sp > XB_SPIN_CAP) { atomicAdd(&(bar)[XB_TMO], 1u); break; } } } } while (0)

struct XcdBarrier {
    unsigned* bar; unsigned x;
    volatile LAS unsigned* st;
};

__device__ __forceinline__ XcdBarrier xcd_barrier_post(unsigned* bar, volatile LAS unsigned* st) {
    XcdBarrier b; b.bar = bar; b.x = xb_xcc_id(); b.st = st;
    if (threadIdx.x == 0) (void)xb_add(&bar[XB_XCNT(b.x)], 1u);
    return b;
}
__device__ __forceinline__ void xcd_barrier_complete(unsigned* bar, unsigned x, unsigned& nloc, unsigned& nx) {
    const unsigned G = gridDim.x * gridDim.y * gridDim.z;
    unsigned sum, cnt, mine, sp = 0u;
    for (;;) {
        sum = 0u; cnt = 0u; mine = 0u;
#pragma unroll
        for (unsigned j = 0; j < 16; ++j) { const unsigned c = xb_ld(&bar[XB_XCNT(j)]); sum += c; cnt += (c > 0u) ? 1u : 0u; mine = (j == x) ? c : mine; }
        if (sum == G) break;
        __builtin_amdgcn_s_sleep(1);
        if ((++sp & 255u) == 0u) { if (xb_ld(&bar[XB_TMO])) break; if (sp > XB_SPIN_CAP) { atomicAdd(&bar[XB_TMO], 1u); break; } }
    }
    nloc = mine > 0u ? mine : 1u; nx = cnt > 0u ? cnt : 1u;
}

__device__ __forceinline__ void xcd_barrier(const XcdBarrier& b) {
    asm volatile("s_waitcnt vmcnt(0)" ::: "memory");
    __syncthreads();
    if (threadIdx.x == 0) {
        unsigned* bar = b.bar;
        __builtin_amdgcn_s_waitcnt(0);
        unsigned nloc = b.st[0], nx = b.st[1];
        if (nloc == 0u) { xcd_barrier_complete(bar, b.x, nloc, nx); b.st[0] = nloc; b.st[1] = nx; }
        const unsigned old = xb_add(&bar[XB_XSUB(b.x)], 1u);
        const unsigned gen = old / nloc;
        if (old + 1u == (gen + 1u) * nloc) {
            __builtin_amdgcn_fence(__ATOMIC_RELEASE, "agent");
            asm volatile("s_waitcnt vmcnt(0)" ::: "memory");
            const unsigned og = xb_add(&bar[XB_TOP], 1u);
            const unsigned tg = og / nx;
            if (og + 1u == (tg + 1u) * nx) xb_add(&bar[XB_TOPGEN], 1u);
            else XB_SPIN(xb_ld(&bar[XB_TOPGEN]) == tg, bar);
            __builtin_amdgcn_fence(__ATOMIC_ACQUIRE, "agent");
            xb_add(&bar[XB_XGEN(b.x)], 1u);
            asm volatile("s_waitcnt vmcnt(0)" ::: "memory");
        } else {
            XB_SPIN(xb_ld(&bar[XB_XGEN(b.x)]) == gen, bar);
            __builtin_amdgcn_fence(__ATOMIC_ACQUIRE, "agent");
            asm volatile("s_waitcnt vmcnt(0)" ::: "memory");
        }
    }
    __syncthreads();
}


__device__ __forceinline__ void gbar(unsigned* ctr, unsigned target) {
    asm volatile("s_waitcnt vmcnt(0)" ::: "memory");
    __syncthreads();
    if (threadIdx.x == 0) {
        __builtin_amdgcn_fence(__ATOMIC_RELEASE, "agent");
        asm volatile("s_waitcnt vmcnt(0)" ::: "memory");
        __hip_atomic_fetch_add(ctr, 1u, __ATOMIC_RELAXED, __HIP_MEMORY_SCOPE_AGENT);
        while (__hip_atomic_load(ctr, __ATOMIC_RELAXED, __HIP_MEMORY_SCOPE_AGENT) < target) __builtin_amdgcn_s_sleep(1);
        __builtin_amdgcn_fence(__ATOMIC_ACQUIRE, "agent");
        asm volatile("s_waitcnt vmcnt(0)" ::: "memory");
    }
    __syncthreads();
}

#ifndef ONLY_GI
#define ENG(k) true
#else
#define ENG(k) ((k) == ONLY_GI)
#endif
#ifndef ONLY_KIND
#define EN(k) true
#else
#define EN(k) ((k) == ONLY_KIND)
#endif
__global__ void __launch_bounds__(512, 2) fwd_megakernel(Params p) {
    extern __shared__ __attribute__((aligned(16))) unsigned char shm[];
    LAS unsigned char* lds = (LAS unsigned char*)shm;
    cg::grid_group grid = cg::this_grid();
    unsigned char* ws = p.ws;
    h16* PRE = (h16*)(ws + WS_PRE); h16* XH = (h16*)(ws + WS_XH); h16* VF = (h16*)(ws + WS_VF);
    unsigned char* R1 = ws + WS_R1; unsigned char* R2 = ws + WS_R2; float* Y = (float*)(ws + WS_Y);
    h16* MIX = (h16*)R1; h16* SIDE = (h16*)R1; h16* AO = (h16*)R1;
    h16* DEC = (h16*)(R1 + R1_DEC); h16* Ab = (h16*)(R1 + R1_A); h16* Gb = (h16*)(R1 + R1_G); h16* AA = (h16*)(R1 + R1_AA); h16* YG = (h16*)(R1 + R1_YG);
    h16* C1 = (h16*)R2; h16* ACT = (h16*)R2; h16* Qb = (h16*)R2; h16* Kb = Qb + (size_t)MTOK * DM; h16* Vt = Kb + (size_t)MTOK * DM;

    volatile LAS unsigned* xst = (volatile LAS unsigned*)(lds + LDS_BYTES - 16);
    if (threadIdx.x == 0) { xst[0] = 0u; xst[1] = 0u; }
    __syncthreads();
    const XcdBarrier xb = xcd_barrier_post((unsigned*)(ws + WS_BAR), xst);
    for (int ph = p.ph_lo; ph < p.ph_hi; ++ph) {
        int layer, kind;
        if (ph < 11) { layer = 0; kind = (int)((0xDCBA9854210ull >> (4 * ph)) & 15ull); }
        else if (ph < 19) { layer = 1; kind = (int)((0xDCBA9876ull >> (4 * (ph - 11))) & 15ull); }
        else if (ph < 29) { layer = 2; kind = (int)((0xDCBA985421ull >> (4 * (ph - 19))) & 15ull); }
        else { layer = 3; kind = (int)((0xDCBA9876ull >> (4 * (ph - 29))) & 15ull); }
        const int j = layer >> 1;
        const char* W = (const char*)(ws + ((layer & 1) ? WS_X : WS_W16));
        const h16* wB1 = (const h16*)(W + W_B1); const h16* wB2 = (const h16*)(W + W_B2); const h16* wWO = (const h16*)(W + W_WO);
        const h16* wUP = (const h16*)(W + W_UP); const h16* wDN = (const h16*)(W + W_DN);
        const int nrep = ((PROBE_MASK >> kind) & 1) ? 2 : 1;
        for (int rep = 0; rep < nrep; ++rep)
        switch (kind) {
        case 0: if (EN(0)) {
            cvt_layer(lds, p, 0);
            ln_phase<false>(p.in[0], nullptr, nullptr, nullptr, XH, p.in[3], MIX);
        } break;
        case 1: if (EN(1)) {
            AMapMix am{(const char*)MIX}; EpiG1 e{C1, j == 0 ? VF : nullptr};
            pg8::gemm_phase(lds, am, DM, wB1, DM, MTOK, j == 0 ? 6912 : 7168, DM, e);
        } break;
        case 2: if (EN(2)) {
            const float* w0 = p.in[5] + (size_t)j * DM; const float* a0 = p.in[8] + (size_t)j * DM; const float* v0 = p.in[11] + (size_t)(j > 0 ? j - 1 : 0) * DM;
            int k2 = 128; asm volatile("" : "+s"(k2));
            if (ENG(0)) { AMapOne am{(const char*)(C1 + 6144)}; EpiG2<0> e{DEC, Ab, Gb, C1, VF, w0, a0, v0, AA, p.in[16] + (size_t)j * DM, p.in[17] + (size_t)j * DM}; pg8::gemm_phase(lds, am, LDC1, wB2, 256, MTOK, DM, k2, e); }
            if (ENG(1)) { AMapOne am{(const char*)(C1 + 6400)}; EpiG2<1> e{DEC, Ab, Gb, C1, VF, w0, a0, v0, AA, p.in[16] + (size_t)j * DM, p.in[17] + (size_t)j * DM}; pg8::gemm_phase(lds, am, LDC1, wB2 + (size_t)2048 * 256, 256, MTOK, DM, k2, e); }
            if (ENG(2)) { AMapOne am{(const char*)(C1 + 6656)}; EpiG2<2> e{DEC, Ab, Gb, C1, VF, w0, a0, v0, AA, p.in[16] + (size_t)j * DM, p.in[17] + (size_t)j * DM}; pg8::gemm_phase(lds, am, LDC1, wB2 + (size_t)4096 * 256, 256, MTOK, DM, k2, e); }
            if (ENG(3) && j > 0) { AMapOne am{(const char*)(C1 + 6912)}; EpiG2<3> e{DEC, Ab, Gb, C1, VF, w0, a0, v0, AA, p.in[16] + (size_t)j * DM, p.in[17] + (size_t)j * DM}; pg8::gemm_phase(lds, am, LDC1, wB2 + (size_t)6144 * 256, 256, MTOK, DM, k2, e); }
        } break;
        case 3: if (EN(3)) prep_phase(C1, Ab, AA, VF, p.in[16] + (size_t)j * DM, p.in[17] + (size_t)j * DM, j == 0); break;
        case 4: if (EN(4)) scan_phase(lds, C1, DEC, AA, Ab, Y, p.in[22] + (size_t)j * DM * 6144, p.in[25] + (size_t)j * DM * DM, p.in[27] + (size_t)(layer + 1) * DM * 2 * FF, p.in[30] + (size_t)(layer + 1) * FF * DM, (char*)(ws + WS_X),
                                       p.in[27] + (size_t)layer * DM * 2 * FF, p.in[30] + (size_t)layer * FF * DM, (char*)(ws + WS_W16)); break;
        case 5: if (EN(5)) gn_phase(Y, C1, Gb, YG, p.in[18] + (size_t)j * DM, p.in[19] + (size_t)j * DM, p.in[20] + (size_t)j * DM, nullptr); break;
        case 6: if (EN(6)) {
            AMapOne am{(const char*)XH}; EpiQKV e{Qb, Kb, Vt};
            pg8::gemm_phase(lds, am, DM, wB1, DM, MTOK, 6144, DM, e);
        } break;
        case 7: if (EN(7)) {
            const float li = layer == 1 ? 0.35550906759096926f : 0.5560581861995943f;
            attn_phase(lds, Qb, Kb, Vt, AO, p.in[26], p.in[23] + (size_t)j * 512, p.in[24] + (size_t)j * 256, li);
        } break;
        case 8: if (EN(8)) {
            AMapOne am{(const char*)((layer & 1) ? AO : YG)}; EpiRes e{XH, PRE};
            pg8::gemm_phase(lds, am, DM, wWO, DM, MTOK, DM, DM, e);
        } break;
        case 9: case 13: if (EN(9)) {
            const int sub = kind == 9 ? 0 : 1;
            const float* g = p.in[1] + (size_t)(layer * 2 + sub) * DM; const float* bt = p.in[2] + (size_t)(layer * 2 + sub) * DM;
            float* xo = nullptr; h16* xh = XH; const float* mu = nullptr; h16* mx = nullptr;
            if (kind == 13) {
                if (layer == 3) { xo = p.out; xh = nullptr; }
                else {
                    if (layer == 1) cvt_layer(lds, p, layer + 1);
                    if (layer == 1) { mu = p.in[3] + (size_t)1 * 6 * DM; mx = MIX; }
                }
            }
            ln_phase<true>(PRE, g, bt, xo, xh, mu, mx);
        } break;
        case 10: if (EN(10)) {
            AMapOne am{(const char*)XH}; EpiUpConv e{ACT, SIDE, p.in[28] + (size_t)layer * 3 * FF, p.in[29] + (size_t)layer * FF};
            pg8::gemm_phase(lds, am, DM, wUP, DM, MTOK, 2 * FF, DM, e);
        } break;
        case 11: if (EN(11)) convfix_phase(SIDE, ACT, p.in[28] + (size_t)layer * 3 * FF, p.in[29] + (size_t)layer * FF); break;
        case 12: if (EN(12)) {
            AMapOne am{(const char*)ACT}; EpiRes e{XH, PRE};
            pg8::gemm_phase(lds, am, FF, wDN, FF, MTOK, DM, FF, e);
        } break;
        }
        if (ph + 1 < p.ph_hi) {
            if (p.ph_lo < 0) grid.sync();
            else xcd_barrier(xb);
        }
    }
}

constexpr int NPHASES = 37;

extern "C" void kernel_launch(void* const* d_in, const int* in_sizes, int n_in, void* d_out, int out_size, void* d_ws, size_t ws_size, hipStream_t stream) {
    static int grid_blocks = 0;
    if (!grid_blocks) {
        if (n_in != 31 || ws_size < WS_END) { fprintf(stderr, "kernel_launch: unexpected n_in %d / ws_size %zu (need %zu)\n", n_in, ws_size, (size_t)WS_END); grid_blocks = -1; return; }
        int dev = 0, cus = 0, per_cu = 0;
        hipGetDevice(&dev);
        hipDeviceGetAttribute(&cus, hipDeviceAttributeMultiprocessorCount, dev);
        if (hipFuncSetAttribute((const void*)fwd_megakernel, hipFuncAttributeMaxDynamicSharedMemorySize, LDS_BYTES) != hipSuccess) { fprintf(stderr, "kernel_launch: hipFuncSetAttribute failed\n"); grid_blocks = -1; return; }
        if (hipOccupancyMaxActiveBlocksPerMultiprocessor(&per_cu, (const void*)fwd_megakernel, 512, LDS_BYTES) != hipSuccess || per_cu < 1) { fprintf(stderr, "kernel_launch: occupancy query gave %d\n", per_cu); per_cu = 1; (void)hipGetLastError(); }
        grid_blocks = cus * per_cu;
        if (grid_blocks > 256) grid_blocks = 256;
    }
    if (grid_blocks < 0) return;
    Params p{};
    for (int i = 0; i < 31; ++i) p.in[i] = (const float*)d_in[i];
    p.out = (float*)d_out; p.ws = (unsigned char*)d_ws; p.ph_lo = 0; p.ph_hi = NPHASES;
    if (hipMemsetAsync((char*)d_ws + WS_BAR, 0, 16384, stream) != hipSuccess) { fprintf(stderr, "kernel_launch: memset failed\n"); return; }
    void* args[] = {&p};
    hipError_t e = hipLaunchCooperativeKernel((const void*)fwd_megakernel, dim3(grid_blocks), dim3(512), args, LDS_BYTES, stream);
    if (e != hipSuccess) fprintf(stderr, "cooperative launch failed: %s (grid %d)\n", hipGetErrorString(e), grid_blocks);
}
```

```cpp
#include <hip/hip_runtime.h>
#include <hip/hip_cooperative_groups.h>
#include <cstdio>
namespace cg = cooperative_groups;

#define LAS __attribute__((address_space(3)))
#define GAS __attribute__((address_space(1)))
typedef _Float16 h16;
typedef _Float16 h16x8 __attribute__((ext_vector_type(8)));
typedef _Float16 h16x4 __attribute__((ext_vector_type(4)));
typedef float f32x4 __attribute__((ext_vector_type(4)));
typedef float f32x2 __attribute__((ext_vector_type(2)));
typedef float f32x16 __attribute__((ext_vector_type(16)));
typedef unsigned u32x4 __attribute__((ext_vector_type(4)));

constexpr int MTOK = 16384, DM = 2048, SEQ = 8192, FF = 5504, LDC1 = 7168;
constexpr float ALPHA = 1.681792830507429f;
constexpr float LOG2E = 1.4426950408889634f;
constexpr float QSCALE = 0.08838834764831845f * LOG2E;
constexpr int LDS_BYTES = 157696;
#define PROBE_MASK 0x0000

constexpr size_t W_B1 = 0, W_B2 = 29360128, W_WO = 33554432, W_UP = 41943040, W_DN = 87031808;
constexpr size_t WS_W16 = 0, WS_X = 117440512, WS_PRE = WS_X + 134217728, WS_XH = WS_PRE + 134217728, WS_VF = WS_XH + 67108864,
                 WS_R1 = WS_VF + 67108864, WS_R2 = WS_R1 + 402653184, WS_Y = WS_R2 + 234881024, WS_BAR = WS_Y + 134217728, WS_END = WS_BAR + 16384;
constexpr size_t R1_DEC = 0, R1_A = 134217728, R1_G = R1_A + 67108864, R1_AA = R1_G + 67108864, R1_YG = R1_AA + 67108864;

struct Params {
    const float* in[31];
    float* out;
    unsigned char* ws;
    int ph_lo, ph_hi;
};

__device__ __forceinline__ int otid() { int t = (int)threadIdx.x; asm volatile("" : "+v"(t)); return t; }
__device__ __forceinline__ int obid() { int t = (int)blockIdx.x; asm volatile("" : "+s"(t)); return t; }
template <int CTRL> __device__ __forceinline__ float dpp_f(float x) { return __int_as_float(__builtin_amdgcn_update_dpp(0, __float_as_int(x), CTRL, 0xF, 0xF, true)); }
__device__ __forceinline__ float row16_sum(float x) { x += dpp_f<0xB1>(x); x += dpp_f<0x4E>(x); x += dpp_f<0x141>(x); x += dpp_f<0x140>(x); return x; }
__device__ __forceinline__ float grp16_sum(float x) { return row16_sum(x); }
__device__ __forceinline__ float wave_sum(float x) { x = row16_sum(x); x += __shfl_xor(x, 16); x += __shfl_xor(x, 32); return x; }
__device__ __forceinline__ float sigmoidf_(float x) { return 1.0f / (1.0f + __expf(-x)); }

namespace pg8 {
constexpr int BM = 256, BK = 64, HALF = 128, HTB = HALF * BK * 2, NXCD = 8, WGM = 4;
__device__ __forceinline__ int lds_byte(int r, int c) { const int st = (r >> 4) * 2 + (c >> 5), rr = r & 15, cc = c & 31, ob = rr * 64 + cc * 2; return st * 1024 + (ob ^ (((ob >> 9) & 1) << 5)); }
__device__ __forceinline__ void stage_rc(int b, int& R, int& C) { const int st = b / 1024, sb = b % 1024, swz = sb ^ (((sb >> 9) & 1) << 5); R = (st >> 1) * 16 + swz / 64; C = (st & 1) * 32 + (swz % 64) / 2; }
__device__ __forceinline__ int perm32(int rho) { const int n = rho >> 4, i = rho & 15; return 8 * (i >> 2) + 4 * n + (i & 3); }
struct Unit { int pm, pn; };
struct Order {
    int nM, nN, nwg, G, c;
    __device__ void init(int M, int N, int G_, int c_) { nM = M / BM; nN = N / BM; nwg = nM * nN; G = G_; c = c_; }
    __device__ bool next(int i, Unit& u) const {
        const long L = (long)i * G + c; if (L >= nwg) return false;
        int wgid = (int)L; { const int q = nwg / NXCD, r = nwg % NXCD, xcd = wgid % NXCD, off = wgid / NXCD; wgid = (xcd < r ? xcd * (q + 1) : r * (q + 1) + (xcd - r) * q) + off; }
        const int nig = WGM * nN, gid = wgid / nig, fm = gid * WGM, gsz = (nM - fm) < WGM ? (nM - fm) : WGM;
        u.pm = fm + ((wgid % nig) % gsz); u.pn = (wgid % nig) / gsz; return true;
    }
};

template <class Epi, class AMap>
__device__ __forceinline__ void gemm_phase(LAS unsigned char* lds, const AMap am, const int lda, const h16* Bt, const int ldb, const int M, const int N, const int K, const Epi& E) {
    const int tid = otid(), wid = __builtin_amdgcn_readfirstlane(tid >> 6), lane = tid & 63, wr = wid >> 2, wc = wid & 3, fr = lane & 15, fq = lane >> 4;
    const int nt = K / BK;
    Order S; S.init(M, N, (int)gridDim.x, obid());
    unsigned voffA[2], voffB[2];
#pragma unroll
    for (int i = 0; i < 2; ++i) { int R, C; stage_rc(tid * 16 + i * 8192, R, C); const int Rb = Epi::PERM ? ((R & ~31) + perm32(R & 31)) : R;
        voffA[i] = (unsigned)(R * lda + C) * 2u; voffB[i] = (unsigned)(Rb * ldb + C) * 2u; }
    const size_t kstep = (size_t)(BK * 2);
    const size_t hstepA = (size_t)HALF * lda * 2, hstepB = (size_t)HALF * ldb * 2;
    const size_t tstepA = 2 * hstepA, tstepB = 2 * hstepB;
    const unsigned ldsw = (unsigned)wid * 1024u;
    const int aoff = lds_byte(wr * 64 + fr, fq * 8), boff = lds_byte(wc * 32 + fr, fq * 8);
#define PG8_SA(b, h) (((b) * 2 + (h)) * HTB)
#define PG8_SB(b, h) ((4 + (b) * 2 + (h)) * HTB)
#define PG8_STAGE(bufoff, gbase, voff) do { _Pragma("unroll") for (int _i = 0; _i < 2; ++_i) \
        __builtin_amdgcn_global_load_lds((const unsigned*)((const char*)(gbase) + (voff)[_i]), (LAS unsigned*)(lds + (bufoff) + ldsw + _i * 8192), 16, 0, 0); } while (0)
#define PG8_LDA(dst, b, h) do { _Pragma("unroll") for (int m = 0; m < 4; ++m) _Pragma("unroll") for (int k = 0; k < 2; ++k) dst[m][k] = *(const LAS h16x8*)(lds + PG8_SA(b, h) + aoff + m * 2048 + k * 1024); } while (0)
#define PG8_LDB(dst, b, h) do { _Pragma("unroll") for (int n = 0; n < 2; ++n) _Pragma("unroll") for (int k = 0; k < 2; ++k) dst[n][k] = *(const LAS h16x8*)(lds + PG8_SB(b, h) + boff + n * 2048 + k * 1024); } while (0)
#define PG8_MMA(ai, bj, At, Bt_) do { __builtin_amdgcn_s_setprio(1); _Pragma("unroll") for (int m = 0; m < 4; ++m) _Pragma("unroll") for (int n = 0; n < 2; ++n) _Pragma("unroll") for (int k = 0; k < 2; ++k) \
        acc[ai][bj][m][n] = __builtin_amdgcn_mfma_f32_16x16x32_f16(Bt_[n][k], At[m][k], acc[ai][bj][m][n], 0, 0, 0); __builtin_amdgcn_s_setprio(0); } while (0)
#define PG8_WAIT_V(n) asm volatile("s_waitcnt vmcnt(" #n ")" ::: "memory")
#define PG8_WAIT_L(n) asm volatile("s_waitcnt lgkmcnt(" #n ")" ::: "memory")
#define PG8_BAR __builtin_amdgcn_s_barrier()
#define PG8_SCHED __builtin_amdgcn_sched_barrier(0)
    Unit cur, nxt; int ui = 0;
    if (!S.next(0, cur)) return;
    f32x4 acc[2][2][4][2];
#pragma unroll
    for (int a = 0; a < 2; ++a)
#pragma unroll
        for (int b = 0; b < 2; ++b)
#pragma unroll
            for (int m = 0; m < 4; ++m)
#pragma unroll
                for (int n = 0; n < 2; ++n) acc[a][b][m][n] = (f32x4){0.f, 0.f, 0.f, 0.f};
    h16x8 At[4][2], B0[2][2], B1[2][2];
    const char* cA = am(cur.pn) + (size_t)cur.pm * tstepA; const char* cB = (const char*)Bt + (size_t)cur.pn * tstepB;
    PG8_STAGE(PG8_SB(0, 0), cB, voffB); PG8_STAGE(PG8_SA(0, 0), cA, voffA); PG8_STAGE(PG8_SB(0, 1), cB + hstepB, voffB); PG8_STAGE(PG8_SA(0, 1), cA + hstepA, voffA);
    if (wr == 1) PG8_BAR;
    PG8_WAIT_V(4); PG8_BAR;
    PG8_STAGE(PG8_SB(1, 0), cB + kstep, voffB); PG8_STAGE(PG8_SA(1, 0), cA + kstep, voffA); PG8_STAGE(PG8_SB(1, 1), cB + hstepB + kstep, voffB);
    PG8_WAIT_V(6); PG8_BAR;
    for (;;) {
        const bool has_next = S.next(ui + 1, nxt);
        const char* nA = has_next ? am(nxt.pn) + (size_t)nxt.pm * tstepA : cA; const char* nB = has_next ? (const char*)Bt + (size_t)nxt.pn * tstepB : cB;
#pragma unroll 1
        for (int t = 0; t < nt; t += 2) {
            const bool last = (t == nt - 2);
            const char* a1 = cA + (size_t)(t + 1) * kstep;
            const char* a2 = last ? nA : cA + (size_t)(t + 2) * kstep; const char* b2 = last ? nB : cB + (size_t)(t + 2) * kstep;
            const char* a3 = a2 + kstep; const char* b3 = b2 + kstep;
            PG8_LDB(B0, 0, 0); PG8_SCHED; PG8_LDA(At, 0, 0); PG8_STAGE(PG8_SA(1, 1), a1 + hstepA, voffA);
            PG8_WAIT_L(8); PG8_BAR; PG8_WAIT_L(0); PG8_MMA(0, 0, At, B0); PG8_BAR; PG8_SCHED;
            PG8_LDB(B1, 0, 1); PG8_STAGE(PG8_SB(0, 0), b2, voffB);
            PG8_BAR; PG8_WAIT_L(0); PG8_MMA(0, 1, At, B1); PG8_BAR;
            PG8_LDA(At, 0, 1); PG8_STAGE(PG8_SA(0, 0), a2, voffA);
            PG8_BAR; PG8_WAIT_L(0); PG8_MMA(1, 0, At, B0); PG8_BAR; PG8_SCHED;
            PG8_STAGE(PG8_SB(0, 1), b2 + hstepB, voffB);
            PG8_WAIT_V(6); PG8_BAR; PG8_MMA(1, 1, At, B1); PG8_BAR;
            PG8_LDB(B0, 1, 0); PG8_SCHED; PG8_LDA(At, 1, 0); PG8_STAGE(PG8_SA(0, 1), a2 + hstepA, voffA);
            PG8_WAIT_L(8); PG8_BAR; PG8_WAIT_L(0); PG8_MMA(0, 0, At, B0); PG8_BAR; PG8_SCHED;
            PG8_LDB(B1, 1, 1); PG8_STAGE(PG8_SB(1, 0), b3, voffB);
            PG8_BAR; PG8_WAIT_L(0); PG8_MMA(0, 1, At, B1); PG8_BAR;
            PG8_LDA(At, 1, 1); PG8_STAGE(PG8_SA(1, 0), a3, voffA);
            PG8_BAR; PG8_WAIT_L(0); PG8_MMA(1, 0, At, B0); PG8_BAR; PG8_SCHED;
            PG8_STAGE(PG8_SB(1, 1), b3 + hstepB, voffB);
            PG8_WAIT_V(6); PG8_BAR; PG8_MMA(1, 1, At, B1); PG8_BAR;
        }
        E(acc, cur, wr, wc, fr, fq);
        if (!has_next) break;
#pragma unroll
        for (int a = 0; a < 2; ++a)
#pragma unroll
            for (int b = 0; b < 2; ++b)
#pragma unroll
                for (int m = 0; m < 4; ++m)
#pragma unroll
                    for (int n = 0; n < 2; ++n) acc[a][b][m][n] = (f32x4){0.f, 0.f, 0.f, 0.f};
        cur = nxt; cA = nA; cB = nB; ++ui;
    }
    PG8_WAIT_V(0);
    if (wr == 0) PG8_BAR;
    PG8_BAR;
#undef PG8_SA
#undef PG8_SB
#undef PG8_STAGE
#undef PG8_LDA
#undef PG8_LDB
#undef PG8_MMA
#undef PG8_WAIT_V
#undef PG8_WAIT_L
#undef PG8_BAR
#undef PG8_SCHED
}
}
using pg8::Unit;

__device__ __forceinline__ u32x4 pack8(f32x4 a, f32x4 b) {
    h16x8 v = {(h16)a[0], (h16)a[1], (h16)a[2], (h16)a[3], (h16)b[0], (h16)b[1], (h16)b[2], (h16)b[3]};
    return __builtin_bit_cast(u32x4, v);
}

struct AMapOne { const char* A; __device__ __forceinline__ const char* operator()(int) const { return A; } };
struct AMapMix {
    const char* A;
    __device__ __forceinline__ const char* operator()(int pn) const {
        int idx; if (pn < 8) idx = 0; else if (pn < 16) idx = 2; else if (pn < 24) idx = 3; else if (pn == 24) idx = 1; else if (pn == 25) idx = 4; else if (pn == 26) idx = 5; else idx = 3;
        return A + (size_t)idx * ((size_t)MTOK * DM * 2);
    }
};
struct AMapLora {
    const char* C1;
    __device__ __forceinline__ const char* operator()(int pn) const { return C1 + (size_t)(6144 + 256 * (pn >> 3)) * 2; }
};

#define EPI_ROWS_PERM  const int row0 = u.pm * 256 + wr * 64 + fr; const int colt = u.pn * 256 + wc * 32 + 8 * fq;
struct EpiH16 {
    static constexpr bool PERM = true;
    h16* O; int ldc;
    __device__ __forceinline__ void operator()(const f32x4 (&acc)[2][2][4][2], const Unit& u, int wr, int wc, int fr, int fq) const {
        EPI_ROWS_PERM
#pragma unroll
        for (int ai = 0; ai < 2; ++ai)
#pragma unroll
            for (int m = 0; m < 4; ++m) { h16* rowp = O + (size_t)(row0 + ai * 128 + m * 16) * ldc + colt;
#pragma unroll
                for (int bj = 0; bj < 2; ++bj) *(u32x4*)(rowp + bj * 128) = pack8(acc[ai][bj][m][0], acc[ai][bj][m][1]); }
    }
};
struct EpiG1 {
    static constexpr bool PERM = true;
    h16* O; h16* VFw;
    __device__ __forceinline__ void operator()(const f32x4 (&acc)[2][2][4][2], const Unit& u, int wr, int wc, int fr, int fq) const {
        EPI_ROWS_PERM
        const int mode = u.pn == 24 ? 1 : (u.pn == 26 ? 2 : 0);
        const bool vtile = VFw != nullptr && u.pn >= 16 && u.pn < 24;
#pragma unroll
        for (int ai = 0; ai < 2; ++ai)
#pragma unroll
            for (int m = 0; m < 4; ++m) { h16* rowp = O + (size_t)(row0 + ai * 128 + m * 16) * LDC1 + colt;
#pragma unroll
                for (int bj = 0; bj < 2; ++bj) { f32x4 v0 = acc[ai][bj][m][0], v1 = acc[ai][bj][m][1];
                    if (mode == 1) {
#pragma unroll
                        for (int j = 0; j < 4; ++j) { v0[j] = 1.0f - 2.0f / (1.0f + __expf(2.0f * v0[j])); v1[j] = 1.0f - 2.0f / (1.0f + __expf(2.0f * v1[j])); } }
                    else if (mode == 2) {
#pragma unroll
                        for (int j = 0; j < 4; ++j) { v0[j] = sigmoidf_(v0[j]); v1[j] = sigmoidf_(v1[j]); } }
                    const u32x4 pk = pack8(v0, v1);
                    *(u32x4*)(rowp + bj * 128) = pk;
                    if (vtile) *(u32x4*)(VFw + (size_t)(row0 + ai * 128 + m * 16) * DM + (colt - 4096) + bj * 128) = pk; } }
    }
};
template <int GI_> struct EpiG2 {
    static constexpr bool PERM = true;
    h16* DEC; h16* Ab; h16* Gb; h16* C1; const h16* VF; const float* w0; const float* a0; const float* v0; h16* AA; const float* k_k; const float* k_a;
    template <int GI>
    __device__ __forceinline__ void body(const f32x4 (&acc)[2][2][4][2], int row0, int colt) const {
#pragma unroll
        for (int bj = 0; bj < 2; ++bj) {
            const int c = colt + bj * 128;
            f32x4 b0 = (f32x4){0.f, 0.f, 0.f, 0.f}, b1 = b0;
            if (GI == 0) { b0 = *(const f32x4*)(w0 + c); b1 = *(const f32x4*)(w0 + c + 4); }
            else if (GI == 1) { b0 = *(const f32x4*)(a0 + c); b1 = *(const f32x4*)(a0 + c + 4); }
            else if (GI == 3) { b0 = *(const f32x4*)(v0 + c); b1 = *(const f32x4*)(v0 + c + 4); }
#pragma unroll
            for (int ai = 0; ai < 2; ++ai)
#pragma unroll
                for (int m = 0; m < 4; ++m) {
                    const size_t row = (size_t)(row0 + ai * 128 + m * 16);
                    f32x4 x0 = acc[ai][bj][m][0] + b0, x1 = acc[ai][bj][m][1] + b1;
                    if (GI == 0) {
#pragma unroll
                        for (int j = 0; j < 4; ++j) {
                            x0[j] = 0.6065306597126334f * sigmoidf_(x0[j]); x1[j] = 0.6065306597126334f * sigmoidf_(x1[j]); }
                        *(u32x4*)(DEC + row * DM + c) = pack8(x0, x1);
                    } else if (GI == 1) {
#pragma unroll
                        for (int j = 0; j < 4; ++j) { x0[j] = sigmoidf_(x0[j]); x1[j] = sigmoidf_(x1[j]); }
                        *(u32x4*)(Ab + row * DM + c) = pack8(x0, x1);
                    } else if (GI == 2) {
                        *(u32x4*)(Gb + row * DM + c) = pack8(x0, x1);
                    } else {
                        h16* vp = C1 + row * LDC1 + 4096 + c;
                        const h16x8 vv = *(const h16x8*)vp; const h16x8 vf = *(const h16x8*)(VF + row * DM + c);
                        f32x4 o0, o1;
#pragma unroll
                        for (int j = 0; j < 4; ++j) { float v = (float)vv[j], f = (float)vf[j]; o0[j] = v + (f - v) * sigmoidf_(x0[j]); v = (float)vv[4 + j]; f = (float)vf[4 + j]; o1[j] = v + (f - v) * sigmoidf_(x1[j]); }
                        *(u32x4*)vp = pack8(o0, o1);
                    }
                    __builtin_amdgcn_sched_barrier(0);
                }
        }
    }
    __device__ __forceinline__ void body_a(const f32x4 (&acc)[2][2][4][2], int row0, int cb0) const {
#pragma unroll
        for (int ai = 0; ai < 2; ++ai)
#pragma unroll
            for (int m = 0; m < 4; ++m) {
                const size_t row = (size_t)(row0 + ai * 128 + m * 16);
                asm volatile("" ::: "memory");
                float a[2][8], kv[2][8], kk[2][8]; float ss = 0.f;
#pragma unroll
                for (int bj = 0; bj < 2; ++bj) {
                    const int c = cb0 + 32 * bj;
                    const f32x4 b0 = *(const f32x4*)(a0 + c), b1 = *(const f32x4*)(a0 + c + 4), q0 = *(const f32x4*)(k_k + c), q1 = *(const f32x4*)(k_k + c + 4);
                    const h16x8 kh = *(const h16x8*)(C1 + row * LDC1 + 2048 + c);
#pragma unroll
                    for (int e = 0; e < 4; ++e) {
                        a[bj][e] = sigmoidf_(acc[ai][bj][m][0][e] + b0[e]); a[bj][4 + e] = sigmoidf_(acc[ai][bj][m][1][e] + b1[e]);
                        kv[bj][e] = (float)kh[e]; kv[bj][4 + e] = (float)kh[4 + e];
                        kk[bj][e] = kv[bj][e] * q0[e]; kk[bj][4 + e] = kv[bj][4 + e] * q1[e];
                        ss += kk[bj][e] * kk[bj][e] + kk[bj][4 + e] * kk[bj][4 + e];
                    }
                }
                ss += __shfl_xor(ss, 16); ss += __shfl_xor(ss, 32);
                const float inv = 1.0f / fmaxf(sqrtf(ss), 1e-12f);
#pragma unroll
                for (int bj = 0; bj < 2; ++bj) {
                    const int c = cb0 + 32 * bj;
                    const f32x4 p0 = *(const f32x4*)(k_a + c), p1 = *(const f32x4*)(k_a + c + 4);
                    f32x4 ko0, ko1, ao0, ao1, bo0, bo1;
#pragma unroll
                    for (int e = 0; e < 4; ++e) {
                        ko0[e] = kv[bj][e] * (1.0f + (a[bj][e] - 1.0f) * p0[e]); ko1[e] = kv[bj][4 + e] * (1.0f + (a[bj][4 + e] - 1.0f) * p1[e]);
                        const float n0_ = kk[bj][e] * inv, n1_ = kk[bj][4 + e] * inv;
                        ao0[e] = -n0_; ao1[e] = -n1_; bo0[e] = n0_ * a[bj][e]; bo1[e] = n1_ * a[bj][4 + e];
                    }
                    *(u32x4*)(C1 + row * LDC1 + 2048 + c) = pack8(ko0, ko1);
                    *(u32x4*)(AA + row * DM + c) = pack8(ao0, ao1);
                    *(u32x4*)(Ab + row * DM + c) = pack8(bo0, bo1);
                }
                __builtin_amdgcn_sched_barrier(0);
            }
    }
    __device__ __forceinline__ void operator()(const f32x4 (&acc)[2][2][4][2], const Unit& u, int wr, int wc, int fr, int fq) const {
        const int row0 = u.pm * 256 + wr * 64 + fr; const int colt = u.pn * 256 + wc * 32 + 8 * fq;
        if (GI_ == 1) body_a(acc, row0, u.pn * 256 + wc * 64 + 8 * fq);
        else body<GI_>(acc, row0, colt);
    }
};
struct EpiRes {
    static constexpr bool PERM = true;
    const h16* X; h16* PRE;
    __device__ __forceinline__ void operator()(const f32x4 (&acc)[2][2][4][2], const Unit& u, int wr, int wc, int fr, int fq) const {
        EPI_ROWS_PERM
#pragma unroll
        for (int ai = 0; ai < 2; ++ai)
#pragma unroll
            for (int m = 0; m < 4; ++m) { const size_t off = (size_t)(row0 + ai * 128 + m * 16) * DM + colt;
#pragma unroll
                for (int bj = 0; bj < 2; ++bj) {
                    const h16x8 x = *(const h16x8*)(X + off + bj * 128);
                    f32x4 o0, o1;
#pragma unroll
                    for (int e = 0; e < 4; ++e) { o0[e] = (float)x[e] * ALPHA + acc[ai][bj][m][0][e]; o1[e] = (float)x[4 + e] * ALPHA + acc[ai][bj][m][1][e]; }
                    *(u32x4*)(PRE + off + bj * 128) = pack8(o0, o1); } }
    }
};
__device__ __forceinline__ float gelu_mul(float u, float gc) {
    const float t = gc * gc;
    const float z = gc * (t * (0.044715f * 1.5957691216057308f * LOG2E) + 1.5957691216057308f * LOG2E);
    return u * gc * __builtin_amdgcn_rcpf(1.0f + __builtin_amdgcn_exp2f(-z));
}
struct EpiUpConv {
    static constexpr bool PERM = true;
    h16* ACT; h16* SIDE; const float* cw; const float* cb;
    __device__ __forceinline__ void operator()(const f32x4 (&acc)[2][2][4][2], const Unit& u, int wr, int wc, int fr, int fq) const {
        const int row0 = u.pm * 256 + wr * 64 + fr, f0 = u.pn * 128 + wc * 32 + 8 * fq;
        f32x4 w0[2], w1[2], w2[2], bb[2];
#pragma unroll
        for (int n = 0; n < 2; ++n) { w0[n] = *(const f32x4*)(cw + f0 + 4 * n); w1[n] = *(const f32x4*)(cw + FF + f0 + 4 * n); w2[n] = *(const f32x4*)(cw + 2 * FF + f0 + 4 * n); bb[n] = *(const f32x4*)(cb + f0 + 4 * n); }
#pragma unroll
        for (int ai = 0; ai < 2; ++ai) {
            f32x4 p1[2], p2[2];
#pragma unroll
            for (int n = 0; n < 2; ++n) { p1[n] = (f32x4){0.f, 0.f, 0.f, 0.f}; p2[n] = p1[n]; }
#pragma unroll
            for (int m = 0; m < 4; ++m) {
                const int row = row0 + ai * 128 + m * 16;
                f32x4 r1[2], r2[2], o[2];
#pragma unroll
                for (int n = 0; n < 2; ++n)
#pragma unroll
                    for (int e = 0; e < 4; ++e) {
                        const float g = acc[ai][1][m][n][e];
                        r1[n][e] = dpp_f<0x121>(g); r2[n][e] = dpp_f<0x122>(g);
                        const float g1 = fr >= 1 ? r1[n][e] : p1[n][e], g2 = fr >= 2 ? r2[n][e] : p2[n][e];
                        const float gc = bb[n][e] + g2 * w0[n][e] + g1 * w1[n][e] + g * w2[n][e];
                        o[n][e] = gelu_mul(acc[ai][0][m][n][e], gc);
                    }
                if (m > 0 || fr >= 2) *(u32x4*)(ACT + (size_t)row * FF + f0) = pack8(o[0], o[1]);
                if (m == 0 && fr < 2) { h16* sp = SIDE + ((size_t)(row >> 6) * 4 + 2 + fr) * (2 * FF) + f0;
                    *(u32x4*)sp = pack8(acc[ai][0][m][0], acc[ai][0][m][1]); *(u32x4*)(sp + FF) = pack8(acc[ai][1][m][0], acc[ai][1][m][1]); }
                if (m == 3 && fr >= 14) { h16* sp = SIDE + ((size_t)(row >> 6) * 4 + (fr - 14)) * (2 * FF) + FF + f0;
                    *(u32x4*)sp = pack8(acc[ai][1][m][0], acc[ai][1][m][1]); }
#pragma unroll
                for (int n = 0; n < 2; ++n) { p1[n] = r1[n]; p2[n] = r2[n]; }
            }
        }
    }
};
__device__ __forceinline__ void convfix_phase(const h16* SIDE, h16* ACT, const float* cw, const float* cb) {
    constexpr int NCG = FF / 8, NT = 256 * 2 * NCG;
    for (int task = obid() * 512 + otid(); task < NT; task += gridDim.x * 512) {
        const int cgi = task % NCG, j = (task / NCG) & 1, gidx = task / (2 * NCG), f = cgi * 8;
        const bool first = (gidx & 127) == 0;
        const h16* cur = SIDE + ((size_t)gidx * 4 + 2 + j) * (2 * FF) + f;
        const h16x8 uh = *(const h16x8*)cur, g0h = *(const h16x8*)(cur + FF);
        h16x8 g1h = {}, g2h = {};
        if (j == 0) { if (!first) { g1h = *(const h16x8*)(SIDE + ((size_t)(gidx - 1) * 4 + 1) * (2 * FF) + FF + f); g2h = *(const h16x8*)(SIDE + ((size_t)(gidx - 1) * 4 + 0) * (2 * FF) + FF + f); } }
        else { g1h = *(const h16x8*)(SIDE + ((size_t)gidx * 4 + 2) * (2 * FF) + FF + f); if (!first) g2h = *(const h16x8*)(SIDE + ((size_t)(gidx - 1) * 4 + 1) * (2 * FF) + FF + f); }
        h16x8 o;
#pragma unroll
        for (int e = 0; e < 8; ++e) {
            const float gc = cb[f + e] + (float)g2h[e] * cw[f + e] + (float)g1h[e] * cw[FF + f + e] + (float)g0h[e] * cw[2 * FF + f + e];
            o[e] = (h16)gelu_mul((float)uh[e], gc);
        }
        *(h16x8*)(ACT + ((size_t)gidx * 64 + j) * FF + f) = o;
    }
}
struct EpiQKV {
    static constexpr bool PERM = true;
    h16* Qb; h16* Kb; h16* Vt;
    __device__ __forceinline__ void operator()(const f32x4 (&acc)[2][2][4][2], const Unit& u, int wr, int wc, int fr, int fq) const {
        const int row0 = u.pm * 256 + wr * 64 + fr; const int part = u.pn >> 3; const int colt = (u.pn & 7) * 256 + wc * 32 + 8 * fq;
#pragma unroll
        for (int ai = 0; ai < 2; ++ai)
#pragma unroll
            for (int m = 0; m < 4; ++m) { const int row = row0 + ai * 128 + m * 16;
#pragma unroll
                for (int bj = 0; bj < 2; ++bj) { const int c = colt + bj * 128;
                    if (part == 0) *(u32x4*)(Qb + (size_t)row * DM + c) = pack8(acc[ai][bj][m][0] * QSCALE, acc[ai][bj][m][1] * QSCALE);
                    else if (part == 1) *(u32x4*)(Kb + (size_t)row * DM + c) = pack8(acc[ai][bj][m][0], acc[ai][bj][m][1]);
                    else {
                        const int b = row >> 13, t = row & 8191, hd = c >> 8, dv = c & 255;
                        const int pos = (t & ~12) | ((t & 4) << 1) | ((t & 8) >> 1);
                        h16* vp = Vt + ((size_t)((b * 8 + hd) * 256 + dv)) * SEQ + pos;
#pragma unroll
                        for (int j = 0; j < 4; ++j) { vp[(size_t)j * SEQ] = (h16)acc[ai][bj][m][0][j]; vp[(size_t)(4 + j) * SEQ] = (h16)acc[ai][bj][m][1][j]; }
                    } } }
    }
};

__device__ __forceinline__ void cvt_job(LAS unsigned char* lds, const float* src, int Ks, int Ns, h16* dst, int Kd, int Nd, int remap = 0) {
    LAS h16* tile = (LAS h16*)lds;
    const int tid = otid(), tk = Kd >> 6, tn = Nd >> 6;
    for (int t = obid(); t < tk * tn; t += gridDim.x) {
        const int k0 = (t % tk) * 64, n0 = (t / tk) * 64;
#pragma unroll
        for (int i = 0; i < 2; ++i) {
            const int idx = tid + 512 * i, kr = idx >> 4, nc = (idx & 15) * 4, k = k0 + kr, n = n0 + nc;
            f32x4 v = (f32x4){0.f, 0.f, 0.f, 0.f};
            if (k < Ks && n < Ns) v = *(const f32x4*)(src + (size_t)k * Ns + n);
            tile[kr * 66 + nc + 0] = (h16)v[0]; tile[kr * 66 + nc + 1] = (h16)v[1]; tile[kr * 66 + nc + 2] = (h16)v[2]; tile[kr * 66 + nc + 3] = (h16)v[3];
        }
        __syncthreads();
        { const int n = tid >> 3, kg = tid & 7; h16x8 o;
#pragma unroll
          for (int e = 0; e < 8; ++e) o[e] = tile[(kg * 8 + e) * 66 + n];
          const int no = n0 + n;
          const int nd = remap == 0 ? no : (remap == 1 ? (no < FF ? (no >> 7) * 256 + (no & 127) : ((no - FF) >> 7) * 256 + 128 + ((no - FF) & 127))
                                                      : ((no & ~255) | ((no & 32) << 2) | ((no & 192) >> 1) | (no & 31)));
          *(h16x8*)(dst + (size_t)nd * Kd + k0 + kg * 8) = o; }
        __syncthreads();
    }
}
__device__ __forceinline__ void cvt_layer(LAS unsigned char* lds, const Params& p, int layer) {
    const bool ffn_here = (layer & 1) != 0;
    h16* W = (h16*)(p.ws + ((layer & 1) ? WS_X : WS_W16));
    const int j = layer >> 1;
    if ((layer & 1) == 0) {
        h16* B1 = (h16*)((char*)W + W_B1); h16* B2 = (h16*)((char*)W + W_B2);
        if (layer == 0) for (int i = 0; i < 3; ++i) cvt_job(lds, p.in[4] + ((size_t)j * 3 + i) * DM * DM, DM, DM, B1 + (size_t)i * DM * DM, DM, DM);
        cvt_job(lds, p.in[6] + (size_t)j * DM * 96, DM, 96, B1 + (size_t)6144 * DM, DM, 256);
        cvt_job(lds, p.in[9] + (size_t)j * DM * 96, DM, 96, B1 + (size_t)6400 * DM, DM, 256);
        cvt_job(lds, p.in[14] + (size_t)j * DM * 128, DM, 128, B1 + (size_t)6656 * DM, DM, 256);
        cvt_job(lds, p.in[7] + (size_t)j * 96 * DM, 96, DM, B2, 256, DM);
        cvt_job(lds, p.in[10] + (size_t)j * 96 * DM, 96, DM, B2 + (size_t)2048 * 256, 256, DM, 2);
        cvt_job(lds, p.in[15] + (size_t)j * 128 * DM, 128, DM, B2 + (size_t)4096 * 256, 256, DM);
        if (j > 0) {
            cvt_job(lds, p.in[12] + (size_t)(j - 1) * DM * 64, DM, 64, B1 + (size_t)6912 * DM, DM, 256);
            cvt_job(lds, p.in[13] + (size_t)(j - 1) * 64 * DM, 64, DM, B2 + (size_t)6144 * 256, 256, DM);
        }
        cvt_job(lds, p.in[21] + (size_t)j * DM * DM, DM, DM, (h16*)((char*)W + W_WO), DM, DM);
    } else {
        cvt_job(lds, p.in[22] + (size_t)j * DM * 6144, DM, 6144, (h16*)((char*)W + W_B1), DM, 6144);
        cvt_job(lds, p.in[25] + (size_t)j * DM * DM, DM, DM, (h16*)((char*)W + W_WO), DM, DM);
    }
    if (ffn_here) {
        cvt_job(lds, p.in[27] + (size_t)layer * DM * 2 * FF, DM, 2 * FF, (h16*)((char*)W + W_UP), DM, 2 * FF, 1);
        cvt_job(lds, p.in[30] + (size_t)layer * FF * DM, FF, DM, (h16*)((char*)W + W_DN), FF, DM);
    }
}

template <bool LN>
__device__ __forceinline__ void ln_row(const void* src, size_t row, int lane, const float* g, const float* bt, f32x4 (&v)[8]) {
    if (LN) {
        const h16x4* sp = (const h16x4*)((const h16*)src + row * DM);
#pragma unroll
        for (int i = 0; i < 8; ++i) { const h16x4 t = sp[i * 64 + lane]; v[i] = (f32x4){(float)t[0], (float)t[1], (float)t[2], (float)t[3]}; }
        float s = 0.f;
#pragma unroll
        for (int i = 0; i < 8; ++i) s += (v[i][0] + v[i][1]) + (v[i][2] + v[i][3]);
        const float mean = wave_sum(s) * (1.0f / DM);
        float q = 0.f;
#pragma unroll
        for (int i = 0; i < 8; ++i) { v[i] = v[i] - mean; q += (v[i][0] * v[i][0] + v[i][1] * v[i][1]) + (v[i][2] * v[i][2] + v[i][3] * v[i][3]); }
        const float rstd = rsqrtf(wave_sum(q) * (1.0f / DM) + 1e-5f);
#pragma unroll
        for (int i = 0; i < 8; ++i) { const f32x4 gg = ((const f32x4*)g)[i * 64 + lane], bb = ((const f32x4*)bt)[i * 64 + lane]; v[i] = v[i] * rstd * gg + bb; }
    } else {
        const f32x4* sp = (const f32x4*)((const float*)src + row * DM);
#pragma unroll
        for (int i = 0; i < 8; ++i) v[i] = sp[i * 64 + lane];
    }
}
__device__ __forceinline__ void ln_load16(const void* src, size_t row, int lane, h16x4 (&t)[8]) {
    const h16x4* sp = (const h16x4*)((const h16*)src + row * DM);
#pragma unroll
    for (int i = 0; i < 8; ++i) t[i] = sp[i * 64 + lane];
}
__device__ __forceinline__ void ln_apply16(const h16x4 (&t)[8], int lane, const float* g, const float* bt, f32x4 (&v)[8]) {
#pragma unroll
    for (int i = 0; i < 8; ++i) v[i] = (f32x4){(float)t[i][0], (float)t[i][1], (float)t[i][2], (float)t[i][3]};
    float s = 0.f;
#pragma unroll
    for (int i = 0; i < 8; ++i) s += (v[i][0] + v[i][1]) + (v[i][2] + v[i][3]);
    const float mean = wave_sum(s) * (1.0f / DM);
    float q = 0.f;
#pragma unroll
    for (int i = 0; i < 8; ++i) { v[i] = v[i] - mean; q += (v[i][0] * v[i][0] + v[i][1] * v[i][1]) + (v[i][2] * v[i][2] + v[i][3] * v[i][3]); }
    const float rstd = rsqrtf(wave_sum(q) * (1.0f / DM) + 1e-5f);
#pragma unroll
    for (int i = 0; i < 8; ++i) { const f32x4 gg = ((const f32x4*)g)[i * 64 + lane], bb = ((const f32x4*)bt)[i * 64 + lane]; v[i] = v[i] * rstd * gg + bb; }
}
template <bool LN>
__device__ __forceinline__ void ln_phase(const void* src, const float* g, const float* bt, float* xout, h16* xh, const float* mu, h16* mix) {
    const int lane = otid() & 63, gw = obid() * 8 + (otid() >> 6), GW = gridDim.x * 8;
    for (int ch = gw; ch < MTOK / 8; ch += GW) {
        const size_t t0 = (size_t)ch * 8;
        f32x4 prev[8], cur[8];
        if (mix) {
            if ((t0 & (SEQ - 1)) == 0) {
#pragma unroll
                for (int i = 0; i < 8; ++i) prev[i] = (f32x4){0.f, 0.f, 0.f, 0.f};
            } else ln_row<LN>(src, t0 - 1, lane, g, bt, prev);
        }
        h16x4 raw[8], rawn[8];
        if (LN) ln_load16(src, t0, lane, raw);
#pragma unroll 1
        for (int r = 0; r < 8; ++r) {
            const size_t row = t0 + r;
            asm volatile("" ::: "memory");
            if (LN) {
                ln_load16(src, t0 + (r < 7 ? r + 1 : 7), lane, rawn);
                ln_apply16(raw, lane, g, bt, cur);
#pragma unroll
                for (int i = 0; i < 8; ++i) raw[i] = rawn[i];
            } else ln_row<LN>(src, row, lane, g, bt, cur);
            if (xout) {
#pragma unroll
                for (int i = 0; i < 8; ++i) ((f32x4*)(xout + row * DM))[i * 64 + lane] = cur[i];
            }
            if (xh) {
#pragma unroll
                for (int i = 0; i < 8; ++i) { h16x4 o = {(h16)cur[i][0], (h16)cur[i][1], (h16)cur[i][2], (h16)cur[i][3]}; ((h16x4*)(xh + row * DM))[i * 64 + lane] = o; }
            }
            if (mix) {
#pragma unroll
                for (int i = 0; i < 8; ++i) {
                    asm volatile("" ::: "memory");
                    const f32x4 xx = prev[i] - cur[i];
#pragma unroll
                    for (int k = 0; k < 6; ++k) {
                        const f32x4 m4 = ((const f32x4*)(mu + (size_t)k * DM))[i * 64 + lane];
                        const f32x4 o4 = cur[i] + xx * m4;
                        h16x4 o = {(h16)o4[0], (h16)o4[1], (h16)o4[2], (h16)o4[3]};
                        ((h16x4*)(mix + ((size_t)k * MTOK + row) * DM))[i * 64 + lane] = o;
                    }
                    prev[i] = cur[i];
                }
            }
        }
    }
}

__device__ __forceinline__ void prep_phase(h16* C1, h16* Ab, h16* AA, h16* VF, const float* k_k, const float* k_a, bool first) {
    const int lane = otid() & 63, gw = obid() * 8 + (otid() >> 6), GW = gridDim.x * 8;
    for (int row = gw; row < MTOK; row += GW) {
#pragma unroll
        for (int i = 0; i < 8; ++i) {
            const int c = i * 256 + lane * 4;
            h16x4* kp = (h16x4*)(C1 + (size_t)row * LDC1 + 2048 + c);
            h16x4* ap = (h16x4*)(Ab + (size_t)row * DM + c);
            const h16x4 kh = *kp, ah = *ap;
            const f32x4 kkw = *(const f32x4*)(k_k + c), kaw = *(const f32x4*)(k_a + c);
            f32x4 k, a, kk;
#pragma unroll
            for (int e = 0; e < 4; ++e) { k[e] = (float)kh[e]; a[e] = (float)ah[e]; kk[e] = k[e] * kkw[e]; }
            float ss = (kk[0] * kk[0] + kk[1] * kk[1]) + (kk[2] * kk[2] + kk[3] * kk[3]);
            ss = grp16_sum(ss);
            const float inv = 1.0f / fmaxf(sqrtf(ss), 1e-12f);
            h16x4 ko, aao, bbo;
#pragma unroll
            for (int e = 0; e < 4; ++e) { const float kn = kk[e] * inv; ko[e] = (h16)(k[e] * (1.0f + (a[e] - 1.0f) * kaw[e])); aao[e] = (h16)(-kn); bbo[e] = (h16)(kn * a[e]); }
            *kp = ko; *ap = bbo; *(h16x4*)(AA + (size_t)row * DM + c) = aao;
            if (first) *(h16x4*)(VF + (size_t)row * DM + c) = *(const h16x4*)(C1 + (size_t)row * LDC1 + 4096 + c);
        }
    }
}

__device__ __forceinline__ void scan_phase(LAS unsigned char* lds, const h16* C1, const h16* DEC, const h16* AA, const h16* BB, float* Y,
                                           const float* sQKV, const float* sWO, const float* sUP, const float* sDN, char* Wn, const float* sUP0, const float* sDN0, char* Wc, const float* sRKV2) {
    constexpr int CH = 32, NCH = SEQ / CH, BUF = 18976;
    LAS float* L = (LAS float*)lds;
    const int tid = otid(), wid = tid >> 6, lane = tid & 63;
    for (int item = obid(); item < 256; item += gridDim.x) {
        const int b = item >> 7, h = (item >> 2) & 31, q = item & 3;
        const size_t row0 = (size_t)b * SEQ;
        __syncthreads();
        if (wid >= 4) {
            const int lt = tid - 256, s = lt >> 3, e8 = lt & 7;
            struct StReg { h16x8 r8, k8, a8, b8, v8, d8; };
            auto gload = [&](int c) -> StReg {
                StReg R;
                const size_t row = row0 + (size_t)c * CH + s;
                R.r8 = *(const h16x8*)(C1 + row * LDC1 + h * 64 + e8 * 8);
                R.k8 = *(const h16x8*)(C1 + row * LDC1 + 2048 + h * 64 + e8 * 8);
                { const int tn = c * CH + s + 1; const size_t rown = row0 + (size_t)(tn < SEQ ? tn : SEQ - 1);
                  R.a8 = *(const h16x8*)(AA + rown * DM + h * 64 + e8 * 8); }
                R.b8 = *(const h16x8*)(BB + row * DM + h * 64 + e8 * 8);
                R.d8 = *(const h16x8*)(DEC + row * DM + h * 64 + e8 * 8);
                R.v8 = (h16x8){};
                if (lt < 64) R.v8 = *(const h16x8*)(C1 + (row0 + (size_t)c * CH + (lt >> 1)) * LDC1 + 4096 + h * 64 + q * 16 + (lt & 1) * 8);
                return R;
            };
            auto lwrite = [&](const StReg& R, int bufi) {
                LAS float* Bf = L + bufi * BUF;
                LAS float* dst = Bf + s * 64 + e8 * 8;
                *(LAS f32x4*)(dst + 0 * 2048) = (f32x4){(float)R.r8[0], (float)R.r8[1], (float)R.r8[2], (float)R.r8[3]}; *(LAS f32x4*)(dst + 0 * 2048 + 4) = (f32x4){(float)R.r8[4], (float)R.r8[5], (float)R.r8[6], (float)R.r8[7]};
                *(LAS f32x4*)(dst + 1 * 2048) = (f32x4){__expf(-(float)R.d8[0]), __expf(-(float)R.d8[1]), __expf(-(float)R.d8[2]), __expf(-(float)R.d8[3])};
                *(LAS f32x4*)(dst + 1 * 2048 + 4) = (f32x4){__expf(-(float)R.d8[4]), __expf(-(float)R.d8[5]), __expf(-(float)R.d8[6]), __expf(-(float)R.d8[7])};
                *(LAS f32x4*)(dst + 2 * 2048) = (f32x4){(float)R.k8[0], (float)R.k8[1], (float)R.k8[2], (float)R.k8[3]}; *(LAS f32x4*)(dst + 2 * 2048 + 4) = (f32x4){(float)R.k8[4], (float)R.k8[5], (float)R.k8[6], (float)R.k8[7]};
                *(LAS f32x4*)(dst + 3 * 2048) = (f32x4){(float)R.a8[0], (float)R.a8[1], (float)R.a8[2], (float)R.a8[3]}; *(LAS f32x4*)(dst + 3 * 2048 + 4) = (f32x4){(float)R.a8[4], (float)R.a8[5], (float)R.a8[6], (float)R.a8[7]};
                *(LAS f32x4*)(dst + 4 * 2048) = (f32x4){(float)R.b8[0], (float)R.b8[1], (float)R.b8[2], (float)R.b8[3]}; *(LAS f32x4*)(dst + 4 * 2048 + 4) = (f32x4){(float)R.b8[4], (float)R.b8[5], (float)R.b8[6], (float)R.b8[7]};
                { float cp = 0.f;
#pragma unroll
                  for (int e = 0; e < 8; ++e) cp += (float)R.b8[e] * (float)R.a8[e];
                  cp += __shfl_xor(cp, 1); cp += __shfl_xor(cp, 2); cp += __shfl_xor(cp, 4);
                  if (e8 == 0) Bf[18944 + s] = cp; }
                if (lt < 64) { LAS float* vd = Bf + 10240 + (lt >> 1) * 16 + (lt & 1) * 8;
                    *(LAS f32x4*)vd = (f32x4){(float)R.v8[0], (float)R.v8[1], (float)R.v8[2], (float)R.v8[3]}; *(LAS f32x4*)(vd + 4) = (f32x4){(float)R.v8[4], (float)R.v8[5], (float)R.v8[6], (float)R.v8[7]}; }
            };
            auto yout = [&](int c, int bufi) {
#pragma unroll
                for (int o2 = 0; o2 < 2; ++o2) {
                    const int o = lt + 256 * o2, ys = o >> 4, yr = o & 15;
                    LAS float* yp = L + bufi * BUF + 10752 + o * 16;
                    f32x4 acc4 = *(LAS f32x4*)(yp + (((0 + (o >> 2)) & 3) << 2));
#pragma unroll
                    for (int i = 1; i < 4; ++i) acc4 += *(LAS f32x4*)(yp + (((i + (o >> 2)) & 3) << 2));
                    Y[(row0 + (size_t)c * CH + ys) * DM + h * 64 + q * 16 + yr] = (acc4[0] + acc4[1]) + (acc4[2] + acc4[3]);
                }
            };
            const int lw = (lt >> 6), wgl = item * 4 + lw;
            LAS h16* ctile = (LAS h16*)(lds + 2 * BUF * 4) + lw * 512;
            f32x4 cv0 = (f32x4){0.f, 0.f, 0.f, 0.f}, cv1 = cv0; h16* cdst = nullptr;
            auto cvt_issue = [&](int tix) {
                constexpr int T0 = 128 * 192, T1 = 128 * 64, T2 = 128 * 344, T3 = 344 * 64;
                cdst = nullptr;
                constexpr int T4 = 3 * 128 * 64;
                if (tix >= T0 + T1 + 2 * (T2 + T3) + (sRKV2 ? T4 : 0)) return;
                const float* src; h16* dst; int Ks, Ns, rm = 0, t = tix;
                if (t >= T0 + T1 + 2 * (T2 + T3)) {
                    t -= T0 + T1 + 2 * (T2 + T3);
                    const int mi = t / (128 * 64); t -= mi * (128 * 64);
                    src = sRKV2 + (size_t)mi * DM * DM; dst = (h16*)(Wc + W_B1) + (size_t)mi * DM * DM; Ks = DM; Ns = DM;
                }
                else if (t >= T0 + T1 + T2 + T3) {
                    t -= T0 + T1 + T2 + T3;
                    if (t < T2) { src = sUP0; dst = (h16*)(Wc + W_UP); Ks = DM; Ns = 2 * FF; rm = 1; }
                    else { t -= T2; src = sDN0; dst = (h16*)(Wc + W_DN); Ks = FF; Ns = DM; }
                }
                else if (t < T0) { src = sQKV; dst = (h16*)(Wn + W_B1); Ks = DM; Ns = 6144; }
                else if (t < T0 + T1) { t -= T0; src = sWO; dst = (h16*)(Wn + W_WO); Ks = DM; Ns = DM; }
                else if (t < T0 + T1 + T2) { t -= T0 + T1; src = sUP; dst = (h16*)(Wn + W_UP); Ks = DM; Ns = 2 * FF; rm = 1; }
                else { t -= T0 + T1 + T2; src = sDN; dst = (h16*)(Wn + W_DN); Ks = FF; Ns = DM; }
                const int tk = Ks >> 4, k0 = (t % tk) * 16, n0 = (t / tk) * 32;
                const int ln = lt & 63, kr = ln >> 3, nc = (ln & 7) * 4;
                cv0 = *(const f32x4*)(src + (size_t)(k0 + kr) * Ns + n0 + nc); cv1 = *(const f32x4*)(src + (size_t)(k0 + kr + 8) * Ns + n0 + nc);
                const int n = ln & 31, hf = ln >> 5, no = n0 + n;
                const int nd = rm == 0 ? no : (no < FF ? (no >> 7) * 256 + (no & 127) : ((no - FF) >> 7) * 256 + 128 + ((no - FF) & 127));
                cdst = dst + (size_t)nd * Ks + k0 + hf * 8;
            };
            auto cvt_finish = [&]() {
                if (cdst == nullptr) return;
                const int ln = lt & 63, kr = ln >> 3, nc = (ln & 7) * 4;
#pragma unroll
                for (int e = 0; e < 4; ++e) { ctile[(nc + e) * 16 + kr] = (h16)cv0[e]; ctile[(nc + e) * 16 + kr + 8] = (h16)cv1[e]; }
                asm volatile("s_waitcnt lgkmcnt(0)" ::: "memory");
                const h16x8 o = *(LAS h16x8*)(ctile + (ln & 31) * 16 + (ln >> 5) * 8);
                *(h16x8*)cdst = o;
                asm volatile("s_waitcnt lgkmcnt(0)" ::: "memory");
            };
            { const StReg R0 = gload(0); lwrite(R0, 0); }
            StReg RA = gload(1);
            __syncthreads();
            for (int c = 0; c < NCH; ++c) {
                StReg RB = RA;
                if (c + 2 < NCH) RB = gload(c + 2);
                if (c + 1 < NCH) lwrite(RA, (c + 1) & 1);
                if (c > 0) yout(c - 1, (c - 1) & 1);
                if (Wn) { cvt_finish(); cvt_issue(wgl + 1024 * c); }
                asm volatile("s_waitcnt lgkmcnt(0)" ::: "memory");
                __builtin_amdgcn_s_barrier();
                asm volatile("" ::: "memory");
                RA = RB;
            }
            yout(NCH - 1, (NCH - 1) & 1);
            if (Wn) cvt_finish();
        } else {
            const int jg = lane & 15, rl = wid * 4 + (lane >> 4);
            f32x2 Sa = (f32x2){0.f, 0.f}, Sb = (f32x2){0.f, 0.f};
            float sa = 0.f;
            __syncthreads();
            for (int c = 0; c < NCH; ++c) {
                LAS float* Bf = L + (c & 1) * BUF;
                LAS float* vec = Bf + jg * 4;
                f32x4 r4 = *(LAS f32x4*)(vec + 0 * 2048), w4 = *(LAS f32x4*)(vec + 1 * 2048), k4 = *(LAS f32x4*)(vec + 2 * 2048), a4 = *(LAS f32x4*)(vec + 3 * 2048), b4 = *(LAS f32x4*)(vec + 4 * 2048);
                float v = Bf[10240 + rl], cn = Bf[18944];
#pragma unroll 1
                for (int s0 = 0; s0 < CH; s0 += 8) {
                    float yv[8];
#pragma unroll
                    for (int u = 0; u < 8; ++u) {
                        const int s = s0 + u, sn = (s + 1 < CH) ? s + 1 : CH - 1;
                        const f32x4 r4n = *(LAS f32x4*)(vec + 0 * 2048 + sn * 64), w4n = *(LAS f32x4*)(vec + 1 * 2048 + sn * 64), k4n = *(LAS f32x4*)(vec + 2 * 2048 + sn * 64),
                                    a4n = *(LAS f32x4*)(vec + 3 * 2048 + sn * 64), b4n = *(LAS f32x4*)(vec + 4 * 2048 + sn * 64);
                        const float vn = Bf[10240 + sn * 16 + rl], cnn = Bf[18944 + sn];
                        const f32x2 aL = {a4[0], a4[1]}, aH = {a4[2], a4[3]}, wL = {w4[0], w4[1]}, wH = {w4[2], w4[3]}, kL = {k4[0], k4[1]}, kH = {k4[2], k4[3]},
                                    bL = {b4[0], b4[1]}, bH = {b4[2], b4[3]}, rL = {r4[0], r4[1]}, rH = {r4[2], r4[3]};
                        const f32x2 uL = Sa * wL + kL * v, uH = Sb * wH + kH * v;
                        const f32x2 dz = uL * aL + uH * aH;
                        const float z = row16_sum(dz[0] + dz[1]);
                        Sa = bL * sa + uL; Sb = bH * sa + uH;
                        const f32x2 dr = Sa * rL + Sb * rH;
                        yv[u] = dr[0] + dr[1];
                        sa = z + cn * sa;
                        r4 = r4n; w4 = w4n; k4 = k4n; a4 = a4n; b4 = b4n; v = vn; cn = cnn;
                    }
#pragma unroll
                    for (int u = 0; u < 8; ++u) Bf[10752 + ((s0 + u) * 16 + rl) * 16 + jg] = yv[u];
                }
                __syncthreads();
            }
        }
    }
}

__device__ __forceinline__ void gn_phase(const float* Y, const h16* C1, const h16* Gb, h16* YG, const float* r_k, const float* lnx_g, const float* lnx_b, h16* VFw) {
    const int lane = otid() & 63, gw = obid() * 8 + (otid() >> 6), GW = gridDim.x * 8;
    for (int row = gw; row < MTOK; row += GW) {
#pragma unroll
        for (int i = 0; i < 8; ++i) {
            const int c = i * 256 + lane * 4;
            const f32x4 y = *(const f32x4*)(Y + (size_t)row * DM + c);
            const h16x4 rh = *(const h16x4*)(C1 + (size_t)row * LDC1 + c), kh = *(const h16x4*)(C1 + (size_t)row * LDC1 + 2048 + c), vh = *(const h16x4*)(C1 + (size_t)row * LDC1 + 4096 + c);
            const h16x4 gh = *(const h16x4*)(Gb + (size_t)row * DM + c);
            const f32x4 rk = *(const f32x4*)(r_k + c), lg = *(const f32x4*)(lnx_g + c), lb = *(const f32x4*)(lnx_b + c);
            float s = (y[0] + y[1]) + (y[2] + y[3]);
            const float mean = grp16_sum(s) * (1.0f / 64.0f);
            const f32x4 d = y - mean;
            float qv = (d[0] * d[0] + d[1] * d[1]) + (d[2] * d[2] + d[3] * d[3]);
            const float rstd = rsqrtf(grp16_sum(qv) * (1.0f / 64.0f) + 64e-5f);
            float bs = 0.f;
#pragma unroll
            for (int e = 0; e < 4; ++e) bs += (float)rh[e] * (float)kh[e] * rk[e];
            bs = grp16_sum(bs);
            h16x4 o;
#pragma unroll
            for (int e = 0; e < 4; ++e) o[e] = (h16)((d[e] * rstd * lg[e] + lb[e] + bs * (float)vh[e]) * (float)gh[e]);
            *(h16x4*)(YG + (size_t)row * DM + c) = o;
            if (VFw) *(h16x4*)(VFw + (size_t)row * DM + c) = vh;
        }
    }
}

__device__ __forceinline__ void convglu_phase(const h16* U, h16* ACT, const float* cw, const float* cb) {
    constexpr int NCG = FF / 8, RC = 16, NT = (MTOK / RC) * NCG;
    for (int task = obid() * 512 + otid(); task < NT; task += gridDim.x * 512) {
        const int cgi = task % NCG, rc = task / NCG, f = cgi * 8, m0 = rc * RC;
        float w0[8], w1[8], w2[8], bb[8], g1[8], g2[8];
#pragma unroll
        for (int e = 0; e < 8; ++e) { w0[e] = cw[f + e]; w1[e] = cw[FF + f + e]; w2[e] = cw[2 * FF + f + e]; bb[e] = cb[f + e]; g1[e] = 0.f; g2[e] = 0.f; }
        if ((m0 & (SEQ - 1)) != 0) {
            const h16x8 a = *(const h16x8*)(U + (size_t)(m0 - 1) * (2 * FF) + FF + f), c2 = *(const h16x8*)(U + (size_t)(m0 - 2) * (2 * FF) + FF + f);
#pragma unroll
            for (int e = 0; e < 8; ++e) { g1[e] = (float)a[e]; g2[e] = (float)c2[e]; }
        }
        for (int r = 0; r < RC; ++r) {
            const size_t m = (size_t)(m0 + r);
            const h16x8 uh = *(const h16x8*)(U + m * (2 * FF) + f), gh = *(const h16x8*)(U + m * (2 * FF) + FF + f);
            h16x8 o;
#pragma unroll
            for (int e = 0; e < 8; ++e) {
                const float g0 = (float)gh[e];
                const float gc = bb[e] + g2[e] * w0[e] + g1[e] * w1[e] + g0 * w2[e];
                const float z = 1.5957691216057308f * (gc + 0.044715f * gc * gc * gc);
                const float ge = gc / (1.0f + __expf(-z));
                o[e] = (h16)((float)uh[e] * ge);
                g2[e] = g1[e]; g1[e] = g0;
            }
            *(h16x8*)(ACT + m * FF + f) = o;
        }
    }
}

__device__ __forceinline__ void attn_phase(LAS unsigned char* lds, const h16* Qb, const h16* Kb, const h16* Vt, h16* AO, const float* rel_bias, const float* lam, const float* subg, float lambda_init) {
    constexpr int STG = 65536;
    const int wid = __builtin_amdgcn_readfirstlane(otid() >> 6), rg = wid & 3, mp = wid >> 2;
    LAS float* lut = (LAS float*)(lds + 2 * STG);
    LAS float* osh = (LAS float*)lds;
    for (int vc = obid(); vc < 256; vc += gridDim.x) {
        const int bh = vc & 15, jj = vc >> 4, b = bh >> 3, h = bh & 7;
        for (int it = 0; it < 4; ++it) {
            const int qb = it == 0 ? 63 - jj : (it == 1 ? 32 + jj : (it == 2 ? 31 - jj : jj));
            __syncthreads();
            const int tid = otid(), lane = tid & 63, l32 = lane & 31, hh = lane >> 5;
            const int kkey = wid * 2 + (lane >> 5);
            const int kseg = (lane & 31) ^ (kkey & 15);
            const int vdv = wid * 8 + (lane >> 3);
            const int vseg = (lane & 7) ^ ((vdv >> 1) & 7);
            const int xk = l32 & 15, yv = (l32 >> 1) & 7;
            if (tid <= 128) {
                const float* rbp_ = rel_bias; asm volatile("" : "+s"(rbp_)); const GAS float* rbp = (const GAS float*)rbp_;
                float val = 0.f;
                if (tid < 128) { int bk = tid; if (tid >= 16) { bk = 16 + (int)(__logf((float)tid * (1.0f / 16.0f)) / 2.0794415416798357f * 16.0f); bk = bk > 31 ? 31 : bk; }
                    val = (rbp[bk * 8 + h] - rbp[31 * 8 + h]) * LOG2E; }
                lut[tid] = val;
            }
            const int q0 = qb * 128, qrow = q0 + 32 * rg + l32;
            const size_t tokbase = (size_t)b * SEQ;
            h16x8 Qf[8];
            { const h16* qp = Qb + (tokbase + qrow) * DM + h * 256 + mp * 128 + hh * 8;
#pragma unroll
              for (int ks = 0; ks < 8; ++ks) Qf[ks] = *(const h16x8*)(qp + ks * 16); }
            f32x16 O[8];
#pragma unroll
            for (int i = 0; i < 8; ++i)
#pragma unroll
                for (int r = 0; r < 16; ++r) O[i][r] = 0.f;
            float mrun = -1e30f, lrun = 0.f;
            const int nkt = 2 * qb + 2;
            const h16* kg = Kb + (tokbase + kkey) * DM + h * 256 + kseg * 8;
            const h16* vg = Vt + ((size_t)((b * 8 + h) * 256) + vdv) * SEQ + vseg * 8;
#define ATT_ISSUE(KT, BUF) do { _Pragma("unroll") for (int _i = 0; _i < 4; ++_i) \
                __builtin_amdgcn_global_load_lds((const unsigned*)(kg + (size_t)(64 * (KT) + 16 * _i) * DM), (LAS unsigned*)((BUF) + (_i * 8 + wid) * 1024), 16, 0, 0); \
              _Pragma("unroll") for (int _i = 0; _i < 4; ++_i) \
                __builtin_amdgcn_global_load_lds((const unsigned*)(vg + (size_t)(64 * _i) * SEQ + 64 * (KT)), (LAS unsigned*)((BUF) + 32768 + (_i * 8 + wid) * 1024), 16, 0, 0); } while (0)
            ATT_ISSUE(0, lds);
            asm volatile("s_waitcnt vmcnt(0)" ::: "memory");
            __syncthreads();
            for (int kt = 0; kt < nkt; ++kt) {
                LAS unsigned char* cb = lds + (kt & 1) * STG; LAS unsigned char* nb = lds + ((kt & 1) ^ 1) * STG;
                const bool near = kt >= 2 * qb - 2;
                if (kt + 1 < nkt) ATT_ISSUE(kt + 1, nb);
#pragma unroll
                for (int kb = 0; kb < 2; ++kb) {
                    if (64 * kt + 32 * kb <= q0 + 32 * rg + 31) {
                        f32x16 S0;
#pragma unroll
                        for (int r = 0; r < 16; ++r) S0[r] = 0.f;
                        LAS unsigned char* ks = cb + (32 * kb + l32) * 512 + mp * 256;
#pragma unroll
                        for (int k = 0; k < 8; ++k) {
                            const h16x8 a0 = *(LAS h16x8*)(ks + (((2 * k + hh) ^ xk) << 4));
                            S0 = __builtin_amdgcn_mfma_f32_32x32x16_f16(a0, Qf[k], S0, 0, 0, 0);
                        }
                        if (near) {
#pragma unroll
                            for (int r = 0; r < 16; ++r) {
                                const int kp = 64 * kt + 32 * kb + (r >> 2) * 8 + hh * 4 + (r & 3); const int d0 = qrow - kp;
                                const int di = d0 < 0 ? 0 : (d0 > 128 ? 128 : d0); const float bv = lut[di];
                                S0[r] = d0 < 0 ? -1e30f : S0[r] + bv;
                            }
                        }
                        float mt = S0[0];
#pragma unroll
                        for (int r = 1; r < 16; ++r) mt = fmaxf(mt, S0[r]);
                        if (__builtin_amdgcn_ballot_w64(mt - mrun > 10.0f) != 0ull) {
                            const float mo = fmaxf(mt, __shfl_xor(mt, 32));
                            const float mn = fmaxf(mrun, mo);
                            const float al = __builtin_amdgcn_exp2f(mrun - mn);
                            mrun = mn; lrun *= al;
#pragma unroll
                            for (int i = 0; i < 8; ++i) O[i] = O[i] * al;
                        }
                        float ps = 0.f;
#pragma unroll
                        for (int r = 0; r < 16; ++r) { S0[r] = __builtin_amdgcn_exp2f(S0[r] - mrun); ps += S0[r]; }
                        lrun += ps;
                        h16x8 P0, P1;
#pragma unroll
                        for (int e = 0; e < 8; ++e) { P0[e] = (h16)S0[e]; P1[e] = (h16)S0[8 + e]; }
                        LAS unsigned char* vs = cb + 32768 + l32 * 128;
                        const int vo0 = ((4 * kb + hh) ^ yv) << 4, vo1 = ((4 * kb + 2 + hh) ^ yv) << 4;
#pragma unroll
                        for (int dvb = 0; dvb < 8; ++dvb) {
                            const h16x8 a = *(LAS h16x8*)(vs + dvb * 4096 + vo0);
                            O[dvb] = __builtin_amdgcn_mfma_f32_32x32x16_f16(a, P0, O[dvb], 0, 0, 0);
                        }
#pragma unroll
                        for (int dvb = 0; dvb < 8; ++dvb) {
                            const h16x8 a = *(LAS h16x8*)(vs + dvb * 4096 + vo1);
                            O[dvb] = __builtin_amdgcn_mfma_f32_32x32x16_f16(a, P1, O[dvb], 0, 0, 0);
                        }
                    }
                }
                asm volatile("s_waitcnt vmcnt(0)" ::: "memory");
                __syncthreads();
            }
#undef ATT_ISSUE
            lrun += __shfl_xor(lrun, 32);
            const float inv = 1.0f / lrun;
            const int lane2 = otid() & 63, l32b = lane2 & 31, hhb = lane2 >> 5;
            const int obase = (rg * 8) * 16 * 64 + lane2;
            if (mp == 1) {
                float lf;
                { const float* lmp_ = lam; asm volatile("" : "+s"(lmp_)); const GAS float* lmp = (const GAS float*)lmp_;
                  float s1 = 0.f, s2 = 0.f; for (int i = lane2; i < 128; i += 64) { s1 += lmp[i] * lmp[128 + i]; s2 += lmp[256 + i] * lmp[384 + i]; }
                  s1 = wave_sum(s1); s2 = wave_sum(s2); lf = __expf(s1) - __expf(s2) + lambda_init; }
                const float sc = inv * lf;
#pragma unroll
                for (int dvb = 0; dvb < 8; ++dvb)
#pragma unroll
                    for (int r = 0; r < 16; ++r) osh[obase + (dvb * 16 + r) * 64] = O[dvb][r] * sc;
            }
            __syncthreads();
            if (mp == 0) {
                const float* sgp_ = subg; asm volatile("" : "+s"(sgp_)); const GAS float* sgp = (const GAS float*)sgp_;
                float ss = 0.f;
#pragma unroll
                for (int dvb = 0; dvb < 8; ++dvb)
#pragma unroll
                    for (int r = 0; r < 16; ++r) { const float o = O[dvb][r] * inv - osh[obase + (dvb * 16 + r) * 64]; O[dvb][r] = o; ss += o * o; }
                ss += __shfl_xor(ss, 32);
                const float rms = rsqrtf(ss * (1.0f / 256.0f) + 1e-5f) * (1.0f - lambda_init);
                h16* op = AO + ((size_t)b * SEQ + q0 + 32 * rg + l32b) * DM + h * 256 + hhb * 4;
#pragma unroll
                for (int dvb = 0; dvb < 8; ++dvb)
#pragma unroll
                    for (int rq = 0; rq < 4; ++rq) {
                        const int dv0 = dvb * 32 + rq * 8;
                        const f32x4 sg = *(const GAS f32x4*)(sgp + dv0 + hhb * 4);
                        h16x4 o = {(h16)(O[dvb][rq * 4 + 0] * rms * sg[0]), (h16)(O[dvb][rq * 4 + 1] * rms * sg[1]), (h16)(O[dvb][rq * 4 + 2] * rms * sg[2]), (h16)(O[dvb][rq * 4 + 3] * rms * sg[3])};
                        *(h16x4*)(op + dv0) = o;
                    }
            }
        }
    }
}

#define XB_TMO      128
#define XB_XCNT(j)  (256  + 64 * (j))
#define XB_XSUB(j)  (1280 + 64 * (j))
#define XB_XGEN(j)  (2304 + 64 * (j))
#define XB_TOP      3328
#define XB_TOPGEN   3392
#define XCD_BAR_WORDS 3456
#define XB_SPIN_CAP (1u << 18)

__device__ __forceinline__ unsigned xb_ld(unsigned* p)              { return __hip_atomic_load(p, __ATOMIC_RELAXED, __HIP_MEMORY_SCOPE_AGENT); }
__device__ __forceinline__ unsigned xb_add(unsigned* p, unsigned v) { return __hip_atomic_fetch_add(p, v, __ATOMIC_RELAXED, __HIP_MEMORY_SCOPE_AGENT); }
__device__ __forceinline__ unsigned xb_xcc_id() { return (unsigned)__builtin_amdgcn_s_getreg((3 << 11) | 20) & 0xFu; }
#define XB_SPIN(cond, bar) do { unsigned _sp = 0; while (cond) { __builtin_amdgcn_s_sleep(1); \
    if ((++_sp & 255u) == 0u) { if (xb_ld(&(bar)[XB_TMO])) break; if (_sp > XB_SPIN_CAP) { atomicAdd(&(bar)[XB_TMO], 1u); break; } } } } while (0)

struct XcdBarrier {
    unsigned* bar; unsigned x;
    volatile LAS unsigned* st;
};

__device__ __forceinline__ XcdBarrier xcd_barrier_post(unsigned* bar, volatile LAS unsigned* st) {
    XcdBarrier b; b.bar = bar; b.x = xb_xcc_id(); b.st = st;
    if (threadIdx.x == 0) (void)xb_add(&bar[XB_XCNT(b.x)], 1u);
    return b;
}
__device__ __forceinline__ void xcd_barrier_complete(unsigned* bar, unsigned x, unsigned& nloc, unsigned& nx) {
    const unsigned G = gridDim.x * gridDim.y * gridDim.z;
    unsigned sum, cnt, mine, sp = 0u;
    for (;;) {
        sum = 0u; cnt = 0u; mine = 0u;
#pragma unroll
        for (unsigned j = 0; j < 16; ++j) { const unsigned c = xb_ld(&bar[XB_XCNT(j)]); sum += c; cnt += (c > 0u) ? 1u : 0u; mine = (j == x) ? c : mine; }
        if (sum == G) break;
        __builtin_amdgcn_s_sleep(1);
        if ((++sp & 255u) == 0u) { if (xb_ld(&bar[XB_TMO])) break; if (sp > XB_SPIN_CAP) { atomicAdd(&bar[XB_TMO], 1u); break; } }
    }
    nloc = mine > 0u ? mine : 1u; nx = cnt > 0u ? cnt : 1u;
}

__device__ __forceinline__ void xcd_barrier(const XcdBarrier& b) {
    asm volatile("s_waitcnt vmcnt(0)" ::: "memory");
    __syncthreads();
    if (threadIdx.x == 0) {
        unsigned* bar = b.bar;
        __builtin_amdgcn_s_waitcnt(0);
        unsigned nloc = b.st[0], nx = b.st[1];
        if (nloc == 0u) { xcd_barrier_complete(bar, b.x, nloc, nx); b.st[0] = nloc; b.st[1] = nx; }
        const unsigned old = xb_add(&bar[XB_XSUB(b.x)], 1u);
        const unsigned gen = old / nloc;
        if (old + 1u == (gen + 1u) * nloc) {
            __builtin_amdgcn_fence(__ATOMIC_RELEASE, "agent");
            asm volatile("s_waitcnt vmcnt(0)" ::: "memory");
            const unsigned og = xb_add(&bar[XB_TOP], 1u);
            const unsigned tg = og / nx;
            if (og + 1u == (tg + 1u) * nx) xb_add(&bar[XB_TOPGEN], 1u);
            else XB_SPIN(xb_ld(&bar[XB_TOPGEN]) == tg, bar);
            __builtin_amdgcn_fence(__ATOMIC_ACQUIRE, "agent");
            xb_add(&bar[XB_XGEN(b.x)], 1u);
            asm volatile("s_waitcnt vmcnt(0)" ::: "memory");
        } else {
            XB_SPIN(xb_ld(&bar[XB_XGEN(b.x)]) == gen, bar);
            __builtin_amdgcn_fence(__ATOMIC_ACQUIRE, "agent");
            asm volatile("s_waitcnt vmcnt(0)" ::: "memory");
        }
    }
    __syncthreads();
}


__device__ __forceinline__ void gbar(unsigned* ctr, unsigned target) {
    asm volatile("s_waitcnt vmcnt(0)" ::: "memory");
    __syncthreads();
    if (threadIdx.x == 0) {
        __builtin_amdgcn_fence(__ATOMIC_RELEASE, "agent");
        asm volatile("s_waitcnt vmcnt(0)" ::: "memory");
        __hip_atomic_fetch_add(ctr, 1u, __ATOMIC_RELAXED, __HIP_MEMORY_SCOPE_AGENT);
        while (__hip_atomic_load(ctr, __ATOMIC_RELAXED, __HIP_MEMORY_SCOPE_AGENT) < target) __builtin_amdgcn_s_sleep(1);
        __builtin_amdgcn_fence(__ATOMIC_ACQUIRE, "agent");
        asm volatile("s_waitcnt vmcnt(0)" ::: "memory");
    }
    __syncthreads();
}

#ifndef ONLY_GI
#define ENG(k) true
#else
#define ENG(k) ((k) == ONLY_GI)
#endif
#ifndef ONLY_KIND
#define EN(k) true
#else
#define EN(k) ((k) == ONLY_KIND)
#endif
__global__ void __launch_bounds__(512, 2) fwd_megakernel(Params p) {
    extern __shared__ __attribute__((aligned(16))) unsigned char shm[];
    LAS unsigned char* lds = (LAS unsigned char*)shm;
    cg::grid_group grid = cg::this_grid();
    unsigned char* ws = p.ws;
    h16* PRE = (h16*)(ws + WS_PRE); h16* XH = (h16*)(ws + WS_XH); h16* VF = (h16*)(ws + WS_VF);
    unsigned char* R1 = ws + WS_R1; unsigned char* R2 = ws + WS_R2; float* Y = (float*)(ws + WS_Y);
    h16* MIX = (h16*)R1; h16* SIDE = (h16*)R1; h16* AO = (h16*)R1;
    h16* DEC = (h16*)(R1 + R1_DEC); h16* Ab = (h16*)(R1 + R1_A); h16* Gb = (h16*)(R1 + R1_G); h16* AA = (h16*)(R1 + R1_AA); h16* YG = (h16*)(R1 + R1_YG);
    h16* C1 = (h16*)R2; h16* ACT = (h16*)R2; h16* Qb = (h16*)R2; h16* Kb = Qb + (size_t)MTOK * DM; h16* Vt = Kb + (size_t)MTOK * DM;

    volatile LAS unsigned* xst = (volatile LAS unsigned*)(lds + LDS_BYTES - 16);
    if (threadIdx.x == 0) { xst[0] = 0u; xst[1] = 0u; }
    __syncthreads();
    const XcdBarrier xb = xcd_barrier_post((unsigned*)(ws + WS_BAR), xst);
    for (int ph = p.ph_lo; ph < p.ph_hi; ++ph) {
        int layer, kind;
        if (ph < 11) { layer = 0; kind = (int)((0xDCBA9854210ull >> (4 * ph)) & 15ull); }
        else if (ph < 19) { layer = 1; kind = (int)((0xDCBA9876ull >> (4 * (ph - 11))) & 15ull); }
        else if (ph < 29) { layer = 2; kind = (int)((0xDCBA985421ull >> (4 * (ph - 19))) & 15ull); }
        else { layer = 3; kind = (int)((0xDCBA9876ull >> (4 * (ph - 29))) & 15ull); }
        const int j = layer >> 1;
        const char* W = (const char*)(ws + ((layer & 1) ? WS_X : WS_W16));
        const h16* wB1 = (const h16*)(W + W_B1); const h16* wB2 = (const h16*)(W + W_B2); const h16* wWO = (const h16*)(W + W_WO);
        const h16* wUP = (const h16*)(W + W_UP); const h16* wDN = (const h16*)(W + W_DN);
        const int nrep = ((PROBE_MASK >> kind) & 1) ? 2 : 1;
        for (int rep = 0; rep < nrep; ++rep)
        switch (kind) {
        case 0: if (EN(0)) {
            cvt_layer(lds, p, 0);
            ln_phase<false>(p.in[0], nullptr, nullptr, nullptr, XH, p.in[3], MIX);
        } break;
        case 1: if (EN(1)) {
            AMapMix am{(const char*)MIX}; EpiG1 e{C1, j == 0 ? VF : nullptr};
            pg8::gemm_phase(lds, am, DM, wB1, DM, MTOK, j == 0 ? 6912 : 7168, DM, e);
        } break;
        case 2: if (EN(2)) {
            const float* w0 = p.in[5] + (size_t)j * DM; const float* a0 = p.in[8] + (size_t)j * DM; const float* v0 = p.in[11] + (size_t)(j > 0 ? j - 1 : 0) * DM;
            int k2 = 128; asm volatile("" : "+s"(k2));
            if (ENG(0)) { AMapOne am{(const char*)(C1 + 6144)}; EpiG2<0> e{DEC, Ab, Gb, C1, VF, w0, a0, v0, AA, p.in[16] + (size_t)j * DM, p.in[17] + (size_t)j * DM}; pg8::gemm_phase(lds, am, LDC1, wB2, 256, MTOK, DM, k2, e); }
            if (ENG(1)) { AMapOne am{(const char*)(C1 + 6400)}; EpiG2<1> e{DEC, Ab, Gb, C1, VF, w0, a0, v0, AA, p.in[16] + (size_t)j * DM, p.in[17] + (size_t)j * DM}; pg8::gemm_phase(lds, am, LDC1, wB2 + (size_t)2048 * 256, 256, MTOK, DM, k2, e); }
            if (ENG(2)) { AMapOne am{(const char*)(C1 + 6656)}; EpiG2<2> e{DEC, Ab, Gb, C1, VF, w0, a0, v0, AA, p.in[16] + (size_t)j * DM, p.in[17] + (size_t)j * DM}; pg8::gemm_phase(lds, am, LDC1, wB2 + (size_t)4096 * 256, 256, MTOK, DM, k2, e); }
            if (ENG(3) && j > 0) { AMapOne am{(const char*)(C1 + 6912)}; EpiG2<3> e{DEC, Ab, Gb, C1, VF, w0, a0, v0, AA, p.in[16] + (size_t)j * DM, p.in[17] + (size_t)j * DM}; pg8::gemm_phase(lds, am, LDC1, wB2 + (size_t)6144 * 256, 256, MTOK, DM, k2, e); }
        } break;
        case 3: if (EN(3)) prep_phase(C1, Ab, AA, VF, p.in[16] + (size_t)j * DM, p.in[17] + (size_t)j * DM, j == 0); break;
        case 4: if (EN(4)) scan_phase(lds, C1, DEC, AA, Ab, Y, p.in[22] + (size_t)j * DM * 6144, p.in[25] + (size_t)j * DM * DM, p.in[27] + (size_t)(layer + 1) * DM * 2 * FF, p.in[30] + (size_t)(layer + 1) * FF * DM, (char*)(ws + WS_X),
                                       p.in[27] + (size_t)layer * DM * 2 * FF, p.in[30] + (size_t)layer * FF * DM, (char*)(ws + WS_W16), layer == 0 ? p.in[4] + (size_t)3 * DM * DM : nullptr); break;
        case 5: if (EN(5)) gn_phase(Y, C1, Gb, YG, p.in[18] + (size_t)j * DM, p.in[19] + (size_t)j * DM, p.in[20] + (size_t)j * DM, nullptr); break;
        case 6: if (EN(6)) {
            AMapOne am{(const char*)XH}; EpiQKV e{Qb, Kb, Vt};
            pg8::gemm_phase(lds, am, DM, wB1, DM, MTOK, 6144, DM, e);
        } break;
        case 7: if (EN(7)) {
            const float li = layer == 1 ? 0.35550906759096926f : 0.5560581861995943f;
            attn_phase(lds, Qb, Kb, Vt, AO, p.in[26], p.in[23] + (size_t)j * 512, p.in[24] + (size_t)j * 256, li);
        } break;
        case 8: if (EN(8)) {
            AMapOne am{(const char*)((layer & 1) ? AO : YG)}; EpiRes e{XH, PRE};
            pg8::gemm_phase(lds, am, DM, wWO, DM, MTOK, DM, DM, e);
        } break;
        case 9: case 13: if (EN(9)) {
            const int sub = kind == 9 ? 0 : 1;
            const float* g = p.in[1] + (size_t)(layer * 2 + sub) * DM; const float* bt = p.in[2] + (size_t)(layer * 2 + sub) * DM;
            float* xo = nullptr; h16* xh = XH; const float* mu = nullptr; h16* mx = nullptr;
            if (kind == 13) {
                if (layer == 3) { xo = p.out; xh = nullptr; }
                else {
                    if (layer == 1) cvt_layer(lds, p, layer + 1);
                    if (layer == 1) { mu = p.in[3] + (size_t)1 * 6 * DM; mx = MIX; }
                }
            }
            ln_phase<true>(PRE, g, bt, xo, xh, mu, mx);
        } break;
        case 10: if (EN(10)) {
            AMapOne am{(const char*)XH}; EpiUpConv e{ACT, SIDE, p.in[28] + (size_t)layer * 3 * FF, p.in[29] + (size_t)layer * FF};
            pg8::gemm_phase(lds, am, DM, wUP, DM, MTOK, 2 * FF, DM, e);
        } break;
        case 11: if (EN(11)) convfix_phase(SIDE, ACT, p.in[28] + (size_t)layer * 3 * FF, p.in[29] + (size_t)layer * FF); break;
        case 12: if (EN(12)) {
            AMapOne am{(const char*)ACT}; EpiRes e{XH, PRE};
            pg8::gemm_phase(lds, am, FF, wDN, FF, MTOK, DM, FF, e);
        } break;
        }
        if (ph + 1 < p.ph_hi) {
            if (p.ph_lo < 0) grid.sync();
            else xcd_barrier(xb);
        }
    }
}

constexpr int NPHASES = 37;

extern "C" void kernel_launch(void* const* d_in, const int* in_sizes, int n_in, void* d_out, int out_size, void* d_ws, size_t ws_size, hipStream_t stream) {
    static int grid_blocks = 0;
    if (!grid_blocks) {
        if (n_in != 31 || ws_size < WS_END) { fprintf(stderr, "kernel_launch: unexpected n_in %d / ws_size %zu (need %zu)\n", n_in, ws_size, (size_t)WS_END); grid_blocks = -1; return; }
        int dev = 0, cus = 0, per_cu = 0;
        hipGetDevice(&dev);
        hipDeviceGetAttribute(&cus, hipDeviceAttributeMultiprocessorCount, dev);
        if (hipFuncSetAttribute((const void*)fwd_megakernel, hipFuncAttributeMaxDynamicSharedMemorySize, LDS_BYTES) != hipSuccess) { fprintf(stderr, "kernel_launch: hipFuncSetAttribute failed\n"); grid_blocks = -1; return; }
        if (hipOccupancyMaxActiveBlocksPerMultiprocessor(&per_cu, (const void*)fwd_megakernel, 512, LDS_BYTES) != hipSuccess || per_cu < 1) { fprintf(stderr, "kernel_launch: occupancy query gave %d\n", per_cu); per_cu = 1; (void)hipGetLastError(); }
        grid_blocks = cus * per_cu;
        if (grid_blocks > 256) grid_blocks = 256;
    }
    if (grid_blocks < 0) return;
    Params p{};
    for (int i = 0; i < 31; ++i) p.in[i] = (const float*)d_in[i];
    p.out = (float*)d_out; p.ws = (unsigned char*)d_ws; p.ph_lo = 0; p.ph_hi = NPHASES;
    if (hipMemsetAsync((char*)d_ws + WS_BAR, 0, 16384, stream) != hipSuccess) { fprintf(stderr, "kernel_launch: memset failed\n"); return; }
    void* args[] = {&p};
    hipError_t e = hipLaunchCooperativeKernel((const void*)fwd_megakernel, dim3(grid_blocks), dim3(512), args, LDS_BYTES, stream);
    if (e != hipSuccess) fprintf(stderr, "cooperative launch failed: %s (grid %d)\n", hipGetErrorString(e), grid_blocks);
}
```
